# Optimizing an MI355X kernel written in HIP

```python
import math
import jax, jax.numpy as jnp
from jax import lax
import numpy as np

D_MODEL = 1024
BATCH = 4
SEQ = 8192
DEPTH = 2

N_MEM = 256
HEAD_DIM = 64
MEM_HEADS = 4
MEM_WIDTH = MEM_HEADS * HEAD_DIM
MAIN_WIDTH = D_MODEL - MEM_WIDTH

GLA_HEADS = 4
GLA_DV = MAIN_WIDTH // GLA_HEADS
GLA_DK = GLA_DV // 2
GLA_LOWRANK = 16
GLA_TAU = 16.0
GLA_CHUNK = 64

SWA_HEADS = MAIN_WIDTH // HEAD_DIM
SWA_KV_HEADS = 4
WINDOW = 128
ROPE_DIM = HEAD_DIM // 4
ROPE_THETA = 500000.0

D_FF = 2816
N_EXPERTS = 8
TOP_K = 2
D_FF_EXPERT = 3584

EPS = 1e-6
N_LAYERS_A = (DEPTH + 1) // 2
N_LAYERS_B = DEPTH // 2

W_IN_A = 2 * GLA_HEADS * GLA_DK + MAIN_WIDTH + GLA_LOWRANK + MAIN_WIDTH + MEM_WIDTH
W_IN_B = SWA_HEADS * HEAD_DIM + 2 * SWA_KV_HEADS * HEAD_DIM + MEM_WIDTH

kernel_name = "hybrid_gla_swa_sink_memxattn_moe"


def rms_norm(x, gain):
    xf = x.astype(jnp.float32)
    y = xf * lax.rsqrt(jnp.mean(xf * xf, axis=-1, keepdims=True) + EPS)
    return (y * gain.astype(jnp.float32)).astype(x.dtype)


def partial_rope(t, positions):
    half = ROPE_DIM // 2
    inv_freq = jnp.power(jnp.float32(ROPE_THETA), -jnp.arange(half, dtype=jnp.float32) / half)
    ang = positions.astype(jnp.float32)[:, :, None] * inv_freq
    cos = jnp.cos(ang)[:, :, None, :]
    sin = jnp.sin(ang)[:, :, None, :]
    tf = t.astype(jnp.float32)
    x1 = tf[..., :half]
    x2 = tf[..., half:ROPE_DIM]
    out = jnp.concatenate([x1 * cos - x2 * sin, x2 * cos + x1 * sin, tf[..., ROPE_DIM:]], axis=-1)
    return out.astype(t.dtype)


def gla_chunked(q, k, v, log_alpha):
    B, S, H, dk = q.shape
    dv = v.shape[-1]
    C = GLA_CHUNK
    N = S // C

    def to_chunks(t):
        return t.astype(jnp.float32).reshape(B, N, C, H, t.shape[-1]).transpose(1, 0, 3, 2, 4)

    qc, kc, vc, gc = to_chunks(q), to_chunks(k), to_chunks(v), to_chunks(log_alpha)
    b = jnp.cumsum(gc, axis=3)
    b_last = b[:, :, :, -1:, :]
    q_dec = qc * jnp.exp(b)
    k_dec = kc * jnp.exp(-b)
    k_to_end = kc * jnp.exp(b_last - b)

    causal = jnp.tril(jnp.ones((C, C), dtype=bool))
    attn = jnp.einsum('nbhtd,nbhsd->nbhts', q_dec, k_dec)
    attn = jnp.where(causal, attn, 0.0)
    o_intra = jnp.einsum('nbhts,nbhsv->nbhtv', attn, vc)

    chunk_kv = jnp.einsum('nbhsd,nbhsv->nbhdv', k_to_end, vc)
    chunk_decay = jnp.exp(b_last[:, :, :, 0, :])

    def step(state, inp):
        kv, dec = inp
        return dec[..., None] * state + kv, state

    state0 = jnp.zeros((B, H, dk, dv), jnp.float32)
    _, state_start = lax.scan(step, state0, (chunk_kv, chunk_decay))
    o_inter = jnp.einsum('nbhtd,nbhdv->nbhtv', q_dec, state_start)
    o = o_intra + o_inter
    return o.transpose(1, 0, 3, 2, 4).reshape(B, S, H, dv)


def sliding_window_gqa_sinks(q, k, v, sinks):
    B, S, H, D = q.shape
    Hkv = k.shape[2]
    G = H // Hkv
    W = WINDOW
    nb = S // W
    qb = q.reshape(B, nb, W, Hkv, G, D)

    def with_prev(t):
        cur = t.reshape(B, nb, W, Hkv, D)
        prev = jnp.concatenate([jnp.zeros_like(cur[:, :1]), cur[:, :-1]], axis=1)
        return jnp.concatenate([prev, cur], axis=2)

    kb, vb = with_prev(k), with_prev(v)
    s = jnp.einsum('bnqkgd,bnskd->bnkgqs', qb, kb).astype(jnp.float32) * (D ** -0.5)

    qi = jnp.arange(W)[:, None]
    kj = jnp.arange(2 * W)[None, :]
    dist = qi + W - kj
    band = (dist >= 0) & (dist < WINDOW)
    has_prev = (jnp.arange(nb)[:, None, None] > 0) | (kj >= W)[None]
    valid = (band[None] & has_prev)[None, :, None, None]

    sink = sinks.astype(jnp.float32).reshape(Hkv, G)[None, None, :, :, None]
    s = jnp.where(valid, s, -jnp.inf)
    m = jnp.maximum(jnp.max(s, axis=-1), sink)
    p = jnp.exp(s - m[..., None])
    denom = jnp.sum(p, axis=-1) + jnp.exp(sink - m)
    p = p / denom[..., None]
    out = jnp.einsum('bnkgqs,bnskd->bnqkgd', p.astype(vb.dtype), vb)
    return out.reshape(B, S, H * D)


def memory_cross_attention(qm, mem_n, w_mem_kv):
    B, S = qm.shape[:2]
    kv = mem_n @ w_mem_kv
    km = kv[..., :MEM_WIDTH].reshape(B, -1, MEM_HEADS, HEAD_DIM)
    vm = kv[..., MEM_WIDTH:].reshape(B, -1, MEM_HEADS, HEAD_DIM)
    s = jnp.einsum('bshd,bmhd->bhsm', qm, km).astype(jnp.float32) * (HEAD_DIM ** -0.5)
    p = jax.nn.softmax(s, axis=-1)
    out = jnp.einsum('bhsm,bmhd->bshd', p.astype(vm.dtype), vm)
    return out.reshape(B, S, MEM_WIDTH)


def swiglu(h, w_gate_up, w_down, d_ff):
    gu = h @ w_gate_up
    return (jax.nn.silu(gu[..., :d_ff]) * gu[..., d_ff:]) @ w_down


def moe_swiglu(h, router_w, exp_w_gate_up, exp_w_down):
    logits = (h @ router_w).astype(jnp.float32)
    top_v, top_i = lax.top_k(logits, TOP_K)
    gates = jax.nn.softmax(top_v, axis=-1)
    combine = jnp.sum(jax.nn.one_hot(top_i, N_EXPERTS, dtype=jnp.float32) * gates[..., None], axis=-2)
    y = jnp.zeros(h.shape, jnp.float32)
    for e in range(N_EXPERTS):
        y = y + combine[..., e:e + 1] * swiglu(h, exp_w_gate_up[e], exp_w_down[e], D_FF_EXPERT).astype(jnp.float32)
    return y.astype(h.dtype)


def setup_inputs(seed: int = 0) -> dict:
    key = jax.random.key(seed)
    ks = jax.random.split(key, 20)
    f32 = jnp.float32

    def w(k, shape, fan_in):
        return jax.random.normal(k, shape, f32) * (fan_in ** -0.5)

    def gain(k, shape):
        return 1.0 + 0.05 * jax.random.normal(k, shape, f32)

    x = jax.random.normal(ks[0], (BATCH, SEQ, D_MODEL), f32)
    mem = jax.random.normal(ks[1], (BATCH, N_MEM, D_MODEL), f32)
    offsets = jax.random.randint(ks[2], (BATCH, 1), 0, 4096, dtype=jnp.int32)
    positions = offsets + jnp.arange(SEQ, dtype=jnp.int32)[None, :]
    return {
        "x": x,
        "mem": mem,
        "positions": positions,
        "mix_norm": gain(ks[3], (DEPTH, D_MODEL)),
        "w_in_a": w(ks[4], (N_LAYERS_A, D_MODEL, W_IN_A), D_MODEL),
        "gla_gate_w": w(ks[5], (N_LAYERS_A, GLA_LOWRANK, GLA_HEADS * GLA_DK), GLA_LOWRANK),
        "gla_gate_b": 2.0 + 0.1 * jax.random.normal(ks[6], (N_LAYERS_A, GLA_HEADS * GLA_DK), f32),
        "gla_out_norm": gain(ks[7], (N_LAYERS_A, GLA_DV)),
        "w_in_b": w(ks[8], (N_LAYERS_B, D_MODEL, W_IN_B), D_MODEL),
        "swa_sinks": 0.5 * jax.random.normal(ks[9], (N_LAYERS_B, SWA_HEADS), f32),
        "mem_norm": gain(ks[10], (DEPTH, D_MODEL)),
        "w_mem_kv": w(ks[11], (DEPTH, D_MODEL, 2 * MEM_WIDTH), D_MODEL),
        "w_out": w(ks[12], (DEPTH, D_MODEL, D_MODEL), D_MODEL),
        "ffn_norm": gain(ks[13], (DEPTH, D_MODEL)),
        "ffn_w_gate_up": w(ks[14], (N_LAYERS_A, D_MODEL, 2 * D_FF), D_MODEL),
        "ffn_w_down": w(ks[15], (N_LAYERS_A, D_FF, D_MODEL), D_FF),
        "router_w": w(ks[16], (N_LAYERS_B, D_MODEL, N_EXPERTS), D_MODEL),
        "exp_w_gate_up": w(ks[17], (N_LAYERS_B, N_EXPERTS, D_MODEL, 2 * D_FF_EXPERT), D_MODEL),
        "exp_w_down": w(ks[18], (N_LAYERS_B, N_EXPERTS, D_FF_EXPERT, D_MODEL), D_FF_EXPERT),
        "final_norm": gain(ks[19], (D_MODEL,)),
    }


def reference(x, mem, positions, mix_norm, w_in_a, gla_gate_w, gla_gate_b, gla_out_norm,
              w_in_b, swa_sinks, mem_norm, w_mem_kv, w_out, ffn_norm, ffn_w_gate_up,
              ffn_w_down, router_w, exp_w_gate_up, exp_w_down, final_norm):
    B, S, _ = x.shape
    for i in range(DEPTH):
        j = i // 2
        h = rms_norm(x, mix_norm[i])
        mem_n = rms_norm(mem, mem_norm[i])
        if i % 2 == 0:
            z = h @ w_in_a[j]
            dqk = GLA_HEADS * GLA_DK
            o0 = 0
            q = z[..., o0:o0 + dqk]; o0 += dqk
            k = z[..., o0:o0 + dqk]; o0 += dqk
            v = z[..., o0:o0 + MAIN_WIDTH]; o0 += MAIN_WIDTH
            g_lr = z[..., o0:o0 + GLA_LOWRANK]; o0 += GLA_LOWRANK
            r = z[..., o0:o0 + MAIN_WIDTH]; o0 += MAIN_WIDTH
            qm = z[..., o0:o0 + MEM_WIDTH]
            gate_logits = (g_lr @ gla_gate_w[j] + gla_gate_b[j]).astype(jnp.float32)
            log_alpha = (jax.nn.log_sigmoid(gate_logits) / GLA_TAU).reshape(B, S, GLA_HEADS, GLA_DK)
            q = q.reshape(B, S, GLA_HEADS, GLA_DK) * (GLA_DK ** -0.5)
            k = k.reshape(B, S, GLA_HEADS, GLA_DK)
            v = v.reshape(B, S, GLA_HEADS, GLA_DV)
            o = gla_chunked(q, k, v, log_alpha)
            o = rms_norm(o, gla_out_norm[j]).reshape(B, S, MAIN_WIDTH)
            main = (o * jax.nn.silu(r.astype(jnp.float32))).astype(x.dtype)
        else:
            z = h @ w_in_b[j]
            dq = SWA_HEADS * HEAD_DIM
            dkv = SWA_KV_HEADS * HEAD_DIM
            q = z[..., :dq].reshape(B, S, SWA_HEADS, HEAD_DIM)
            k = z[..., dq:dq + dkv].reshape(B, S, SWA_KV_HEADS, HEAD_DIM)
            v = z[..., dq + dkv:dq + 2 * dkv].reshape(B, S, SWA_KV_HEADS, HEAD_DIM)
            qm = z[..., dq + 2 * dkv:]
            q = partial_rope(q, positions)
            k = partial_rope(k, positions)
            main = sliding_window_gqa_sinks(q, k, v, swa_sinks[j]).astype(x.dtype)
        mem_out = memory_cross_attention(qm.reshape(B, S, MEM_HEADS, HEAD_DIM), mem_n, w_mem_kv[i])
        mixed = jnp.concatenate([main, mem_out.astype(x.dtype)], axis=-1) @ w_out[i]
        x = x + mixed
        h = rms_norm(x, ffn_norm[i])
        if i % 2 == 0:
            x = x + swiglu(h, ffn_w_gate_up[j], ffn_w_down[j], D_FF)
        else:
            x = x + moe_swiglu(h, router_w[j], exp_w_gate_up[j], exp_w_down[j])
    return rms_norm(x, final_norm)
```

```cpp
#include <hip/hip_runtime.h>
#include <cstdio>
#include <cstdint>

#ifndef N_LAUNCH_MODE
#define N_LAUNCH_MODE 0
#endif
#ifndef FASTMASK
#define FASTMASK 0u
#endif

#define LAS __attribute__((address_space(3)))
#define GAS __attribute__((address_space(1)))
typedef unsigned short bf16;
typedef float f32x4 __attribute__((ext_vector_type(4)));
typedef float f32x2 __attribute__((ext_vector_type(2)));
typedef unsigned u32x4 __attribute__((ext_vector_type(4)));
typedef unsigned u32x2 __attribute__((ext_vector_type(2)));
typedef short bf16x8 __attribute__((ext_vector_type(8)));

constexpr int NB = 4, SEQ = 8192, DM = 1024, M = NB * SEQ;
constexpr int NMEM = 256, HD = 64, MEMH = 4, MEMW = 256, MAINW = 768;
constexpr int GH = 4, GDV = 192, GDK = 96, GLRK = 16, GCH = 64, NCH = SEQ / GCH;
constexpr int SWH = 12, SWKV = 4, WIN = 128;
constexpr int DFF = 2816, NE = 8, DFE = 3584;
constexpr int WINA = 2576, WINB = 1536;
constexpr int NA = 2560;
constexpr int ZA_Q = 0, ZA_K = 384, ZA_V = 768, ZA_R = 1536, ZA_QM = 2304;
constexpr int ZB_Q = 0, ZB_K = 768, ZB_V = 1024, ZB_QM = 1280;
constexpr float EPS = 1e-6f;
constexpr int MAXROWS = 67584;
constexpr int MAXRT = MAXROWS / 256;

constexpr size_t MiB = 1u << 20;
constexpr size_t WS_CTL = 0, CTL_ZERO_BYTES = 1 * MiB;
constexpr int CW_BAR = 4096;
constexpr size_t CTL_SS1 = 128 * 1024, CTL_SS2 = 256 * 1024, CTL_SS3 = 384 * 1024;
constexpr size_t WS_SS0 = 1 * MiB;
constexpr size_t WS_GLR = 2 * MiB;
constexpr size_t WS_ROPE = 4 * MiB;
constexpr size_t WS_MEMKV = 6 * MiB;
constexpr size_t WS_MEMN = 8 * MiB;
constexpr size_t WS_ROUTE = 12 * MiB;
constexpr size_t RT_TOPI = WS_ROUTE;
constexpr size_t RT_TOPG = RT_TOPI + 256 * 1024;
constexpr size_t RT_POS = RT_TOPG + 256 * 1024;
constexpr size_t RT_RS3 = RT_POS + 256 * 1024;
constexpr size_t RT_ROWTOK = RT_RS3 + 128 * 1024;
constexpr size_t RT_ROWGATE = RT_ROWTOK + 272 * 1024;
constexpr size_t RT_ROWRS = RT_ROWGATE + 272 * 1024;
constexpr size_t RT_BCNT = RT_ROWRS + 272 * 1024;
constexpr size_t RT_TILEE = RT_BCNT + 8 * 1024;
static_assert(RT_TILEE + 4096 <= 16 * MiB, "route map");
constexpr size_t WT_INA = 16 * MiB, WT_INB = 21 * MiB, WT_MKV = 24 * MiB, WT_OUT = 26 * MiB, WT_FGU = 30 * MiB, WT_FDN = 41 * MiB, WT_EGU = 47 * MiB, WT_EDN = 159 * MiB;
constexpr size_t WS_Z = 216 * MiB;
constexpr size_t WS_XB = 376 * MiB;
constexpr size_t WS_MIX = 440 * MiB;
constexpr size_t WS_GK = 504 * MiB;
constexpr size_t WS_ACTM = 216 * MiB;
constexpr size_t WS_XG = 720 * MiB;
constexpr size_t WS_END = 852 * MiB;
static_assert(WS_ACTM + (size_t)MAXROWS * DFE * 2 <= WS_XG, "ACT_MOE fits");
constexpr size_t GK_KV = WS_GK;
constexpr size_t GK_ST = WS_GK + 144 * MiB;
constexpr size_t GK_ALPHA = WS_GK;
constexpr size_t GK_ORAW = WS_GK + 48 * MiB;
constexpr size_t GK_ACTF = WS_GK;
constexpr size_t GK_ZF = WS_GK;

constexpr int NWAVES = 8, NTHREADS = 512;
constexpr int LDS_BYTES = 147456;
constexpr int MISC_OFF = 131072 + 320;

__device__ __forceinline__ float bf2f(bf16 b) { return __uint_as_float(((unsigned)b) << 16); }
__device__ __forceinline__ unsigned f2bf(float f) { unsigned u = __float_as_uint(f); return (u + 0x7fffu + ((u >> 16) & 1u)) >> 16; }
__device__ __forceinline__ unsigned pk2(float lo, float hi) { return f2bf(lo) | (f2bf(hi) << 16); }
__device__ __forceinline__ float wave_sum(float v) {
#pragma unroll
    for (int o = 1; o < 64; o <<= 1) v += __shfl_xor(v, o);
    return v;
}
__device__ __forceinline__ float wave_max(float v) {
#pragma unroll
    for (int o = 1; o < 64; o <<= 1) v = fmaxf(v, __shfl_xor(v, o));
    return v;
}
__device__ __forceinline__ float silu_f(float x) { return x / (1.0f + __expf(-x)); }

#define XB_TMO      128
#define XB_XCNT(j)  (256  + 64 * (j))
#define XB_XSUB(j)  (1280 + 64 * (j))
#define XB_XGEN(j)  (2304 + 64 * (j))
#define XB_TOP      3328
#define XB_TOPGEN   3392
#define XCD_BAR_WORDS 3456
#define XB_SPIN_CAP (1u << 18)

__device__ __forceinline__ unsigned xb_ld(unsigned* p)              { return __hip_atomic_load(p, __ATOMIC_RELAXED, __HIP_MEMORY_SCOPE_AGENT); }
__device__ __forceinline__ unsigned xb_add(unsigned* p, unsigned v) { return __hip_atomic_fetch_add(p, v, __ATOMIC_RELAXED, __HIP_MEMORY_SCOPE_AGENT); }
__device__ __forceinline__ unsigned xb_xcc_id() { return (unsigned)__builtin_amdgcn_s_getreg((3 << 11) | 20) & 0xFu; }
#define XB_SPIN(cond, bar) do { unsigned _sp = 0; while (cond) { __builtin_amdgcn_s_sleep(1); \
    if ((++_sp & 255u) == 0u) { if (xb_ld(&(bar)[XB_TMO])) break; if (_sp > XB_SPIN_CAP) { atomicAdd(&(bar)[XB_TMO], 1u); break; } } } } while (0)

struct XcdBarrier {
    unsigned* bar; unsigned x;
    volatile LAS unsigned* st;
};

__device__ __forceinline__ XcdBarrier xcd_barrier_post(unsigned* bar, volatile LAS unsigned* st) {
    XcdBarrier b; b.bar = bar; b.x = xb_xcc_id(); b.st = st;
    if (threadIdx.x == 0) (void)xb_add(&bar[XB_XCNT(b.x)], 1u);
    return b;
}
__device__ __forceinline__ void xcd_barrier_complete(unsigned* bar, unsigned x, unsigned& nloc, unsigned& nx) {
    const unsigned G = gridDim.x * gridDim.y * gridDim.z;
    unsigned sum, cnt, mine, sp = 0u;
    for (;;) {
        sum = 0u; cnt = 0u; mine = 0u;
#pragma unroll
        for (unsigned j = 0; j < 16; ++j) { const unsigned c = xb_ld(&bar[XB_XCNT(j)]); sum += c; cnt += (c > 0u) ? 1u : 0u; mine = (j == x) ? c : mine; }
        if (sum == G) break;
        __builtin_amdgcn_s_sleep(1);
        if ((++sp & 255u) == 0u) { if (xb_ld(&bar[XB_TMO])) break; if (sp > XB_SPIN_CAP) { atomicAdd(&bar[XB_TMO], 1u); break; } }
    }
    nloc = mine > 0u ? mine : 1u; nx = cnt > 0u ? cnt : 1u;
}

__device__ __forceinline__ void xcd_barrier(const XcdBarrier& b) {
    asm volatile("s_waitcnt vmcnt(0)" ::: "memory");
    __syncthreads();
    if (threadIdx.x == 0) {
        unsigned* bar = b.bar;
        __builtin_amdgcn_s_waitcnt(0);
        unsigned nloc = b.st[0], nx = b.st[1];
        if (nloc == 0u) { xcd_barrier_complete(bar, b.x, nloc, nx); b.st[0] = nloc; b.st[1] = nx; }
        const unsigned old = xb_add(&bar[XB_XSUB(b.x)], 1u);
        const unsigned gen = old / nloc;
        if (old + 1u == (gen + 1u) * nloc) {
            __builtin_amdgcn_fence(__ATOMIC_RELEASE, "agent");
            asm volatile("s_waitcnt vmcnt(0)" ::: "memory");
            const unsigned og = xb_add(&bar[XB_TOP], 1u);
            const unsigned tg = og / nx;
            if (og + 1u == (tg + 1u) * nx) xb_add(&bar[XB_TOPGEN], 1u);
            else XB_SPIN(xb_ld(&bar[XB_TOPGEN]) == tg, bar);
            __builtin_amdgcn_fence(__ATOMIC_ACQUIRE, "agent");
            xb_add(&bar[XB_XGEN(b.x)], 1u);
            asm volatile("s_waitcnt vmcnt(0)" ::: "memory");
        } else {
            XB_SPIN(xb_ld(&bar[XB_XGEN(b.x)]) == gen, bar);
            __builtin_amdgcn_fence(__ATOMIC_ACQUIRE, "agent");
            asm volatile("s_waitcnt vmcnt(0)" ::: "memory");
        }
    }
    __syncthreads();
}

struct Args {
    const float* x; const float* mem; const int* positions; const float* mix_norm; const float* w_in_a; const float* gla_gate_w; const float* gla_gate_b; const float* gla_out_norm;
    const float* w_in_b; const float* swa_sinks; const float* mem_norm; const float* w_mem_kv; const float* w_out; const float* ffn_norm; const float* ffn_w_gate_up; const float* ffn_w_down;
    const float* router_w; const float* exp_w_gate_up; const float* exp_w_down; const float* final_norm;
    float* out; unsigned char* ws; int lo, hi, li, pad;
};

template <bool DUAL, class AF, class BF, class B2F, class EF>
__device__ __forceinline__ void simple_gemm(LAS float* sm, int Mrows, int N, int K, AF a_at, BF b_at, B2F b2_at, EF epi) {
    const int tid = threadIdx.x, ty = tid >> 4, tx = tid & 15;
    LAS float* As = sm; LAS float* Bs = sm + 16 * 132; LAS float* B2 = Bs + 16 * 68;
    const int tm = (Mrows + 127) / 128, tn = (N + 63) / 64;
    for (int t = blockIdx.x; t < tm * tn; t += gridDim.x) {
        const int m0 = (t / tn) * 128, n0 = (t % tn) * 64;
        float acc[4][4], acc2[4][4];
#pragma unroll
        for (int i = 0; i < 4; ++i)
#pragma unroll
            for (int j = 0; j < 4; ++j) { acc[i][j] = 0.f; acc2[i][j] = 0.f; }
        for (int k0 = 0; k0 < K; k0 += 16) {
#pragma unroll
            for (int i = 0; i < 4; ++i) { const int idx = tid + 512 * i, kk = idx & 15, mm = idx >> 4; As[kk * 132 + mm] = (m0 + mm < Mrows) ? a_at(m0 + mm, k0 + kk) : 0.f; }
#pragma unroll
            for (int i = 0; i < 2; ++i) { const int idx = tid + 512 * i, nn = idx & 63, kk = idx >> 6; const bool ok = n0 + nn < N;
                Bs[kk * 68 + nn] = ok ? b_at(k0 + kk, n0 + nn, m0) : 0.f; if (DUAL) B2[kk * 68 + nn] = ok ? b2_at(k0 + kk, n0 + nn, m0) : 0.f; }
            __syncthreads();
#pragma unroll
            for (int kk = 0; kk < 16; ++kk) {
                const f32x4 a = *(const LAS f32x4*)(As + kk * 132 + 4 * ty), b = *(const LAS f32x4*)(Bs + kk * 68 + 4 * tx);
                f32x4 b2 = b; if (DUAL) b2 = *(const LAS f32x4*)(B2 + kk * 68 + 4 * tx);
#pragma unroll
                for (int i = 0; i < 4; ++i)
#pragma unroll
                    for (int j = 0; j < 4; ++j) { acc[i][j] += a[i] * b[j]; if (DUAL) acc2[i][j] += a[i] * b2[j]; }
            }
            __syncthreads();
        }
#pragma unroll
        for (int i = 0; i < 4; ++i)
#pragma unroll
            for (int j = 0; j < 4; ++j) { const int m = m0 + 4 * ty + i, n = n0 + 4 * tx + j; if (m < Mrows && n < N) epi(m, n, acc[i][j], acc2[i][j]); }
    }
}

__constant__ float c_inv_freq[8] = {1.0f, 0.1939227432012558f, 0.03760603070259094f, 0.007292664609849453f, 0.0014142135623842478f, 0.00027424818836152554f, 5.318296098266728e-05f, 1.0313386155758053e-05f};

__device__ __forceinline__ void prep_rows(const Args& a) {
    const int lane = threadIdx.x & 63, wave = threadIdx.x >> 6, gw = blockIdx.x * NWAVES + wave, NGW = gridDim.x * NWAVES;
    bf16* XB = (bf16*)(a.ws + WS_XB); float* SS0 = (float*)(a.ws + WS_SS0);
    for (int m = gw; m < M; m += NGW) {
        const f32x4* xr = (const f32x4*)(a.x + (size_t)m * DM) + lane; f32x4 v[4]; float s = 0.f;
#pragma unroll
        for (int j = 0; j < 4; ++j) { v[j] = xr[64 * j]; s += (v[j].x * v[j].x + v[j].y * v[j].y) + (v[j].z * v[j].z + v[j].w * v[j].w); }
        s = wave_sum(s);
        u32x2* o = (u32x2*)(XB + (size_t)m * DM) + lane;
#pragma unroll
        for (int j = 0; j < 4; ++j) { u32x2 w; w.x = pk2(v[j].x, v[j].y); w.y = pk2(v[j].z, v[j].w); o[64 * j] = w; }
        if (lane == 0) SS0[m] = s;
    }
    bf16* MEMN = (bf16*)(a.ws + WS_MEMN);
    for (int r = gw; r < NB * NMEM; r += NGW) {
        const f32x4* xr = (const f32x4*)(a.mem + (size_t)r * DM) + lane; f32x4 v[4]; float s = 0.f;
#pragma unroll
        for (int j = 0; j < 4; ++j) { v[j] = xr[64 * j]; s += (v[j].x * v[j].x + v[j].y * v[j].y) + (v[j].z * v[j].z + v[j].w * v[j].w); }
        const float rs = rsqrtf(wave_sum(s) * (1.0f / DM) + EPS);
#pragma unroll
        for (int l = 0; l < 2; ++l) { u32x2* o = (u32x2*)(MEMN + ((size_t)l * NB * NMEM + r) * DM) + lane;
#pragma unroll
            for (int j = 0; j < 4; ++j) { const f32x4 g = *((const f32x4*)(a.mem_norm + l * DM) + lane + 64 * j); u32x2 w; w.x = pk2(v[j].x * rs * g.x, v[j].y * rs * g.y); w.y = pk2(v[j].z * rs * g.z, v[j].w * rs * g.w); o[64 * j] = w; } }
    }
    float* ROPE = (float*)(a.ws + WS_ROPE);
    for (int idx = blockIdx.x * NTHREADS + threadIdx.x; idx < M * 8; idx += gridDim.x * NTHREADS) {
        const int m = idx >> 3, i = idx & 7; const float ang = (float)a.positions[m] * c_inv_freq[i];
        const double t = (double)ang * 0.15915494309189533577; const float fr = (float)(t - floor(t));
        ROPE[m * 16 + i] = __builtin_amdgcn_cosf(fr); ROPE[m * 16 + 8 + i] = __builtin_amdgcn_sinf(fr);
    }
}

__device__ __forceinline__ void s_inproj_a(const Args& a, LAS float* sm) {
    const bf16* XB = (const bf16*)(a.ws + WS_XB); const float* SS0 = (const float*)(a.ws + WS_SS0); bf16* Z = (bf16*)(a.ws + WS_Z); float* GLR = (float*)(a.ws + WS_GLR);
    const float* W = a.w_in_a; const float* g = a.mix_norm;
    simple_gemm<false>(sm, M, WINA, DM,
        [&](int m, int k) { return bf2f(XB[(size_t)m * DM + k]) * g[k]; },
        [&](int k, int n, int) { return W[(size_t)k * WINA + n]; }, [&](int, int, int) { return 0.f; },
        [&](int m, int n, float acc, float) { const float v = acc * rsqrtf(SS0[m] * (1.0f / DM) + EPS);
            if (n < 384) Z[(size_t)m * NA + ZA_Q + n] = (bf16)f2bf(v * 0.10206207261596575f);
            else if (n < 768) Z[(size_t)m * NA + ZA_K + (n - 384)] = (bf16)f2bf(v);
            else if (n < 1536) Z[(size_t)m * NA + ZA_V + (n - 768)] = (bf16)f2bf(v);
            else if (n < 1552) GLR[m * 16 + (n - 1536)] = v;
            else if (n < 2320) Z[(size_t)m * NA + ZA_R + (n - 1552)] = (bf16)f2bf(v);
            else Z[(size_t)m * NA + ZA_QM + (n - 2320)] = (bf16)f2bf(v * 0.125f); });
}
__device__ __forceinline__ void s_memkv(const Args& a, LAS float* sm) {
    const bf16* MEMN = (const bf16*)(a.ws + WS_MEMN); bf16* MEMKV = (bf16*)(a.ws + WS_MEMKV);
    for (int l = 0; l < 2; ++l) { const float* W = a.w_mem_kv + (size_t)l * DM * 512; const bf16* A = MEMN + (size_t)l * NB * NMEM * DM; bf16* O = MEMKV + (size_t)l * NB * NMEM * 512;
        simple_gemm<false>(sm, NB * NMEM, 512, DM, [&](int m, int k) { return bf2f(A[(size_t)m * DM + k]); }, [&](int k, int n, int) { return W[(size_t)k * 512 + n]; }, [&](int, int, int) { return 0.f; },
            [&](int m, int n, float acc, float) { O[(size_t)m * 512 + n] = (bf16)f2bf(acc); }); }
}
__device__ __forceinline__ void s_gla_alpha(const Args& a) {
    const float* GLR = (const float*)(a.ws + WS_GLR); float* ALPHA = (float*)(a.ws + GK_ALPHA);
    for (int idx = blockIdx.x * NTHREADS + threadIdx.x; idx < M * 384; idx += gridDim.x * NTHREADS) {
        const int m = idx / 384, c = idx % 384; float lg = a.gla_gate_b[c];
#pragma unroll
        for (int j = 0; j < 16; ++j) lg += GLR[m * 16 + j] * a.gla_gate_w[j * 384 + c];
        const float ls = fminf(lg, 0.f) - log1pf(__expf(-fabsf(lg)));
        ALPHA[idx] = __expf(ls * (1.0f / 16.0f));
    }
}
__device__ __forceinline__ void s_gla_rec(const Args& a) {
    const bf16* Z = (const bf16*)(a.ws + WS_Z); const float* ALPHA = (const float*)(a.ws + GK_ALPHA); float* ORAW = (float*)(a.ws + GK_ORAW);
    for (int item = blockIdx.x; item < NB * GH * 12; item += gridDim.x) {
        const int bh = item / 12, dvg = item % 12, b = bh / GH, h = bh % GH;
        if (threadIdx.x < 64) { const int dv = dvg * 16 + (threadIdx.x & 15), cp = threadIdx.x >> 4, c0 = cp * 24;
            float S[24];
#pragma unroll
            for (int c = 0; c < 24; ++c) S[c] = 0.f;
            for (int t = 0; t < SEQ; ++t) { const size_t m = (size_t)b * SEQ + t; const bf16* zr = Z + m * NA; const float* ar = ALPHA + m * 384 + h * GDK + c0;
                const float vv = bf2f(zr[ZA_V + h * GDV + dv]); float o = 0.f;
#pragma unroll
                for (int c = 0; c < 24; ++c) { S[c] = ar[c] * S[c] + bf2f(zr[ZA_K + h * GDK + c0 + c]) * vv; o += bf2f(zr[ZA_Q + h * GDK + c0 + c]) * S[c]; }
                o += __shfl_xor(o, 16); o += __shfl_xor(o, 32);
                if (cp == 0) ORAW[m * MAINW + h * GDV + dv] = o; }
        }
    }
}
__device__ __forceinline__ void s_gla_out(const Args& a) {
    const int lane = threadIdx.x & 63, gw = blockIdx.x * NWAVES + (threadIdx.x >> 6), NGW = gridDim.x * NWAVES;
    const bf16* Z = (const bf16*)(a.ws + WS_Z); const float* ORAW = (const float*)(a.ws + GK_ORAW); bf16* MIX = (bf16*)(a.ws + WS_MIX);
    for (int it = gw; it < M * GH; it += NGW) { const int m = it / GH, h = it % GH; float o[3]; float s = 0.f;
#pragma unroll
        for (int j = 0; j < 3; ++j) { o[j] = ORAW[(size_t)m * MAINW + h * GDV + lane + 64 * j]; s += o[j] * o[j]; }
        const float rs = rsqrtf(wave_sum(s) * (1.0f / GDV) + EPS);
#pragma unroll
        for (int j = 0; j < 3; ++j) { const int dv = lane + 64 * j; const float r = bf2f(Z[(size_t)m * NA + ZA_R + h * GDV + dv]);
            MIX[(size_t)m * DM + h * GDV + dv] = (bf16)f2bf(o[j] * rs * a.gla_out_norm[dv] * silu_f(r)); } }
}
__device__ __forceinline__ void s_memattn(const Args& a, int layer, int ldz, int qoff) {
    const int lane = threadIdx.x & 63, gw = blockIdx.x * NWAVES + (threadIdx.x >> 6), NGW = gridDim.x * NWAVES;
    const bf16* Z = (const bf16*)(a.ws + WS_Z); const bf16* KV = (const bf16*)(a.ws + WS_MEMKV) + (size_t)layer * NB * NMEM * 512; bf16* MIX = (bf16*)(a.ws + WS_MIX);
    for (int it = gw; it < M * MEMH; it += NGW) { const int m = it / MEMH, h = it % MEMH, b = m / SEQ; const bf16* q = Z + (size_t)m * ldz + qoff + h * HD;
        float s[4];
#pragma unroll
        for (int i = 0; i < 4; ++i) { const bf16* kr = KV + ((size_t)b * NMEM + lane + 64 * i) * 512 + h * HD; float d = 0.f;
            for (int e = 0; e < HD; ++e) d += bf2f(q[e]) * bf2f(kr[e]);
            s[i] = d; }
        const float mx = wave_max(fmaxf(fmaxf(s[0], s[1]), fmaxf(s[2], s[3]))); float p[4], ps = 0.f;
#pragma unroll
        for (int i = 0; i < 4; ++i) { p[i] = __expf(s[i] - mx); ps += p[i]; }
        const float den = wave_sum(ps); float acc = 0.f;
#pragma unroll
        for (int i = 0; i < 4; ++i) for (int jl = 0; jl < 64; ++jl) acc += __shfl(p[i], jl) * bf2f(KV[((size_t)b * NMEM + jl + 64 * i) * 512 + 256 + h * HD + lane]);
        MIX[(size_t)m * DM + MAINW + h * HD + lane] = (bf16)f2bf(acc / den); }
}
__device__ __forceinline__ void s_swa(const Args& a) {
    const int lane = threadIdx.x & 63, gw = blockIdx.x * NWAVES + (threadIdx.x >> 6), NGW = gridDim.x * NWAVES;
    const bf16* Z = (const bf16*)(a.ws + WS_Z); bf16* MIX = (bf16*)(a.ws + WS_MIX);
    for (int it = gw; it < M * SWH; it += NGW) { const int m = it / SWH, hq = it % SWH, t = m % SEQ, kvh = hq / 3; const bf16* q = Z + (size_t)m * WINB + ZB_Q + hq * HD;
        float s[2]; bool ok[2];
#pragma unroll
        for (int i = 0; i < 2; ++i) { const int off = lane + 64 * i; ok[i] = (t - off) >= 0; const bf16* kr = Z + (size_t)(ok[i] ? m - off : m) * WINB + ZB_K + kvh * HD; float d = 0.f;
            for (int e = 0; e < HD; ++e) d += bf2f(q[e]) * bf2f(kr[e]);
            s[i] = ok[i] ? d : -INFINITY; }
        const float sink = a.swa_sinks[hq]; const float mx = fmaxf(wave_max(fmaxf(s[0], s[1])), sink); float p[2];
#pragma unroll
        for (int i = 0; i < 2; ++i) p[i] = ok[i] ? __expf(s[i] - mx) : 0.f;
        const float den = wave_sum(p[0] + p[1]) + __expf(sink - mx); float acc = 0.f;
#pragma unroll
        for (int i = 0; i < 2; ++i) for (int jl = 0; jl < 64; ++jl) { const int off = jl + 64 * i; const float pj = __shfl(p[i], jl); const size_t mr = (t - off) >= 0 ? (size_t)(m - off) : (size_t)m;
            acc += pj * bf2f(Z[mr * WINB + ZB_V + kvh * HD + lane]); }
        MIX[(size_t)m * DM + hq * HD + lane] = (bf16)f2bf(acc / den); }
}
__device__ __forceinline__ void s_outproj(const Args& a, LAS float* sm, int layer, const float* xin) {
    const bf16* MIX = (const bf16*)(a.ws + WS_MIX); const float* W = a.w_out + (size_t)layer * DM * DM; float* X = a.out;
    simple_gemm<false>(sm, M, DM, DM, [&](int m, int k) { return bf2f(MIX[(size_t)m * DM + k]); }, [&](int k, int n, int) { return W[(size_t)k * DM + n]; }, [&](int, int, int) { return 0.f; },
        [&](int m, int n, float acc, float) { X[(size_t)m * DM + n] = xin[(size_t)m * DM + n] + acc; });
}
__device__ __forceinline__ void s_xb_ss(const Args& a, float* SS) {
    const int lane = threadIdx.x & 63, gw = blockIdx.x * NWAVES + (threadIdx.x >> 6), NGW = gridDim.x * NWAVES; bf16* XB = (bf16*)(a.ws + WS_XB);
    for (int m = gw; m < M; m += NGW) { const f32x4* xr = (const f32x4*)(a.out + (size_t)m * DM) + lane; f32x4 v[4]; float s = 0.f;
#pragma unroll
        for (int j = 0; j < 4; ++j) { v[j] = xr[64 * j]; s += (v[j].x * v[j].x + v[j].y * v[j].y) + (v[j].z * v[j].z + v[j].w * v[j].w); }
        s = wave_sum(s); u32x2* o = (u32x2*)(XB + (size_t)m * DM) + lane;
#pragma unroll
        for (int j = 0; j < 4; ++j) { u32x2 w; w.x = pk2(v[j].x, v[j].y); w.y = pk2(v[j].z, v[j].w); o[64 * j] = w; }
        if (lane == 0) SS[m] = s; }
}
__device__ __forceinline__ void s_ffn_gu(const Args& a, LAS float* sm) {
    const bf16* XB = (const bf16*)(a.ws + WS_XB); const float* SS = (const float*)(a.ws + CTL_SS1); bf16* ACT = (bf16*)(a.ws + GK_ACTF); const float* W = a.ffn_w_gate_up; const float* g = a.ffn_norm;
    simple_gemm<true>(sm, M, DFF, DM, [&](int m, int k) { return bf2f(XB[(size_t)m * DM + k]) * g[k]; },
        [&](int k, int n, int) { return W[(size_t)k * 2 * DFF + n]; }, [&](int k, int n, int) { return W[(size_t)k * 2 * DFF + DFF + n]; },
        [&](int m, int n, float gg, float uu) { const float rs = rsqrtf(SS[m] * (1.0f / DM) + EPS); ACT[(size_t)m * DFF + n] = (bf16)f2bf(silu_f(gg * rs) * (uu * rs)); });
}
__device__ __forceinline__ void s_ffn_dn(const Args& a, LAS float* sm) {
    const bf16* ACT = (const bf16*)(a.ws + GK_ACTF); const float* W = a.ffn_w_down; float* X = a.out;
    simple_gemm<false>(sm, M, DM, DFF, [&](int m, int k) { return bf2f(ACT[(size_t)m * DFF + k]); }, [&](int k, int n, int) { return W[(size_t)k * DM + n]; }, [&](int, int, int) { return 0.f; },
        [&](int m, int n, float acc, float) { X[(size_t)m * DM + n] += acc; });
}
__device__ __forceinline__ void s_inproj_b(const Args& a, LAS float* sm) {
    const bf16* XB = (const bf16*)(a.ws + WS_XB); const float* SS = (const float*)(a.ws + CTL_SS2); float* ZF = (float*)(a.ws + GK_ZF); const float* W = a.w_in_b; const float* g = a.mix_norm + DM;
    simple_gemm<false>(sm, M, WINB, DM, [&](int m, int k) { return bf2f(XB[(size_t)m * DM + k]) * g[k]; }, [&](int k, int n, int) { return W[(size_t)k * WINB + n]; }, [&](int, int, int) { return 0.f; },
        [&](int m, int n, float acc, float) { float v = acc * rsqrtf(SS[m] * (1.0f / DM) + EPS); if (n < ZB_K || n >= ZB_QM) v *= 0.125f; ZF[(size_t)m * WINB + n] = v; });
}
__device__ __forceinline__ void s_rope(const Args& a) {
    const float* ZF = (const float*)(a.ws + GK_ZF); const float* ROPE = (const float*)(a.ws + WS_ROPE); bf16* Z = (bf16*)(a.ws + WS_Z);
    for (size_t idx = (size_t)blockIdx.x * NTHREADS + threadIdx.x; idx < (size_t)M * WINB; idx += (size_t)gridDim.x * NTHREADS) {
        const int m = (int)(idx / WINB), n = (int)(idx % WINB); float v = ZF[idx];
        if (n < ZB_V) { const int d = n & 63; if (d < 16) { const int i = d & 7; const float c = ROPE[m * 16 + i], s = ROPE[m * 16 + 8 + i];
            v = (d < 8) ? v * c - ZF[idx + 8] * s : v * c + ZF[idx - 8] * s; } }
        Z[idx] = (bf16)f2bf(v); }
}
__device__ __forceinline__ void route_top2(const Args& a, LAS unsigned* scnt) {
    const int lane = threadIdx.x & 63, wave = threadIdx.x >> 6;
    int* TOPI = (int*)(a.ws + RT_TOPI); float* TOPG = (float*)(a.ws + RT_TOPG); float* RS3 = (float*)(a.ws + RT_RS3); int* BCNT = (int*)(a.ws + RT_BCNT);
    const float* g = a.ffn_norm + DM; const float* RW = a.router_w;
    for (int vb = blockIdx.x; vb < 256; vb += gridDim.x) {
        if (threadIdx.x < 8) scnt[threadIdx.x] = 0u;
        __syncthreads();
        for (int i = 0; i < 16; ++i) { const int m = vb * 128 + wave * 16 + i; const f32x4* xr = (const f32x4*)(a.out + (size_t)m * DM) + lane;
            float lg[8]; float ss = 0.f;
#pragma unroll
            for (int e = 0; e < 8; ++e) lg[e] = 0.f;
#pragma unroll
            for (int j = 0; j < 4; ++j) { const f32x4 v = xr[64 * j]; const f32x4 gg = *((const f32x4*)g + lane + 64 * j); ss += (v.x * v.x + v.y * v.y) + (v.z * v.z + v.w * v.w);
#pragma unroll
                for (int c = 0; c < 4; ++c) { const float xv = v[c] * gg[c]; const f32x4* wr = (const f32x4*)(RW + (size_t)(4 * (lane + 64 * j) + c) * 8); const f32x4 w0 = wr[0], w1 = wr[1];
                    lg[0] += xv * w0.x; lg[1] += xv * w0.y; lg[2] += xv * w0.z; lg[3] += xv * w0.w; lg[4] += xv * w1.x; lg[5] += xv * w1.y; lg[6] += xv * w1.z; lg[7] += xv * w1.w; } }
            ss = wave_sum(ss); const float rs = rsqrtf(ss * (1.0f / DM) + EPS);
#pragma unroll
            for (int e = 0; e < 8; ++e) lg[e] = wave_sum(lg[e]) * rs;
            int i0 = 0; float v0 = lg[0];
#pragma unroll
            for (int e = 1; e < 8; ++e) if (lg[e] > v0) { v0 = lg[e]; i0 = e; }
            int i1 = -1; float v1 = -INFINITY;
#pragma unroll
            for (int e = 0; e < 8; ++e) if (e != i0 && lg[e] > v1) { v1 = lg[e]; i1 = e; }
            const float g0 = 1.0f / (1.0f + __expf(v1 - v0));
            if (lane == 0) { TOPI[2 * m] = i0; TOPI[2 * m + 1] = i1; TOPG[2 * m] = g0; TOPG[2 * m + 1] = 1.0f - g0; RS3[m] = rs; __hip_atomic_fetch_add(&scnt[i0], 1u, __ATOMIC_RELAXED, __HIP_MEMORY_SCOPE_WORKGROUP); __hip_atomic_fetch_add(&scnt[i1], 1u, __ATOMIC_RELAXED, __HIP_MEMORY_SCOPE_WORKGROUP); }
        }
        __syncthreads();
        if (threadIdx.x < 8) BCNT[vb * 8 + threadIdx.x] = (int)scnt[threadIdx.x];
        __syncthreads();
    }
}
__device__ __forceinline__ void route_build(const Args& a, LAS unsigned* sc) {
    const int tid = threadIdx.x, lane = tid & 63, wave = tid >> 6;
    const int* TOPI = (const int*)(a.ws + RT_TOPI); const float* TOPG = (const float*)(a.ws + RT_TOPG); const float* RS3 = (const float*)(a.ws + RT_RS3); const int* BCNT = (const int*)(a.ws + RT_BCNT);
    int* POS = (int*)(a.ws + RT_POS); int* ROWTOK = (int*)(a.ws + RT_ROWTOK); float* ROWGATE = (float*)(a.ws + RT_ROWGATE); float* ROWRS = (float*)(a.ws + RT_ROWRS); int* TILEE = (int*)(a.ws + RT_TILEE);
    const bf16* XB = (const bf16*)(a.ws + WS_XB); bf16* XG = (bf16*)(a.ws + WS_XG);
    for (int vb = blockIdx.x; vb < 256; vb += gridDim.x) {
        __syncthreads();
        if (tid < 8) { int tot = 0, pre = 0; for (int b = 0; b < 256; ++b) { const int c = BCNT[b * 8 + tid]; tot += c; if (b < vb) pre += c; } sc[tid] = (unsigned)tot; sc[16 + tid] = (unsigned)pre; }
        __syncthreads();
        if (tid == 0) { unsigned base = 0; for (int e = 0; e < 8; ++e) { sc[8 + e] = base; base += (sc[e] + 255u) & ~255u; } sc[24] = base; }
        __syncthreads();
        if (tid < 8) {
            unsigned r = sc[8 + tid] + sc[16 + tid];
            for (int i = 0; i < 128; ++i) { const int m = vb * 128 + i;
                if (TOPI[2 * m] == tid) { sc[32 + 2 * i] = r++; } else if (TOPI[2 * m + 1] == tid) { sc[32 + 2 * i + 1] = r++; } }
        }
        __syncthreads();
        if (tid < 256) { const int i = tid >> 1, s = tid & 1, m = vb * 128 + i; const int row = (int)sc[32 + tid]; POS[2 * m + s] = row; ROWTOK[row] = m; ROWGATE[row] = TOPG[2 * m + s]; ROWRS[row] = RS3[m]; }
        for (int p = wave; p < 256; p += NWAVES) { const int i = p >> 1, m = vb * 128 + i; const int row = (int)sc[32 + p];
            const u32x4* src = (const u32x4*)(XB + (size_t)m * DM); u32x4* dst = (u32x4*)(XG + (size_t)row * DM); dst[lane] = src[lane]; dst[lane + 64] = src[lane + 64]; }
        if (vb == 0) {
            if (tid < 8) { const unsigned b0 = sc[8 + tid], cnt = sc[tid], pe = (cnt + 255u) & ~255u; for (unsigned t = 0; t < pe / 256u; ++t) TILEE[b0 / 256u + t] = tid; }
            if (tid == 0) TILEE[MAXRT] = (int)(sc[24] / 256u);
            for (int e = 0; e < 8; ++e) { const unsigned b0 = sc[8 + e], cnt = sc[e], pe = (cnt + 255u) & ~255u; for (unsigned r = b0 + cnt + tid; r < b0 + pe; r += NTHREADS) { ROWTOK[r] = -1; ROWGATE[r] = 0.f; ROWRS[r] = 0.f; } }
        }
    }
}
__device__ __forceinline__ void s_moe_gu(const Args& a, LAS float* sm) {
    const bf16* XG = (const bf16*)(a.ws + WS_XG); const int* ROWTOK = (const int*)(a.ws + RT_ROWTOK); const float* ROWRS = (const float*)(a.ws + RT_ROWRS); const int* TILEE = (const int*)(a.ws + RT_TILEE);
    bf16* ACT = (bf16*)(a.ws + WS_ACTM); const float* W = a.exp_w_gate_up; const float* g = a.ffn_norm + DM; const int nrows = TILEE[MAXRT] * 256;
    simple_gemm<true>(sm, nrows, DFE, DM, [&](int m, int k) { return ROWTOK[m] >= 0 ? bf2f(XG[(size_t)m * DM + k]) * g[k] : 0.f; },
        [&](int k, int n, int m0) { return W[((size_t)TILEE[m0 >> 8] * DM + k) * 2 * DFE + n]; }, [&](int k, int n, int m0) { return W[((size_t)TILEE[m0 >> 8] * DM + k) * 2 * DFE + DFE + n]; },
        [&](int m, int n, float gg, float uu) { const float rs = ROWRS[m]; ACT[(size_t)m * DFE + n] = (bf16)f2bf(silu_f(gg * rs) * (uu * rs)); });
}
__device__ __forceinline__ void s_moe_dn(const Args& a, LAS float* sm) {
    const bf16* ACT = (const bf16*)(a.ws + WS_ACTM); const float* ROWGATE = (const float*)(a.ws + RT_ROWGATE); const int* TILEE = (const int*)(a.ws + RT_TILEE);
    bf16* Y = (bf16*)(a.ws + WS_XG); const float* W = a.exp_w_down; const int nrows = TILEE[MAXRT] * 256;
    simple_gemm<false>(sm, nrows, DM, DFE, [&](int m, int k) { return bf2f(ACT[(size_t)m * DFE + k]); }, [&](int k, int n, int m0) { return W[((size_t)TILEE[m0 >> 8] * DFE + k) * DM + n]; }, [&](int, int, int) { return 0.f; },
        [&](int m, int n, float acc, float) { Y[(size_t)m * DM + n] = (bf16)f2bf(acc * ROWGATE[m]); });
}
__device__ __forceinline__ void final_rows(const Args& a) {
    const int lane = threadIdx.x & 63, gw = blockIdx.x * NWAVES + (threadIdx.x >> 6), NGW = gridDim.x * NWAVES; const bf16* Y = (const bf16*)(a.ws + WS_XG); const int* POS = (const int*)(a.ws + RT_POS);
    for (int m = gw; m < M; m += NGW) { f32x4* xr = (f32x4*)(a.out + (size_t)m * DM) + lane; const u32x2* y0 = (const u32x2*)(Y + (size_t)POS[2 * m] * DM) + lane; const u32x2* y1 = (const u32x2*)(Y + (size_t)POS[2 * m + 1] * DM) + lane;
        f32x4 v[4]; float s = 0.f;
#pragma unroll
        for (int j = 0; j < 4; ++j) { v[j] = xr[64 * j]; const u32x2 p = y0[64 * j], q = y1[64 * j];
            v[j].x += __uint_as_float(p.x << 16) + __uint_as_float(q.x << 16); v[j].y += __uint_as_float(p.x & 0xffff0000u) + __uint_as_float(q.x & 0xffff0000u);
            v[j].z += __uint_as_float(p.y << 16) + __uint_as_float(q.y << 16); v[j].w += __uint_as_float(p.y & 0xffff0000u) + __uint_as_float(q.y & 0xffff0000u);
            s += (v[j].x * v[j].x + v[j].y * v[j].y) + (v[j].z * v[j].z + v[j].w * v[j].w); }
        const float rs = rsqrtf(wave_sum(s) * (1.0f / DM) + EPS);
#pragma unroll
        for (int j = 0; j < 4; ++j) { const f32x4 g = *((const f32x4*)a.final_norm + lane + 64 * j); xr[64 * j] = (f32x4){v[j].x * rs * g.x, v[j].y * rs * g.y, v[j].z * rs * g.z, v[j].w * rs * g.w}; } }
}

constexpr int NSTEPS = 21;
__global__ void __launch_bounds__(NTHREADS, 2) fwd(Args args) {
    extern __shared__ __attribute__((aligned(16))) unsigned char lds_raw[];
    LAS unsigned char* lds = (LAS unsigned char*)lds_raw;
    LAS float* smf = (LAS float*)lds;
    volatile LAS unsigned* MISC = (volatile LAS unsigned*)(lds + MISC_OFF);
    for (int u = threadIdx.x; u < (LDS_BYTES - 131072) / 4; u += NTHREADS) ((LAS unsigned*)(lds + 131072))[u] = 0u;
    __syncthreads();
    unsigned* barw = (unsigned*)(args.ws + WS_CTL) + CW_BAR;
    XcdBarrier bar; bar.bar = barw; bar.x = 0; bar.st = nullptr;
    const int lo = args.lo, hi = args.hi;
    if (hi - lo > 1) bar = xcd_barrier_post(barw, MISC + 8);
#define RUN(s) (lo <= (s) && (s) < hi)
#define SEAM(s) do { if ((s) + 1 < hi) xcd_barrier(bar); } while (0)
    LAS unsigned* sc = (LAS unsigned*)(lds + 65536);

    if (RUN(0)) { prep_rows(args); SEAM(0); }
    if (RUN(1)) { s_inproj_a(args, smf); s_memkv(args, smf); SEAM(1); }
    if (RUN(2)) { s_gla_alpha(args); SEAM(2); }
    if (RUN(3)) { s_gla_rec(args); SEAM(3); }
    if (RUN(4)) { s_gla_out(args); s_memattn(args, 0, NA, ZA_QM); SEAM(4); }
    if (RUN(5)) { s_outproj(args, smf, 0, args.x); SEAM(5); }
    if (RUN(6)) { s_xb_ss(args, (float*)(args.ws + CTL_SS1)); SEAM(6); }
    if (RUN(7)) { s_ffn_gu(args, smf); SEAM(7); }
    if (RUN(8)) { s_ffn_dn(args, smf); SEAM(8); }
    if (RUN(9)) { s_xb_ss(args, (float*)(args.ws + CTL_SS2)); SEAM(9); }
    if (RUN(10)) { s_inproj_b(args, smf); SEAM(10); }
    if (RUN(11)) { s_rope(args); SEAM(11); }
    if (RUN(12)) { s_swa(args); s_memattn(args, 1, WINB, ZB_QM); SEAM(12); }
    if (RUN(13)) { s_outproj(args, smf, 1, args.out); SEAM(13); }
    if (RUN(14)) { s_xb_ss(args, (float*)(args.ws + CTL_SS3)); SEAM(14); }
    if (RUN(15)) { route_top2(args, sc); SEAM(15); }
    if (RUN(16)) { route_build(args, sc); SEAM(16); }
    if (RUN(18)) { s_moe_gu(args, smf); SEAM(18); }
    if (RUN(19)) { s_moe_dn(args, smf); SEAM(19); }
    if (RUN(20)) { final_rows(args); }
#undef RUN
#undef SEAM
}

extern "C" void kernel_launch(void* const* d_in, const int* in_sizes, int n_in, void* d_out, int out_size, void* d_ws, size_t ws_size, hipStream_t stream) {
    static int grid = 0;
    if (grid == 0) {
        if (n_in != 20 || out_size != M * DM || ws_size < WS_END) { fprintf(stderr, "kernel_launch: unexpected shapes (n_in %d, out %d, ws %zu < %zu); nothing launched\n", n_in, out_size, ws_size, (size_t)WS_END); grid = -1; return; }
        int dev = 0, cus = 0, per_cu = 0;
        if (hipGetDevice(&dev) != hipSuccess || hipDeviceGetAttribute(&cus, hipDeviceAttributeMultiprocessorCount, dev) != hipSuccess) { grid = -1; return; }
        if (hipFuncSetAttribute((const void*)fwd, hipFuncAttributeMaxDynamicSharedMemorySize, LDS_BYTES) != hipSuccess) { fprintf(stderr, "kernel_launch: hipFuncSetAttribute failed\n"); grid = -1; return; }
        if (hipOccupancyMaxActiveBlocksPerMultiprocessor(&per_cu, (const void*)fwd, NTHREADS, LDS_BYTES) != hipSuccess || per_cu < 1) { fprintf(stderr, "kernel_launch: occupancy query says %d\n", per_cu); }
        (void)hipGetLastError();
        grid = cus;
    }
    if (grid < 0) return;
    if (hipMemsetAsync((char*)d_ws + WS_CTL, 0, CTL_ZERO_BYTES, stream) != hipSuccess) return;
    Args a{};
    a.x = (const float*)d_in[0]; a.mem = (const float*)d_in[1]; a.positions = (const int*)d_in[2]; a.mix_norm = (const float*)d_in[3]; a.w_in_a = (const float*)d_in[4];
    a.gla_gate_w = (const float*)d_in[5]; a.gla_gate_b = (const float*)d_in[6]; a.gla_out_norm = (const float*)d_in[7]; a.w_in_b = (const float*)d_in[8]; a.swa_sinks = (const float*)d_in[9];
    a.mem_norm = (const float*)d_in[10]; a.w_mem_kv = (const float*)d_in[11]; a.w_out = (const float*)d_in[12]; a.ffn_norm = (const float*)d_in[13]; a.ffn_w_gate_up = (const float*)d_in[14];
    a.ffn_w_down = (const float*)d_in[15]; a.router_w = (const float*)d_in[16]; a.exp_w_gate_up = (const float*)d_in[17]; a.exp_w_down = (const float*)d_in[18]; a.final_norm = (const float*)d_in[19];
    a.out = (float*)d_out; a.ws = (unsigned char*)d_ws; a.li = 0; a.pad = 0;
#if N_LAUNCH_MODE == 1
    a.lo = 0; a.hi = NSTEPS;
    hipLaunchKernelGGL(fwd, dim3(grid), dim3(NTHREADS), LDS_BYTES, stream, a);
#else
    for (int s = 0; s < NSTEPS; ++s) { if (s == 17) continue; a.lo = s; a.hi = s + 1; hipLaunchKernelGGL(fwd, dim3(grid), dim3(NTHREADS), LDS_BYTES, stream, a); }
#endif
}
```

```cpp
#include <hip/hip_runtime.h>
#include <cstdio>
#include <cstdint>

#ifndef N_LAUNCH_MODE
#define N_LAUNCH_MODE 1
#endif
#ifndef PROBE_REPEAT_MASK
#define PROBE_REPEAT_MASK 0u
#endif
#ifndef FASTMASK
#define FASTMASK 0xC35B7u
#endif

#define LAS __attribute__((address_space(3)))
#define GAS __attribute__((address_space(1)))
typedef unsigned short bf16;
typedef float f32x4 __attribute__((ext_vector_type(4)));
typedef float f32x2 __attribute__((ext_vector_type(2)));
typedef unsigned u32x4 __attribute__((ext_vector_type(4)));
typedef unsigned u32x2 __attribute__((ext_vector_type(2)));
typedef short bf16x8 __attribute__((ext_vector_type(8)));

constexpr int NB = 4, SEQ = 8192, DM = 1024, M = NB * SEQ;
constexpr int NMEM = 256, HD = 64, MEMH = 4, MEMW = 256, MAINW = 768;
constexpr int GH = 4, GDV = 192, GDK = 96, GLRK = 16, GCH = 64, NCH = SEQ / GCH;
constexpr int SWH = 12, SWKV = 4, WIN = 128;
constexpr int DFF = 2816, NE = 8, DFE = 3584;
constexpr int WINA = 2576, WINB = 1536;
constexpr int NA = 2560;
constexpr int ZA_Q = 0, ZA_K = 384, ZA_V = 768, ZA_R = 1536, ZA_QM = 2304;
constexpr int ZB_Q = 0, ZB_K = 768, ZB_V = 1024, ZB_QM = 1280;
constexpr float EPS = 1e-6f;
constexpr float LOG2E = 1.4426950408889634f, QS = 0.125f * LOG2E;
constexpr int MAXROWS = 67584;
constexpr int MAXRT = MAXROWS / 256;

constexpr size_t MiB = 1u << 20;
constexpr size_t WS_CTL = 0, CTL_ZERO_BYTES = 1 * MiB;
constexpr int CW_BAR = 4096;
constexpr size_t CTL_SS1 = 128 * 1024, CTL_SS2 = 256 * 1024, CTL_SS3 = 384 * 1024;
constexpr size_t WS_SS0 = 1 * MiB;
constexpr size_t GK_DEC = 1 * MiB + 256 * 1024;
constexpr size_t WS_GLR = 2 * MiB;
constexpr size_t WS_ROPE = 4 * MiB;
constexpr size_t WS_MEMKV = 6 * MiB;
constexpr size_t WS_MEMN = 8 * MiB;
constexpr size_t WS_ROUTE = 12 * MiB;
constexpr size_t RT_TOPI = WS_ROUTE;
constexpr size_t RT_TOPG = RT_TOPI + 256 * 1024;
constexpr size_t RT_POS = RT_TOPG + 256 * 1024;
constexpr size_t RT_RS3 = RT_POS + 256 * 1024;
constexpr size_t RT_ROWTOK = RT_RS3 + 128 * 1024;
constexpr size_t RT_ROWGATE = RT_ROWTOK + 272 * 1024;
constexpr size_t RT_ROWRS = RT_ROWGATE + 272 * 1024;
constexpr size_t RT_BCNT = RT_ROWRS + 272 * 1024;
constexpr size_t RT_TILEE = RT_BCNT + 8 * 1024;
static_assert(RT_TILEE + 4096 <= 16 * MiB, "route map");
constexpr size_t WT_INA = 16 * MiB, WT_INB = 21 * MiB, WT_MKV = 24 * MiB, WT_OUT = 26 * MiB, WT_FGU = 30 * MiB, WT_FDN = 41 * MiB, WT_EGU = 47 * MiB, WT_EDN = 159 * MiB;
constexpr size_t WS_Z = 216 * MiB;
constexpr size_t WS_XB = 376 * MiB;
constexpr size_t WS_MIX = 440 * MiB;
constexpr size_t WS_GK = 504 * MiB;
constexpr size_t WS_ACTM = 504 * MiB;
constexpr size_t WS_X8 = 440 * MiB;
constexpr size_t WS_XG = 736 * MiB;
constexpr size_t WS_SSP1 = 868 * MiB, WS_SSP2 = 870 * MiB;
constexpr size_t WS_END = 872 * MiB;
static_assert(WS_ACTM + (size_t)MAXROWS * DFE <= WS_XG, "ACT_MOE (fp8) fits");
constexpr size_t GK_KV = WS_GK;
constexpr size_t GK_ST = WS_GK + 144 * MiB;
constexpr size_t GK_ALPHA = WS_GK;
constexpr size_t GK_ORAW = WS_GK + 48 * MiB;
constexpr size_t GK_ACTF = WS_GK;
constexpr size_t GK_ZF = WS_GK;

constexpr int NWAVES = 8, NTHREADS = 512;
constexpr int LDS_BYTES = 147456;
constexpr int MISC_OFF = LDS_BYTES - 512;

__device__ __forceinline__ float bf2f(bf16 b) { return __uint_as_float(((unsigned)b) << 16); }
__device__ __forceinline__ unsigned f2bf(float f) { unsigned u = __float_as_uint(f); return (u + 0x7fffu + ((u >> 16) & 1u)) >> 16; }
__device__ __forceinline__ unsigned pk2(float lo, float hi) { return f2bf(lo) | (f2bf(hi) << 16); }
__device__ __forceinline__ float wave_sum(float v) {
#pragma unroll
    for (int o = 1; o < 64; o <<= 1) v += __shfl_xor(v, o);
    return v;
}
__device__ __forceinline__ float wave_max(float v) {
#pragma unroll
    for (int o = 1; o < 64; o <<= 1) v = fmaxf(v, __shfl_xor(v, o));
    return v;
}
__device__ __forceinline__ float silu_f(float x) { return x / (1.0f + __expf(-x)); }

#define XB_TMO      128
#define XB_XCNT(j)  (256  + 64 * (j))
#define XB_XSUB(j)  (1280 + 64 * (j))
#define XB_XGEN(j)  (2304 + 64 * (j))
#define XB_TOP      3328
#define XB_TOPGEN   3392
#define XCD_BAR_WORDS 3456
#define XB_SPIN_CAP (1u << 18)

__device__ __forceinline__ unsigned xb_ld(unsigned* p)              { return __hip_atomic_load(p, __ATOMIC_RELAXED, __HIP_MEMORY_SCOPE_AGENT); }
__device__ __forceinline__ unsigned xb_add(unsigned* p, unsigned v) { return __hip_atomic_fetch_add(p, v, __ATOMIC_RELAXED, __HIP_MEMORY_SCOPE_AGENT); }
__device__ __forceinline__ unsigned xb_xcc_id() { return (unsigned)__builtin_amdgcn_s_getreg((3 << 11) | 20) & 0xFu; }
#define XB_SPIN(cond, bar) do { unsigned _sp = 0; while (cond) { __builtin_amdgcn_s_sleep(1); \
    if ((++_sp & 255u) == 0u) { if (xb_ld(&(bar)[XB_TMO])) break; if (_sp > XB_SPIN_CAP) { atomicAdd(&(bar)[XB_TMO], 1u); break; } } } } while (0)

struct XcdBarrier {
    unsigned* bar; unsigned x;
    volatile LAS unsigned* st;
};

__device__ __forceinline__ XcdBarrier xcd_barrier_post(unsigned* bar, volatile LAS unsigned* st) {
    XcdBarrier b; b.bar = bar; b.x = xb_xcc_id(); b.st = st;
    if (threadIdx.x == 0) (void)xb_add(&bar[XB_XCNT(b.x)], 1u);
    return b;
}
__device__ __forceinline__ void xcd_barrier_complete(unsigned* bar, unsigned x, unsigned& nloc, unsigned& nx) {
    const unsigned G = gridDim.x * gridDim.y * gridDim.z;
    unsigned sum, cnt, mine, sp = 0u;
    for (;;) {
        sum = 0u; cnt = 0u; mine = 0u;
#pragma unroll
        for (unsigned j = 0; j < 16; ++j) { const unsigned c = xb_ld(&bar[XB_XCNT(j)]); sum += c; cnt += (c > 0u) ? 1u : 0u; mine = (j == x) ? c : mine; }
        if (sum == G) break;
        __builtin_amdgcn_s_sleep(1);
        if ((++sp & 255u) == 0u) { if (xb_ld(&bar[XB_TMO])) break; if (sp > XB_SPIN_CAP) { atomicAdd(&bar[XB_TMO], 1u); break; } }
    }
    nloc = mine > 0u ? mine : 1u; nx = cnt > 0u ? cnt : 1u;
}

__device__ __forceinline__ void xcd_barrier(const XcdBarrier& b) {
    asm volatile("s_waitcnt vmcnt(0)" ::: "memory");
    __syncthreads();
    if (threadIdx.x == 0) {
        unsigned* bar = b.bar;
        __builtin_amdgcn_s_waitcnt(0);
        unsigned nloc = b.st[0], nx = b.st[1];
        if (nloc == 0u) { xcd_barrier_complete(bar, b.x, nloc, nx); b.st[0] = nloc; b.st[1] = nx; }
        const unsigned old = xb_add(&bar[XB_XSUB(b.x)], 1u);
        const unsigned gen = old / nloc;
        if (old + 1u == (gen + 1u) * nloc) {
            __builtin_amdgcn_fence(__ATOMIC_RELEASE, "agent");
            asm volatile("s_waitcnt vmcnt(0)" ::: "memory");
            const unsigned og = xb_add(&bar[XB_TOP], 1u);
            const unsigned tg = og / nx;
            if (og + 1u == (tg + 1u) * nx) xb_add(&bar[XB_TOPGEN], 1u);
            else XB_SPIN(xb_ld(&bar[XB_TOPGEN]) == tg, bar);
            __builtin_amdgcn_fence(__ATOMIC_ACQUIRE, "agent");
            xb_add(&bar[XB_XGEN(b.x)], 1u);
            asm volatile("s_waitcnt vmcnt(0)" ::: "memory");
        } else {
            XB_SPIN(xb_ld(&bar[XB_XGEN(b.x)]) == gen, bar);
            __builtin_amdgcn_fence(__ATOMIC_ACQUIRE, "agent");
            asm volatile("s_waitcnt vmcnt(0)" ::: "memory");
        }
    }
    __syncthreads();
}

struct Args {
    const float* x; const float* mem; const int* positions; const float* mix_norm; const float* w_in_a; const float* gla_gate_w; const float* gla_gate_b; const float* gla_out_norm;
    const float* w_in_b; const float* swa_sinks; const float* mem_norm; const float* w_mem_kv; const float* w_out; const float* ffn_norm; const float* ffn_w_gate_up; const float* ffn_w_down;
    const float* router_w; const float* exp_w_gate_up; const float* exp_w_down; const float* final_norm;
    float* out; unsigned char* ws; int lo, hi, li, pad;
};


namespace pg8 {
#define PG8_LAS __attribute__((address_space(3)))
typedef unsigned short bf16_t;
typedef short bf16x8 __attribute__((ext_vector_type(8)));
typedef float f32x4 __attribute__((ext_vector_type(4)));
typedef unsigned u32x4 __attribute__((ext_vector_type(4)));
typedef int v8i32 __attribute__((ext_vector_type(8)));
constexpr int BM = 256, BK = 64, HALF = 128, HTB = HALF * BK * 2  , STAGE_BYTES = 8 * HTB, NXCD = 8, WGM = 8;

__host__ __device__ __forceinline__ int lds_byte(int r, int c) { const int st = (r >> 4) * 2 + (c >> 5), rr = r & 15, cc = c & 31, ob = rr * 64 + cc * 2; return st * 1024 + (ob ^ (((ob >> 9) & 1) << 5)); }
__host__ __device__ __forceinline__ void stage_rc(int b, int& R, int& C) { const int st = b / 1024, sb = b % 1024, swz = sb ^ (((sb >> 9) & 1) << 5); R = (st >> 1) * 16 + swz / 64; C = (st & 1) * 32 + (swz % 64) / 2; }
__host__ __device__ __forceinline__ int perm32(int rho) { const int n = rho >> 4, i = rho & 15; return 8 * (i >> 2) + 4 * n + (i & 3); }

struct Unit { int pm, pn, koff; };
struct Gemm { const bf16_t* A; const bf16_t* Bt; int M, N, K, ld; };

struct StaticOrder {
    static constexpr bool HAS_KOFF = false;
    int nM, nN, nwg, G, c, pb;
    __host__ __device__ void init(int M, int N, int G_, int c_, int pb_ = 0) { nM = M / BM; nN = N / BM; nwg = nM * nN; G = G_; c = c_; pb = pb_; }
    __host__ __device__ bool next(int i, Unit& u) const {
        const long L = (long)i * G + c; if (L >= nwg) return false;
        int wgid = (int)L; { const int q = nwg / NXCD, r = nwg % NXCD, xcd = wgid % NXCD, off = wgid / NXCD; wgid = (xcd < r ? xcd * (q + 1) : r * (q + 1) + (xcd - r) * q) + off; }
        if (pb > 0) { const int per = nM * pb, blk = wgid / per, q = wgid - blk * per, w = (nN - blk * pb) < pb ? (nN - blk * pb) : pb; u.pm = q / w; u.pn = blk * pb + q % w; return true; }
        const int nig = WGM * nN, gid = wgid / nig, fm = gid * WGM, gsz = (nM - fm) < WGM ? (nM - fm) : WGM;
        u.pm = fm + ((wgid % nig) % gsz); u.pn = (wgid % nig) / gsz; return true;
    }
    __device__ __forceinline__ void a_ready(const Unit&) const {}
    __device__ __forceinline__ void done(const Unit&) const {}
};


__device__ __forceinline__ unsigned cvt_pk_bf16(float lo, float hi) { unsigned r; asm volatile("v_cvt_pk_bf16_f32 %0, %1, %2" : "=v"(r) : "v"(lo), "v"(hi)); return r; }
__device__ __forceinline__ float fast_silu(float g) { return g * __builtin_amdgcn_rcpf(1.0f + __expf(-g)); }
__device__ __forceinline__ float swiglu2(float g, float u) { return (g * u) * __builtin_amdgcn_rcpf(1.0f + __builtin_amdgcn_exp2f(-g)); }

__device__ __forceinline__ unsigned pk4_fp8(float a, float b, float c, float d) {
    a = __builtin_amdgcn_fmed3f(a, -448.f, 448.f); b = __builtin_amdgcn_fmed3f(b, -448.f, 448.f); c = __builtin_amdgcn_fmed3f(c, -448.f, 448.f); d = __builtin_amdgcn_fmed3f(d, -448.f, 448.f);
    unsigned w = 0u; w = __builtin_amdgcn_cvt_pk_fp8_f32(a, b, w, false); w = __builtin_amdgcn_cvt_pk_fp8_f32(c, d, w, true); return w; }
__device__ __forceinline__ float rs_from16(const float* p) { const f32x4 a = *(const f32x4*)p, b = *(const f32x4*)(p + 4), c = *(const f32x4*)(p + 8), d = *(const f32x4*)(p + 12);
    const float t = (((a[0] + a[1]) + (a[2] + a[3])) + ((b[0] + b[1]) + (b[2] + b[3]))) + (((c[0] + c[1]) + (c[2] + c[3])) + ((d[0] + d[1]) + (d[2] + d[3]))); return rsqrtf(t * (1.0f / 1024.0f) + 1e-6f); }
template <int MODE> struct EpiScaleBf16 {
    static constexpr bool PERM = true, AFTER_DRAIN = false;
    bf16_t* O; int ldc; const float* sv; int pn_mod;
    __device__ __forceinline__ void operator()(const f32x4 (&acc)[2][2][4][2], const Unit& u, int wr, int wc, int fr, int fq) const {
        const int row0 = u.pm * BM + wr * 64 + fr, pn = pn_mod ? (u.pn % pn_mod) : u.pn, col0 = pn * BM + wc * 32 + 8 * fq;
#pragma unroll
        for (int ai = 0; ai < 2; ++ai)
#pragma unroll
            for (int m = 0; m < 4; ++m) { const int r = row0 + ai * HALF + m * 16; float sc = 1.0f;
                if (MODE == 1) sc = rsqrtf(sv[r] * (1.0f / 1024.0f) + 1e-6f);
                if (MODE == 2) sc = sv[r];
                if (MODE == 3) sc = rs_from16(sv + (size_t)r * 16);
                bf16_t* rowp = O + (size_t)r * ldc + col0;
#pragma unroll
                for (int bj = 0; bj < 2; ++bj) { const f32x4 v0 = acc[ai][bj][m][0] * sc, v1 = acc[ai][bj][m][1] * sc;
                    u32x4 w; w.x = cvt_pk_bf16(v0[0], v0[1]); w.y = cvt_pk_bf16(v0[2], v0[3]); w.z = cvt_pk_bf16(v1[0], v1[1]); w.w = cvt_pk_bf16(v1[2], v1[3]);
                    *(u32x4*)(rowp + bj * HALF) = w; } }
    }
};
template <bool WITH_SS, bool WITH_X8 = false> struct EpiResid {
    static constexpr bool PERM = true, AFTER_DRAIN = false;
    bf16_t* xb; float* ss; unsigned char* x8;
    __device__ __forceinline__ void operator()(const f32x4 (&acc)[2][2][4][2], const Unit& u, int wr, int wc, int fr, int fq) const {
        const int row0 = u.pm * BM + wr * 64 + fr, col0 = u.pn * BM + wc * 32 + 8 * fq;
        u32x4 old[2][4][2];
#pragma unroll
        for (int ai = 0; ai < 2; ++ai)
#pragma unroll
            for (int m = 0; m < 4; ++m)
#pragma unroll
                for (int bj = 0; bj < 2; ++bj) old[ai][m][bj] = *(const u32x4*)(xb + (size_t)(row0 + ai * HALF + m * 16) * 1024 + col0 + bj * HALF);
#pragma unroll
        for (int ai = 0; ai < 2; ++ai)
#pragma unroll
            for (int m = 0; m < 4; ++m) { const int r = row0 + ai * HALF + m * 16; bf16_t* rowp = xb + (size_t)r * 1024 + col0; float part = 0.f;
#pragma unroll
                for (int bj = 0; bj < 2; ++bj) { const u32x4 o = old[ai][m][bj]; f32x4 v0 = acc[ai][bj][m][0], v1 = acc[ai][bj][m][1];
                    v0[0] += __uint_as_float(o.x << 16); v0[1] += __uint_as_float(o.x & 0xffff0000u); v0[2] += __uint_as_float(o.y << 16); v0[3] += __uint_as_float(o.y & 0xffff0000u);
                    v1[0] += __uint_as_float(o.z << 16); v1[1] += __uint_as_float(o.z & 0xffff0000u); v1[2] += __uint_as_float(o.w << 16); v1[3] += __uint_as_float(o.w & 0xffff0000u);
                    u32x4 w; w.x = cvt_pk_bf16(v0[0], v0[1]); w.y = cvt_pk_bf16(v0[2], v0[3]); w.z = cvt_pk_bf16(v1[0], v1[1]); w.w = cvt_pk_bf16(v1[2], v1[3]);
                    *(u32x4*)(rowp + bj * HALF) = w;
                    if (WITH_X8) { typedef unsigned u32x2v __attribute__((ext_vector_type(2))); u32x2v w8; w8.x = pk4_fp8(v0[0], v0[1], v0[2], v0[3]); w8.y = pk4_fp8(v1[0], v1[1], v1[2], v1[3]); *(u32x2v*)(x8 + (size_t)r * 1024 + col0 + bj * HALF) = w8; }
                    part += ((v0[0] * v0[0] + v0[1] * v0[1]) + (v0[2] * v0[2] + v0[3] * v0[3])) + ((v1[0] * v1[0] + v1[1] * v1[1]) + (v1[2] * v1[2] + v1[3] * v1[3])); }
                if (WITH_SS) { part += __shfl_xor(part, 16); part += __shfl_xor(part, 32); if (fq == 0) ss[(size_t)r * 16 + u.pn * 4 + wc] = part; } }
    }
};
template <int MODE> struct EpiSwiGLU {
    static constexpr bool PERM = true, AFTER_DRAIN = false;
    bf16_t* O; int ldc; const float* sv; int pn_mod;
    __device__ __forceinline__ void operator()(const f32x4 (&acc)[2][2][4][2], const Unit& u, int wr, int wc, int fr, int fq) const {
        const int row0 = u.pm * BM + wr * 64 + fr, pn = pn_mod ? (u.pn % pn_mod) : u.pn, col0 = pn * HALF + wc * 32 + 8 * fq;
#pragma unroll
        for (int ai = 0; ai < 2; ++ai)
#pragma unroll
            for (int m = 0; m < 4; ++m) { const int r = row0 + ai * HALF + m * 16; float sc = 1.0f;
                if (MODE == 1) sc = rsqrtf(sv[r] * (1.0f / 1024.0f) + 1e-6f);
                if (MODE == 2) sc = sv[r];
                if (MODE == 3) sc = rs_from16(sv + (size_t)r * 16);
                const f32x4 g0 = acc[ai][0][m][0] * sc, g1 = acc[ai][0][m][1] * sc, u0 = acc[ai][1][m][0] * sc, u1 = acc[ai][1][m][1] * sc; f32x4 a0, a1;
#pragma unroll
                for (int j = 0; j < 4; ++j) { a0[j] = swiglu2(g0[j], u0[j]); a1[j] = swiglu2(g1[j], u1[j]); }
                u32x4 w; w.x = cvt_pk_bf16(a0[0], a0[1]); w.y = cvt_pk_bf16(a0[2], a0[3]); w.z = cvt_pk_bf16(a1[0], a1[1]); w.w = cvt_pk_bf16(a1[2], a1[3]);
                *(u32x4*)(O + (size_t)r * ldc + col0) = w; }
    }
};
__device__ __forceinline__ unsigned pk4_fp8_nc(float a, float b, float c, float d) { unsigned w = 0u; w = __builtin_amdgcn_cvt_pk_fp8_f32(a, b, w, false); w = __builtin_amdgcn_cvt_pk_fp8_f32(c, d, w, true); return w; }
template <int MODE> struct EpiSwiGLUF8 {
    static constexpr bool PERM = true, AFTER_DRAIN = false; static constexpr int NST = 4;
    unsigned char* O; int ldc; const float* sv; int pn_mod;
    __device__ __forceinline__ void operator()(const f32x4 (&acc)[2][2][4][2], const Unit& u, int wr, int wc, int fr, int fq) const {
        const int row0 = u.pm * BM + wr * 64 + fr, pn = pn_mod ? (u.pn % pn_mod) : u.pn, col0 = pn * HALF + wc * 32 + 8 * (fq & ~1);
#pragma unroll
        for (int ai = 0; ai < 2; ++ai)
#pragma unroll
            for (int mp = 0; mp < 2; ++mp) { unsigned wx[2], wy[2];
#pragma unroll
                for (int q = 0; q < 2; ++q) { const int m = 2 * mp + q, r = row0 + ai * HALF + m * 16; float sc = 1.0f;
                    if (MODE == 1) sc = rsqrtf(sv[r] * (1.0f / 1024.0f) + 1e-6f);
                    if (MODE == 2) sc = sv[r];
                    if (MODE == 3) sc = rs_from16(sv + (size_t)r * 16);
                    const f32x4 g0 = acc[ai][0][m][0] * sc, g1 = acc[ai][0][m][1] * sc, u0 = acc[ai][1][m][0] * sc, u1 = acc[ai][1][m][1] * sc; f32x4 a0, a1;
#pragma unroll
                    for (int j = 0; j < 4; ++j) { a0[j] = swiglu2(g0[j], u0[j]); a1[j] = swiglu2(g1[j], u1[j]); }
                    wx[q] = pk4_fp8_nc(a0[0], a0[1], a0[2], a0[3]); wy[q] = pk4_fp8_nc(a1[0], a1[1], a1[2], a1[3]); }
                const auto sx = __builtin_amdgcn_permlane16_swap(wx[0], wx[1], false, false); const auto sy = __builtin_amdgcn_permlane16_swap(wy[0], wy[1], false, false);
                u32x4 w; w.x = sx[0]; w.y = sy[0]; w.z = sx[1]; w.w = sy[1];
                const int r = row0 + ai * HALF + (2 * mp + (fq & 1)) * 16;
                *(u32x4*)(O + (size_t)r * ldc + col0) = w; }
    }
};
struct EpiGateF8 {
    static constexpr bool PERM = true, AFTER_DRAIN = false; static constexpr int NST = 8;
    unsigned char* O; int ldc; const float* sv; int pn_mod;
    __device__ __forceinline__ void operator()(const f32x4 (&acc)[2][2][4][2], const Unit& u, int wr, int wc, int fr, int fq) const {
        const int row0 = u.pm * BM + wr * 64 + fr, pn = pn_mod ? (u.pn % pn_mod) : u.pn, col0 = pn * BM + wc * 32 + 8 * (fq & ~1);
#pragma unroll
        for (int ai = 0; ai < 2; ++ai)
#pragma unroll
            for (int mp = 0; mp < 2; ++mp) { unsigned wx[2][2], wy[2][2];
#pragma unroll
                for (int q = 0; q < 2; ++q) { const int m = 2 * mp + q, r = row0 + ai * HALF + m * 16; const float sc = sv[r] * 16.0f;
#pragma unroll
                    for (int bj = 0; bj < 2; ++bj) { const f32x4 v0 = acc[ai][bj][m][0] * sc, v1 = acc[ai][bj][m][1] * sc; wx[q][bj] = pk4_fp8(v0[0], v0[1], v0[2], v0[3]); wy[q][bj] = pk4_fp8(v1[0], v1[1], v1[2], v1[3]); } }
                const int r = row0 + ai * HALF + (2 * mp + (fq & 1)) * 16;
#pragma unroll
                for (int bj = 0; bj < 2; ++bj) { const auto sx = __builtin_amdgcn_permlane16_swap(wx[0][bj], wx[1][bj], false, false); const auto sy = __builtin_amdgcn_permlane16_swap(wy[0][bj], wy[1][bj], false, false);
                    u32x4 w; w.x = sx[0]; w.y = sy[0]; w.z = sx[1]; w.w = sy[1]; *(u32x4*)(O + (size_t)r * ldc + col0 + bj * HALF) = w; } }
    }
};
struct EpiRope {
    static constexpr bool PERM = true, AFTER_DRAIN = false;
    bf16_t* O; int ldc; const float* ss; const float* rope;
    __device__ __forceinline__ void operator()(const f32x4 (&acc)[2][2][4][2], const Unit& u, int wr, int wc, int fr, int fq) const {
        const int row0 = u.pm * BM + wr * 64 + fr, col0 = u.pn * BM + wc * 32 + 8 * fq; const bool rot = (u.pn < 4) && ((wc & 1) == 0);
#pragma unroll
        for (int ai = 0; ai < 2; ++ai)
#pragma unroll
            for (int m = 0; m < 4; ++m) { const int r = row0 + ai * HALF + m * 16; const float sc = rs_from16(ss + (size_t)r * 16);
                f32x4 c0 = {1.f, 1.f, 1.f, 1.f}, c1 = c0, s0 = {0.f, 0.f, 0.f, 0.f}, s1 = s0;
                if (rot && fq < 2) { const f32x4* rp = (const f32x4*)(rope + (size_t)r * 16); c0 = rp[0]; c1 = rp[1]; s0 = rp[2]; s1 = rp[3]; if (fq == 0) { s0 = -s0; s1 = -s1; } }
                bf16_t* rowp = O + (size_t)r * ldc + col0;
#pragma unroll
                for (int bj = 0; bj < 2; ++bj) { f32x4 v0 = acc[ai][bj][m][0] * sc, v1 = acc[ai][bj][m][1] * sc;
                    if (rot) { f32x4 p0, p1;
#pragma unroll
                        for (int j = 0; j < 4; ++j) { p0[j] = __shfl_xor(v0[j], 16); p1[j] = __shfl_xor(v1[j], 16); }
                        v0 = v0 * c0 + p0 * s0; v1 = v1 * c1 + p1 * s1; }
                    u32x4 w; w.x = cvt_pk_bf16(v0[0], v0[1]); w.y = cvt_pk_bf16(v0[2], v0[3]); w.z = cvt_pk_bf16(v1[0], v1[1]); w.w = cvt_pk_bf16(v1[2], v1[3]);
                    *(u32x4*)(rowp + bj * HALF) = w; } }
    }
};
constexpr int TAIL_SL = 7, TAIL_KB = DFE / TAIL_SL;
struct TailOrder {
    static constexpr bool HAS_KOFF = true;
    int nt_units, G, c; const int* tilee;
    __device__ __forceinline__ void init(int nrt, int G_, int c_, const int* tilee_) { nt_units = (nrt - 256) * 4 * TAIL_SL; G = G_; c = c_; tilee = tilee_; }
    __device__ __forceinline__ bool next(int i, Unit& u) const { const int L = i * G + c; if (L >= nt_units) return false; const int t = L / TAIL_SL, sl = L % TAIL_SL, rt = t >> 2, j = t & 3;
        u.pm = 256 + rt; u.pn = tilee[u.pm] * 4 + j; u.koff = sl * TAIL_KB; return true; }
    __device__ __forceinline__ void a_ready(const Unit&) const {}
    __device__ __forceinline__ void done(const Unit&) const {}
};
struct EpiTailPart {
    static constexpr bool PERM = false, AFTER_DRAIN = false;
    float* P;
    __device__ __forceinline__ void operator()(const f32x4 (&acc)[2][2][4][2], const Unit& u, int wr, int wc, int fr, int fq) const {
        float* T = P + (size_t)(((u.pm - 256) * 4 + (u.pn & 3)) * TAIL_SL + u.koff / TAIL_KB) * 65536;
#pragma unroll
        for (int ai = 0; ai < 2; ++ai)
#pragma unroll
            for (int m = 0; m < 4; ++m) { float* rowp = T + (size_t)(ai * HALF + wr * 64 + m * 16 + fr) * 256 + wc * 32 + 4 * fq;
#pragma unroll
                for (int bj = 0; bj < 2; ++bj)
#pragma unroll
                    for (int n = 0; n < 2; ++n) *(f32x4*)(rowp + bj * HALF + n * 16) = acc[ai][bj][m][n]; }
    }
};
struct MoeOrder {
    static constexpr bool HAS_KOFF = false;
    StaticOrder so; const int* tilee; int tpe;
    __device__ __forceinline__ void init(int nrt, int tpe_, int G_, int c_, const int* tilee_, int pb_ = 0) { so.nM = nrt; so.nN = tpe_; so.nwg = nrt * tpe_; so.G = G_; so.c = c_; so.pb = pb_; tilee = tilee_; tpe = tpe_; }
    __device__ __forceinline__ bool next(int i, Unit& u) const { if (!so.next(i, u)) return false; u.pn += tilee[u.pm] * tpe; return true; }
    __device__ __forceinline__ void a_ready(const Unit&) const {}
    __device__ __forceinline__ void done(const Unit&) const {}
};
template <class Epi, class Sched, bool ALIGN_EPI = false, bool SP2 = false, bool F8 = false>
__device__ __forceinline__ void gemm_phase(PG8_LAS unsigned char* lds, const Gemm g, const Sched& S, const Epi& E) {
    int tid_ = threadIdx.x; asm volatile("" : "+v"(tid_));
    const int tid = tid_, wid = __builtin_amdgcn_readfirstlane(tid >> 6), lane = tid & 63, wr = wid >> 2, wc = wid & 3, fr = lane & 15, fq = lane >> 4;
    const int K = g.K, nt = K / BK, LD = Sched::HAS_KOFF ? g.ld : g.K;
    unsigned voffA[2], voffB[2];
#pragma unroll
    for (int i = 0; i < 2; ++i) { int R, C; stage_rc(tid * 16 + i * 8192, R, C); const int Rb = Epi::PERM ? ((R & ~31) + perm32(R & 31)) : R;
        voffA[i] = (unsigned)(R * LD + C) * 2u; voffB[i] = (unsigned)(Rb * LD + C) * 2u; }
    const size_t kstep = (size_t)(BK * 2);
    const size_t hstep = (size_t)HALF * LD * 2;
    const size_t tstep = 2 * hstep;
    const unsigned ldsw = (unsigned)wid * 1024u;
    const int aoff = lds_byte(wr * 64 + fr, fq * 8), boff = lds_byte(wc * 32 + fr, fq * 8);
#define PG8_SA(b, h) (((b) * 2 + (h)) * HTB)
#define PG8_SB(b, h) ((4 + (b) * 2 + (h)) * HTB)
#define PG8_STAGE(bufoff, gbase, voff) do { _Pragma("unroll") for (int _i = 0; _i < 2; ++_i) \
        __builtin_amdgcn_global_load_lds((const unsigned*)((const char*)(gbase) + (voff)[_i]), (PG8_LAS unsigned*)(lds + (bufoff) + ldsw + _i * 8192), 16, 0, 0); } while (0)
#define PG8_CAT(lo, hi) __builtin_bit_cast(v8i32, __builtin_shufflevector((lo), (hi), 0, 1, 2, 3, 4, 5, 6, 7, 8, 9, 10, 11, 12, 13, 14, 15))
#define PG8_LDA(dst, b, h) do { _Pragma("unroll") for (int m = 0; m < 4; ++m) { if constexpr (F8) { dst##8[m] = PG8_CAT(*(const PG8_LAS bf16x8*)(lds + PG8_SA(b, h) + aoff + m * 2048), *(const PG8_LAS bf16x8*)(lds + PG8_SA(b, h) + aoff + m * 2048 + 1024)); } \
        else { _Pragma("unroll") for (int k = 0; k < 2; ++k) dst[m][k] = *(const PG8_LAS bf16x8*)(lds + PG8_SA(b, h) + aoff + m * 2048 + k * 1024); } } } while (0)
#define PG8_LDB(dst, b, h) do { _Pragma("unroll") for (int n = 0; n < 2; ++n) { if constexpr (F8) { dst##8[n] = PG8_CAT(*(const PG8_LAS bf16x8*)(lds + PG8_SB(b, h) + boff + n * 2048), *(const PG8_LAS bf16x8*)(lds + PG8_SB(b, h) + boff + n * 2048 + 1024)); } \
        else { _Pragma("unroll") for (int k = 0; k < 2; ++k) dst[n][k] = *(const PG8_LAS bf16x8*)(lds + PG8_SB(b, h) + boff + n * 2048 + k * 1024); } } } while (0)
#define PG8_MMA(ai, bj, At, Bt) do { __builtin_amdgcn_s_setprio(1); _Pragma("unroll") for (int m = 0; m < 4; ++m) _Pragma("unroll") for (int n = 0; n < 2; ++n) { \
        if constexpr (F8) { asm volatile("v_mfma_scale_f32_16x16x128_f8f6f4 %0, %1, %2, %0, %3, %4 op_sel_hi:[0,0,0]" : "+v"(acc[ai][bj][m][n]) : "v"(Bt##8[n]), "v"(At##8[m]), "v"(sclW), "v"(sclA)); } \
        else { _Pragma("unroll") for (int k = 0; k < 2; ++k) acc[ai][bj][m][n] = __builtin_amdgcn_mfma_f32_16x16x32_bf16(Bt[n][k], At[m][k], acc[ai][bj][m][n], 0, 0, 0); } } __builtin_amdgcn_s_setprio(0); } while (0)
#define PG8_MMA_Z(ai, bj, At, Bt) do { __builtin_amdgcn_s_setprio(1); _Pragma("unroll") for (int m = 0; m < 4; ++m) _Pragma("unroll") for (int n = 0; n < 2; ++n) { \
        if constexpr (F8) { asm volatile("v_mfma_scale_f32_16x16x128_f8f6f4 %0, %1, %2, 0, %3, %4 op_sel_hi:[0,0,0]" : "=&v"(acc[ai][bj][m][n]) : "v"(Bt##8[n]), "v"(At##8[m]), "v"(sclW), "v"(sclA)); } \
        else { acc[ai][bj][m][n] = __builtin_amdgcn_mfma_f32_16x16x32_bf16(Bt[n][0], At[m][0], (f32x4){0.f, 0.f, 0.f, 0.f}, 0, 0, 0); \
               acc[ai][bj][m][n] = __builtin_amdgcn_mfma_f32_16x16x32_bf16(Bt[n][1], At[m][1], acc[ai][bj][m][n], 0, 0, 0); } } __builtin_amdgcn_s_setprio(0); } while (0)
#define PG8_WAIT_V(n) asm volatile("s_waitcnt vmcnt(" #n ")" ::: "memory")
#define PG8_WAIT_L(n) asm volatile("s_waitcnt lgkmcnt(" #n ")" ::: "memory")
#define PG8_BAR __builtin_amdgcn_s_barrier()
#define PG8_SCHED __builtin_amdgcn_sched_barrier(0)
    Unit cur, nxt; int ui = 0;
    if (!S.next(0, cur)) return;
    f32x4 acc[2][2][4][2];
    if constexpr (!SP2) {
#pragma unroll
    for (int a = 0; a < 2; ++a)
#pragma unroll
        for (int b = 0; b < 2; ++b)
#pragma unroll
            for (int m = 0; m < 4; ++m)
#pragma unroll
                for (int n = 0; n < 2; ++n) acc[a][b][m][n] = (f32x4){0.f, 0.f, 0.f, 0.f};
    }
    bf16x8 At[4][2], B0[2][2], B1[2][2]; v8i32 At8[4], B08[2], B18[2];
    const int sclW = 0x79797979, sclA = 0x7F7F7F7F;
    const char* cA = (const char*)g.A + (size_t)cur.pm * tstep; const char* cB = (const char*)g.Bt + (size_t)cur.pn * tstep;
    if constexpr (Sched::HAS_KOFF) { cA += cur.koff; cB += cur.koff; }
    S.a_ready(cur);
    if constexpr (SP2) {
        PG8_STAGE(PG8_SB(0, 0), cB, voffB); PG8_STAGE(PG8_SB(0, 1), cB + hstep, voffB); PG8_STAGE(PG8_SA(0, 0), cA, voffA); PG8_STAGE(PG8_SA(0, 1), cA + hstep, voffA);
        if (wr == 1) PG8_BAR;
        PG8_WAIT_V(2); PG8_BAR;
        PG8_STAGE(PG8_SB(1, 0), cB + kstep, voffB); PG8_STAGE(PG8_SA(1, 0), cA + kstep, voffA); PG8_STAGE(PG8_SB(1, 1), cB + hstep + kstep, voffB);
        PG8_WAIT_V(6); PG8_BAR;
    } else {
        PG8_STAGE(PG8_SB(0, 0), cB, voffB); PG8_STAGE(PG8_SA(0, 0), cA, voffA); PG8_STAGE(PG8_SB(0, 1), cB + hstep, voffB); PG8_STAGE(PG8_SA(0, 1), cA + hstep, voffA);
        if (wr == 1) PG8_BAR;
        PG8_WAIT_V(4); PG8_BAR;
        PG8_STAGE(PG8_SB(1, 0), cB + kstep, voffB); PG8_STAGE(PG8_SA(1, 0), cA + kstep, voffA); PG8_STAGE(PG8_SB(1, 1), cB + hstep + kstep, voffB);
        PG8_WAIT_V(6); PG8_BAR;
    }
    for (;;) {
        const bool has_next = S.next(ui + 1, nxt);
        const char* nA = has_next ? (const char*)g.A + (size_t)nxt.pm * tstep : cA; const char* nB = has_next ? (const char*)g.Bt + (size_t)nxt.pn * tstep : cB;
        if constexpr (Sched::HAS_KOFF) { if (has_next) { nA += nxt.koff; nB += nxt.koff; } }
#pragma clang loop unroll(disable)
        for (int t = 0; t < nt; t += 2) {
            const bool last = (t == nt - 2);
            const char* a1 = cA + (size_t)(t + 1) * kstep;
            const char* a2 = last ? nA : cA + (size_t)(t + 2) * kstep; const char* b2 = last ? nB : cB + (size_t)(t + 2) * kstep;
            const char* a3 = a2 + kstep; const char* b3 = b2 + kstep;
            if (last && has_next) S.a_ready(nxt);
            if constexpr (SP2) {
            PG8_LDB(B0, 0, 0); PG8_LDB(B1, 0, 1); PG8_SCHED; PG8_LDA(At, 0, 0); PG8_STAGE(PG8_SA(1, 1), a1 + hstep, voffA);
            PG8_WAIT_V(8); PG8_WAIT_L(0); PG8_BAR; if (t == 0) { PG8_MMA_Z(0, 0, At, B0); PG8_MMA_Z(0, 1, At, B1); } else { PG8_MMA(0, 0, At, B0); PG8_MMA(0, 1, At, B1); } PG8_BAR; PG8_SCHED;
            PG8_LDA(At, 0, 1); PG8_STAGE(PG8_SB(0, 0), b2, voffB); PG8_STAGE(PG8_SB(0, 1), b2 + hstep, voffB); PG8_STAGE(PG8_SA(0, 0), a2, voffA);
            PG8_WAIT_V(8); PG8_WAIT_L(0); PG8_BAR; if (t == 0) { PG8_MMA_Z(1, 0, At, B0); PG8_MMA_Z(1, 1, At, B1); } else { PG8_MMA(1, 0, At, B0); PG8_MMA(1, 1, At, B1); } PG8_BAR; PG8_SCHED;
            PG8_LDB(B0, 1, 0); PG8_LDB(B1, 1, 1); PG8_SCHED; PG8_LDA(At, 1, 0); PG8_STAGE(PG8_SA(0, 1), a2 + hstep, voffA);
            PG8_WAIT_V(8); PG8_WAIT_L(0); PG8_BAR; PG8_MMA(0, 0, At, B0); PG8_MMA(0, 1, At, B1); PG8_BAR; PG8_SCHED;
            PG8_LDA(At, 1, 1); PG8_STAGE(PG8_SB(1, 0), b3, voffB); PG8_STAGE(PG8_SB(1, 1), b3 + hstep, voffB); PG8_STAGE(PG8_SA(1, 0), a3, voffA);
            PG8_WAIT_V(8); PG8_WAIT_L(0); PG8_BAR; PG8_MMA(1, 0, At, B0); PG8_MMA(1, 1, At, B1); PG8_BAR; PG8_SCHED;
            } else {
            PG8_LDB(B0, 0, 0); PG8_SCHED; PG8_LDA(At, 0, 0); PG8_STAGE(PG8_SA(1, 1), a1 + hstep, voffA);
            PG8_WAIT_L(8); PG8_BAR; PG8_WAIT_L(0); PG8_MMA(0, 0, At, B0); PG8_BAR; PG8_SCHED;
            PG8_LDB(B1, 0, 1); PG8_STAGE(PG8_SB(0, 0), b2, voffB);
            PG8_BAR; PG8_WAIT_L(0); PG8_MMA(0, 1, At, B1); PG8_BAR;
            PG8_LDA(At, 0, 1); PG8_STAGE(PG8_SA(0, 0), a2, voffA);
            PG8_BAR; PG8_WAIT_L(0); PG8_MMA(1, 0, At, B0); PG8_BAR; PG8_SCHED;
            PG8_STAGE(PG8_SB(0, 1), b2 + hstep, voffB);
            PG8_WAIT_V(6); PG8_BAR; PG8_MMA(1, 1, At, B1); PG8_BAR;
            PG8_LDB(B0, 1, 0); PG8_SCHED; PG8_LDA(At, 1, 0); PG8_STAGE(PG8_SA(0, 1), a2 + hstep, voffA);
            PG8_WAIT_L(8); PG8_BAR; PG8_WAIT_L(0); PG8_MMA(0, 0, At, B0); PG8_BAR; PG8_SCHED;
            PG8_LDB(B1, 1, 1); PG8_STAGE(PG8_SB(1, 0), b3, voffB);
            PG8_BAR; PG8_WAIT_L(0); PG8_MMA(0, 1, At, B1); PG8_BAR;
            PG8_LDA(At, 1, 1); PG8_STAGE(PG8_SA(1, 0), a3, voffA);
            PG8_BAR; PG8_WAIT_L(0); PG8_MMA(1, 0, At, B0); PG8_BAR; PG8_SCHED;
            PG8_STAGE(PG8_SB(1, 1), b3 + hstep, voffB);
            PG8_WAIT_V(6); PG8_BAR; PG8_MMA(1, 1, At, B1); PG8_BAR;
            }
        }
        if constexpr (F8) asm volatile("s_nop 15\n\ts_nop 15" ::: "memory");
        if constexpr (ALIGN_EPI) { if (wr == 0) PG8_BAR; }
        if constexpr (!Epi::AFTER_DRAIN) { E(acc, cur, wr, wc, fr, fq); S.done(cur); }
        if (!has_next) break;
        if constexpr (!SP2) {
#pragma unroll
        for (int a = 0; a < 2; ++a)
#pragma unroll
            for (int b = 0; b < 2; ++b)
#pragma unroll
                for (int m = 0; m < 4; ++m)
#pragma unroll
                    for (int n = 0; n < 2; ++n) acc[a][b][m][n] = (f32x4){0.f, 0.f, 0.f, 0.f};
        }
        cur = nxt; cA = nA; cB = nB; ++ui;
        if constexpr (ALIGN_EPI) { if (wr == 1) PG8_BAR; }
    }
    PG8_WAIT_V(0);
    if constexpr (!ALIGN_EPI) { if (wr == 0) PG8_BAR; }
    PG8_BAR;
    if constexpr (Epi::AFTER_DRAIN) { E.fused(acc, cur, wr, wc, fr, fq, lds, wid, lane); S.done(cur); }
#undef PG8_SA
#undef PG8_SB
#undef PG8_STAGE
#undef PG8_LDA
#undef PG8_CAT
#undef PG8_LDB
#undef PG8_MMA
#undef PG8_MMA_Z
#undef PG8_WAIT_V
#undef PG8_WAIT_L
#undef PG8_BAR
#undef PG8_SCHED
}
}

#define FAST(s) (((FASTMASK) >> (s)) & 1u)
#ifndef FFN_DN_F8
#define FFN_DN_F8 1
#endif
#ifndef FFN_F8
#define FFN_F8 0
#endif
#ifndef GEMM_PB
#define GEMM_PB 4
#endif
#ifndef GLA2
#define GLA2 1
#endif
#ifndef Y_F8
#define Y_F8 1
#endif
#ifndef MOE_TAILFIX
#define MOE_TAILFIX 1
#endif
#ifndef MOE_F8
#define MOE_F8 1
#endif

template <bool NT = true>
__device__ __forceinline__ void conv_item(const float* W, int ldw, int K, const float* gain, float scale, int srccol0, bf16* WT, int dstrow0, int k0, LAS float* scr, int lane) {
    float ld[64];
#pragma unroll
    for (int i = 0; i < 64; ++i) ld[i] = __builtin_nontemporal_load(W + (size_t)(k0 + i) * ldw + srccol0 + lane);
#pragma unroll
    for (int i = 0; i < 64; ++i) { float v = ld[i] * scale; if (gain) v *= gain[k0 + i]; scr[i * 65 + lane] = v; }
    asm volatile("s_waitcnt lgkmcnt(0)" ::: "memory");
    const int c = lane & 7;
#pragma unroll
    for (int j = 0; j < 8; ++j) { const int n = (lane >> 3) + 8 * j; const LAS float* sp = scr + (8 * c) * 65 + n;
        u32x4 o; o.x = pk2(sp[0 * 65], sp[1 * 65]); o.y = pk2(sp[2 * 65], sp[3 * 65]); o.z = pk2(sp[4 * 65], sp[5 * 65]); o.w = pk2(sp[6 * 65], sp[7 * 65]);
        if (NT) __builtin_nontemporal_store(o, (u32x4*)(WT + (size_t)(dstrow0 + n) * K + k0 + 8 * c)); else *(u32x4*)(WT + (size_t)(dstrow0 + n) * K + k0 + 8 * c) = o; }
    asm volatile("s_waitcnt lgkmcnt(0)" ::: "memory");
}
__device__ __forceinline__ void conv_item_f8(const float* W, int ldw, int K, const float* gain, float scale, int srccol0, unsigned char* WT, int dstrow0, int k0, LAS float* scr, int lane) {
    float ld[64];
#pragma unroll
    for (int i = 0; i < 64; ++i) { const int kk = 2 * i + (lane >> 5); ld[i] = __builtin_nontemporal_load(W + (size_t)(k0 + kk) * ldw + srccol0 + (lane & 31)); }
#pragma unroll
    for (int i = 0; i < 64; ++i) { const int kk = 2 * i + (lane >> 5); float v = ld[i] * scale; if (gain) v *= gain[k0 + kk]; scr[kk * 33 + (lane & 31)] = v; }
    asm volatile("s_waitcnt lgkmcnt(0)" ::: "memory");
    const int c = lane & 15;
#pragma unroll
    for (int j = 0; j < 8; ++j) { const int n = (lane >> 4) + 4 * j; const LAS float* sp = scr + (8 * c) * 33 + n;
        u32x2 o; o.x = pg8::pk4_fp8(sp[0 * 33], sp[1 * 33], sp[2 * 33], sp[3 * 33]); o.y = pg8::pk4_fp8(sp[4 * 33], sp[5 * 33], sp[6 * 33], sp[7 * 33]);
        __builtin_nontemporal_store(o, (u32x2*)(WT + (size_t)(dstrow0 + n) * K + k0 + 8 * c)); }
    asm volatile("s_waitcnt lgkmcnt(0)" ::: "memory");
}
__device__ __forceinline__ void conv_weights(const Args& a, LAS unsigned char* lds) {
    const int lane = threadIdx.x & 63, wave = threadIdx.x >> 6, gw = blockIdx.x * NWAVES + wave, NGW = gridDim.x * NWAVES;
    LAS float* scr = (LAS float*)(lds + wave * 16896);
    static_assert(FFN_F8 == 0, "the fp8 gate/up conversion path below still enumerates 64 x 64 items");
    constexpr int I_INA = 16 * (NA / 64), I_INB = 16 * (WINB / 64), I_MKV = 2 * 16 * 8, I_OUT = 2 * 16 * 16, I_FGU = 16 * (2 * DFF / 64), I_FDN = (FFN_F8 || FFN_DN_F8) ? (DFF / 128) * 32 : (DFF / 64) * 16;
    constexpr int I_EGU = MOE_F8 ? NE * 8 * (2 * DFE / 32) : NE * 16 * (2 * DFE / 64), I_EDN = MOE_F8 ? NE * (DFE / 128) * 32 : NE * (DFE / 64) * 16;
    constexpr int NIT = I_INA + I_INB + I_MKV + I_OUT + I_FGU + I_FDN + I_EGU + I_EDN;
    for (int it = gw; it < NIT; it += NGW) {
        int r = it;
        if (r < I_INA) { const int nb = r % (NA / 64), kb = r / (NA / 64), n0 = nb * 64; const int src = n0 < 1536 ? n0 : n0 + 16; const float sc = n0 < 384 ? 0.10206207261596575f : (n0 >= ZA_QM ? QS : 1.0f);
            conv_item<false>(a.w_in_a, WINA, DM, a.mix_norm, sc, src, (bf16*)(a.ws + WT_INA), n0, kb * 64, scr, lane); continue; } r -= I_INA;
        if (r < I_INB) { const int nb = r % (WINB / 64), kb = r / (WINB / 64), n0 = nb * 64; const float sc = (n0 < ZB_K || n0 >= ZB_QM) ? QS : 1.0f;
            conv_item(a.w_in_b, WINB, DM, a.mix_norm + DM, sc, n0, (bf16*)(a.ws + WT_INB), n0, kb * 64, scr, lane); continue; } r -= I_INB;
        if (r < I_MKV) { const int l = r / 128, q = r % 128, nb = q % 8, kb = q / 8;
            conv_item<false>(a.w_mem_kv + (size_t)l * DM * 512, 512, DM, nullptr, 1.0f, nb * 64, (bf16*)(a.ws + WT_MKV) + (size_t)l * 512 * DM, nb * 64, kb * 64, scr, lane); continue; } r -= I_MKV;
        if (r < I_OUT) { const int l = r / 256, q = r % 256, nb = q % 16, kb = q / 16;
            conv_item(a.w_out + (size_t)l * DM * DM, DM, DM, nullptr, 1.0f, nb * 64, (bf16*)(a.ws + WT_OUT) + (size_t)l * DM * DM, nb * 64, kb * 64, scr, lane); continue; } r -= I_OUT;
        if (r < I_FGU) { const int nb = r % (2 * DFF / 64), kb = r / (2 * DFF / 64), n0 = nb * 64; const int src = ((n0 & 255) >> 7) * DFF + (n0 >> 8) * 128 + (n0 & 127);
            const float gs = (n0 & 255) < 128 ? LOG2E : 1.0f / LOG2E;
            if (FFN_F8) conv_item_f8(a.ffn_w_gate_up, 2 * DFF, DM, a.ffn_norm, 64.0f * gs, src, (unsigned char*)(a.ws + WT_FGU), n0, kb * 64, scr, lane);
            else conv_item(a.ffn_w_gate_up, 2 * DFF, DM, a.ffn_norm, gs, src, (bf16*)(a.ws + WT_FGU), n0, kb * 64, scr, lane);
            continue; } r -= I_FGU;
        if (r < I_FDN) {
            if (FFN_F8 || FFN_DN_F8) { const int nb = r % 32, kb = r / 32; conv_item_f8(a.ffn_w_down, DM, DFF, nullptr, 64.0f, nb * 32, (unsigned char*)(a.ws + WT_FDN), nb * 32, kb * 128, scr, lane); }
            else { const int nb = r % 16, kb = r / 16; conv_item(a.ffn_w_down, DM, DFF, nullptr, 1.0f, nb * 64, (bf16*)(a.ws + WT_FDN), nb * 64, kb * 64, scr, lane); }
            continue; } r -= I_FDN;
        if (r < I_EGU) {
            if (MOE_F8) { constexpr int per = 8 * (2 * DFE / 32); const int e = r / per, q = r % per, nb = q % (2 * DFE / 32), kb = q / (2 * DFE / 32), n0 = nb * 32; const int src = ((n0 & 255) >> 7) * DFE + (n0 >> 8) * 128 + (n0 & 127);
                const float gs = (n0 & 255) < 128 ? LOG2E : 1.0f / LOG2E;
                conv_item_f8(a.exp_w_gate_up + (size_t)e * DM * 2 * DFE, 2 * DFE, DM, a.ffn_norm + DM, 64.0f * gs, src, (unsigned char*)(a.ws + WT_EGU) + (size_t)e * 2 * DFE * DM, n0, kb * 128, scr, lane); }
            else { constexpr int per = 16 * (2 * DFE / 64); const int e = r / per, q = r % per, nb = q % (2 * DFE / 64), kb = q / (2 * DFE / 64), n0 = nb * 64; const int src = ((n0 & 255) >> 7) * DFE + (n0 >> 8) * 128 + (n0 & 127);
                const float gs = (n0 & 255) < 128 ? LOG2E : 1.0f / LOG2E;
                conv_item(a.exp_w_gate_up + (size_t)e * DM * 2 * DFE, 2 * DFE, DM, a.ffn_norm + DM, gs, src, (bf16*)(a.ws + WT_EGU) + (size_t)e * 2 * DFE * DM, n0, kb * 64, scr, lane); }
            continue; } r -= I_EGU;
        if (MOE_F8) { constexpr int per = (DFE / 128) * 32; const int e = r / per, q = r % per, nb = q % 32, kb = q / 32;
            conv_item_f8(a.exp_w_down + (size_t)e * DFE * DM, DM, DFE, nullptr, 64.0f, nb * 32, (unsigned char*)(a.ws + WT_EDN) + (size_t)e * DM * DFE, nb * 32, kb * 128, scr, lane); }
        else { constexpr int per = (DFE / 64) * 16; const int e = r / per, q = r % per, nb = q % 16, kb = q / 16;
            conv_item(a.exp_w_down + (size_t)e * DFE * DM, DM, DFE, nullptr, 1.0f, nb * 64, (bf16*)(a.ws + WT_EDN) + (size_t)e * DM * DFE, nb * 64, kb * 64, scr, lane); }
    }
}
typedef short s16x4 __attribute__((ext_vector_type(4)));
typedef __bf16 bf16x2_t __attribute__((ext_vector_type(2)));
#define MFMA16(a, b, c) __builtin_amdgcn_mfma_f32_16x16x32_bf16((a), (b), (c), 0, 0, 0)
__device__ __forceinline__ s16x4 ds_tr(LAS const unsigned char* p) { return __builtin_bit_cast(s16x4, __builtin_amdgcn_ds_read_tr16_b64_v4i16((LAS s16x4*)p)); }
__device__ __forceinline__ bf16x8 cat8(s16x4 lo, s16x4 hi) { return __builtin_shufflevector(lo, hi, 0, 1, 2, 3, 4, 5, 6, 7); }
__device__ __forceinline__ unsigned cvtpk(float lo, float hi) { f32x2 v = {lo, hi}; bf16x2_t b = __builtin_convertvector(v, bf16x2_t); return __builtin_bit_cast(unsigned, b); }
__device__ __forceinline__ bf16x8 pack8(f32x4 a, f32x4 b) { u32x4 w; w.x = cvtpk(a[0], a[1]); w.y = cvtpk(a[2], a[3]); w.z = cvtpk(b[0], b[1]); w.w = cvtpk(b[2], b[3]); return __builtin_bit_cast(bf16x8, w); }
__device__ __forceinline__ bf16x8 row_frag(LAS const unsigned char* T, int stride, int row0, int col0, int fr, int fq) { return *(LAS const bf16x8*)(T + (row0 + fr) * stride + (col0 + 8 * fq) * 2); }
__device__ __forceinline__ bf16x8 tr_frag(LAS const unsigned char* T, int stride, int k0, int col0, int fr, int fq) {
    LAS const unsigned char* p = T + (k0 + 8 * fq + (fr >> 2)) * stride + (col0 + 4 * (fr & 3)) * 2; return cat8(ds_tr(p), ds_tr(p + 4 * stride)); }
__device__ __forceinline__ bf16x8 tr2(LAS const unsigned char* p, int stride) { return cat8(ds_tr(p), ds_tr(p + 4 * stride)); }
__device__ __forceinline__ bf16x8 tr_frag_perm(LAS const unsigned char* T, int stride, int k0, int col0, int fr, int fq) {
    LAS const unsigned char* p = T + (k0 + 4 * fq + (fr >> 2)) * stride + (col0 + 4 * (fr & 3)) * 2; return cat8(ds_tr(p), ds_tr(p + 16 * stride)); }

template <bool SWA_MODE>
__device__ __forceinline__ void attn_wave16(LAS const unsigned char* Ks, LAS const unsigned char* Vs, const bf16x8 (&qf)[2], bf16* O, int ldo, int kb0, int dbase, int lim, float sink, int lane) {
    constexpr int NKB = SWA_MODE ? 10 : 16;
    const int fr = lane & 15, fq = lane >> 4;
    f32x4 sacc[NKB];
    const int kx = (fr >> 1) & 7;
    LAS const unsigned char* kbase = Ks + kb0 * 2048 + fr * 128;
#pragma unroll
    for (int i = 0; i < NKB; ++i) { sacc[i] = (f32x4){0.f, 0.f, 0.f, 0.f};
#pragma unroll
        for (int ks = 0; ks < 2; ++ks) { const bf16x8 a = *(LAS const bf16x8*)(kbase + i * 2048 + (((fq + 4 * ks) ^ kx) * 16)); sacc[i] = MFMA16(a, qf[ks], sacc[i]); }
        if ((i & 3) == 3) __builtin_amdgcn_sched_barrier(0); }
    float mx = -INFINITY;
#pragma unroll
    for (int i = 0; i < NKB; ++i)
#pragma unroll
        for (int r = 0; r < 4; ++r) { float v = sacc[i][r];
            if (SWA_MODE) { const unsigned d = (unsigned)(dbase - (16 * i + r)); if (d > (unsigned)lim) v = -INFINITY; sacc[i][r] = v; }
            mx = fmaxf(mx, v); }
    mx = fmaxf(mx, __shfl_xor(mx, 16)); mx = fmaxf(mx, __shfl_xor(mx, 32));
    if (SWA_MODE) mx = fmaxf(mx, sink);
    float sum = 0.f;
#pragma unroll
    for (int i = 0; i < NKB; ++i)
#pragma unroll
        for (int r = 0; r < 4; ++r) { const float pv = __builtin_amdgcn_exp2f(sacc[i][r] - mx); sacc[i][r] = pv; sum += pv; }
    sum += __shfl_xor(sum, 16); sum += __shfl_xor(sum, 32);
    if (SWA_MODE) sum += __builtin_amdgcn_exp2f(sink - mx);
    const float inv = 1.0f / sum;
    f32x4 oacc[4];
#pragma unroll
    for (int db = 0; db < 4; ++db) oacc[db] = (f32x4){0.f, 0.f, 0.f, 0.f};
    const int vx = (2 * fq + (fr >> 3)) & 3;
    LAS const unsigned char* vbase = Vs + kb0 * 2048 + (4 * fq + (fr >> 2)) * 128 + (4 * (fr & 3)) * 2;
#pragma unroll
    for (int g = 0; g < NKB / 2; ++g) { const bf16x8 pb = pack8(sacc[2 * g], sacc[2 * g + 1]);
#pragma unroll
        for (int db = 0; db < 4; ++db) { LAS const unsigned char* p = vbase + g * 4096 + ((db ^ vx) * 32); const bf16x8 va = cat8(ds_tr(p), ds_tr(p + 2048)); oacc[db] = MFMA16(va, pb, oacc[db]); }
        if (g & 1) __builtin_amdgcn_sched_barrier(0); }
#pragma unroll
    for (int db = 0; db < 4; ++db) { const f32x4 o = oacc[db] * inv; u32x2 w; w.x = cvtpk(o[0], o[1]); w.y = cvtpk(o[2], o[3]); *(u32x2*)(O + (size_t)fr * ldo + 16 * db + 4 * fq) = w; }
}
struct KVPref { u32x4 k[4], v[4]; };
__device__ __forceinline__ void attn_issue(KVPref& P, const bf16* Ksrc, const bf16* Vsrc, int ld, int row_lo) {
#pragma unroll
    for (int i = 0; i < 4; ++i) { const int c = threadIdx.x + NTHREADS * i, row = c >> 3, p8 = c & 7; P.k[i] = (u32x4){0u, 0u, 0u, 0u}; P.v[i] = P.k[i];
        if (row >= row_lo) { P.k[i] = *(const u32x4*)(Ksrc + (ptrdiff_t)row * ld + p8 * 8); P.v[i] = *(const u32x4*)(Vsrc + (ptrdiff_t)row * ld + p8 * 8); } }
}
__device__ __forceinline__ void attn_store(const KVPref& P, LAS unsigned char* Ks, LAS unsigned char* Vs) {
#pragma unroll
    for (int i = 0; i < 4; ++i) { const int c = threadIdx.x + NTHREADS * i, row = c >> 3, p8 = c & 7;
        *(LAS u32x4*)(Ks + row * 128 + ((p8 ^ ((row >> 1) & 7)) * 16)) = P.k[i];
        *(LAS u32x4*)(Vs + row * 128 + (((p8 >> 1) ^ ((row >> 1) & 3)) * 32) + (p8 & 1) * 16) = P.v[i]; }
}
__device__ __forceinline__ void fast_attn(const Args& a, LAS unsigned char* lds, int layer, bool do_swa, bool do_mem) {
    const int lane = threadIdx.x & 63, wave = threadIdx.x >> 6, fr = lane & 15, fq = lane >> 4;
    const bf16* Z = (const bf16*)(a.ws + WS_Z); bf16* MIX = (bf16*)(a.ws + WS_MIX); const bf16* KV = (const bf16*)(a.ws + WS_MEMKV) + (size_t)layer * NB * NMEM * 512;
    LAS unsigned char* Ks = lds; LAS unsigned char* Vs = lds + 32768;
    const int ldz = layer ? WINB : NA, qoff = layer ? ZB_QM : ZA_QM;
    const int nswa = do_swa ? NB * SWKV * (SEQ / 128) : 0, nmem = do_mem ? NB * MEMH * 16 : 0, NU = nswa + nmem;
    KVPref P; bf16x8 qn[4][2];
    auto issue = [&](int u) {
        if (u < nswa) { const int n = u % 64, kvh = (u / 64) % SWKV, b = u / (64 * SWKV); const ptrdiff_t m0 = (ptrdiff_t)b * SEQ + 128 * n;
            attn_issue(P, Z + (m0 - 128) * WINB + ZB_K + kvh * HD, Z + (m0 - 128) * WINB + ZB_V + kvh * HD, WINB, n == 0 ? 128 : 0);
#pragma unroll
            for (int g3 = 0; g3 < 3; ++g3)
#pragma unroll
                for (int ks = 0; ks < 2; ++ks) qn[g3][ks] = *(const bf16x8*)(Z + ((size_t)m0 + 16 * wave + fr) * WINB + ZB_Q + (kvh * 3 + g3) * HD + 8 * fq + 32 * ks); }
        else { const int v = u - nswa, qg = v % 16, h = (v / 16) % MEMH, b = v / (16 * MEMH); attn_issue(P, KV + (size_t)b * NMEM * 512 + h * HD, KV + (size_t)b * NMEM * 512 + 256 + h * HD, 512, 0);
#pragma unroll
            for (int i = 0; i < 4; ++i)
#pragma unroll
                for (int ks = 0; ks < 2; ++ks) qn[i][ks] = *(const bf16x8*)(Z + ((size_t)b * SEQ + 128 * (4 * qg + i) + 16 * wave + fr) * ldz + qoff + h * HD + 8 * fq + 32 * ks); } };
    int u = (gridDim.x % 8 == 0) ? (int)((blockIdx.x % 8) * (gridDim.x / 8) + blockIdx.x / 8) : (int)blockIdx.x; if (u < NU) issue(u);
    for (; u < NU; u += gridDim.x) {
        __syncthreads();
        attn_store(P, Ks, Vs);
        bf16x8 qf[4][2];
#pragma unroll
        for (int i = 0; i < 4; ++i)
#pragma unroll
            for (int ks = 0; ks < 2; ++ks) qf[i][ks] = qn[i][ks];
        if (u + (int)gridDim.x < NU) issue(u + gridDim.x);
        __syncthreads();
        if (u < nswa) { const int n = u % 64, kvh = (u / 64) % SWKV, b = u / (64 * SWKV); const size_t mr = (size_t)b * SEQ + 128 * n + 16 * wave;
            const int kb0 = wave & ~1, dbase = 128 + 16 * wave + fr - 16 * kb0 - 4 * fq, tq = 128 * n + 16 * wave + fr, lim = tq < 127 ? tq : 127;
#pragma unroll
            for (int g3 = 0; g3 < 3; ++g3) { const int hq = kvh * 3 + g3; attn_wave16<true>(Ks, Vs, qf[g3], MIX + mr * DM + hq * HD, DM, kb0, dbase, lim, a.swa_sinks[hq] * LOG2E, lane); }
        } else { const int v = u - nswa, qg = v % 16, h = (v / 16) % MEMH, b = v / (16 * MEMH);
#pragma unroll
            for (int i = 0; i < 4; ++i) { const size_t mr = (size_t)b * SEQ + 128 * (4 * qg + i) + 16 * wave; attn_wave16<false>(Ks, Vs, qf[i], MIX + mr * DM + MAINW + h * HD, DM, 0, 0, 0, 0.f, lane); }
        }
    }
}

constexpr int GL_B = 0, GL_QD = 24576, GL_KD = 37888, GL_VT = 51200, GL_ST = 76800, GL_GLR = 115200, GL_GW = 119296, GL_GT = 125440, GL_SSQ = 126976;
constexpr int QSTR = 208, VSTR = 400;
struct G1Pref { f32x4 glr; f32x4 gw; u32x4 q[2], k[2], v[3]; };
__device__ __forceinline__ void g1_issue(G1Pref& P, const Args& a, int u) {
    const int tid = threadIdx.x; const int n = u % NCH, h = (u / NCH) % GH, b = u / (NCH * GH); const size_t m0 = (size_t)b * SEQ + (size_t)n * GCH;
    const bf16* Z = (const bf16*)(a.ws + WS_Z); const float* GLR = (const float*)(a.ws + WS_GLR);
    if (tid < 256) P.glr = *(const f32x4*)(GLR + m0 * 16 + tid * 4);
    if (tid < 384) { const int j = tid / 24, c4 = (tid % 24) * 4; P.gw = *(const f32x4*)(a.gla_gate_w + j * (GH * GDK) + h * GDK + c4); }
#pragma unroll
    for (int j = 0; j < 2; ++j) { const int i = tid + NTHREADS * j; if (i < 64 * 12) { const int t = i / 12, c8 = (i % 12) * 8; P.q[j] = *(const u32x4*)(Z + (m0 + t) * NA + ZA_Q + h * GDK + c8); P.k[j] = *(const u32x4*)(Z + (m0 + t) * NA + ZA_K + h * GDK + c8); } }
#pragma unroll
    for (int j = 0; j < 3; ++j) { const int i = tid + NTHREADS * j, t = i / 24, ch = i % 24; P.v[j] = *(const u32x4*)(Z + (m0 + t) * NA + ZA_V + h * GDV + ch * 8); }
}
__device__ __forceinline__ void gla_chunk_kv(const Args& a, LAS unsigned char* lds) {
    const int tid = threadIdx.x, lane = tid & 63, wave = tid >> 6, fr = lane & 15, fq = lane >> 4;
    bf16* Z = (bf16*)(a.ws + WS_Z); bf16* KV = (bf16*)(a.ws + GK_KV); float* DECB = (float*)(a.ws + GK_DEC);
    LAS float* B32 = (LAS float*)(lds + GL_B); LAS unsigned char* KE = lds + GL_KD; LAS unsigned char* VT = lds + GL_VT;
    LAS float* GLT = (LAS float*)(lds + GL_GLR); LAS float* GW = (LAS float*)(lds + GL_GW); LAS float* GT = (LAS float*)(lds + GL_GT); LAS float* EL = (LAS float*)(lds + GL_SSQ);
    constexpr int NU = NB * GH * NCH;
    G1Pref P; int u = blockIdx.x; if (u < NU) g1_issue(P, a, u);
    for (; u < NU; u += gridDim.x) { const int n = u % NCH, h = (u / NCH) % GH, b = u / (NCH * GH); const size_t m0 = (size_t)b * SEQ + (size_t)n * GCH;
        __syncthreads();
        if (tid < 256) *(LAS f32x4*)(GLT + tid * 4) = P.glr;
        if (tid < 384) *(LAS f32x4*)(GW + tid * 4) = P.gw;
        __syncthreads();
        const int c = tid % GDK, rg = tid / GDK;
        if (tid < 4 * GDK) { float gw[16];
#pragma unroll
            for (int j = 0; j < 16; ++j) gw[j] = GW[j * GDK + c];
            const float bias = a.gla_gate_b[h * GDK + c]; float run = 0.f;
#pragma unroll 4
            for (int tt = 0; tt < 16; ++tt) { const int t = rg * 16 + tt; float lg = bias;
#pragma unroll
                for (int q = 0; q < 4; ++q) { const f32x4 g = *(LAS const f32x4*)(GLT + t * 16 + 4 * q); lg += g[0] * gw[4 * q] + g[1] * gw[4 * q + 1] + g[2] * gw[4 * q + 2] + g[3] * gw[4 * q + 3]; }
                const float ls = (fminf(lg, 0.f) - __logf(1.0f + __expf(-fabsf(lg)))) * (1.0f / 16.0f); run += ls; B32[t * GDK + c] = run; }
            GT[rg * GDK + c] = run; }
        __syncthreads();
        if (tid < 4 * GDK) { float pre = 0.f; for (int r = 0; r < rg; ++r) pre += GT[r * GDK + c];
            if (rg > 0) {
#pragma unroll 4
                for (int tt = 0; tt < 16; ++tt) B32[(rg * 16 + tt) * GDK + c] += pre; }
            if (rg == 3) { const float el = __expf(B32[63 * GDK + c]); EL[c] = el; DECB[(size_t)u * GDK + c] = el; } }
        __syncthreads();
#pragma unroll
        for (int j = 0; j < 2; ++j) { const int i = tid + NTHREADS * j; if (i < 64 * 12) { const int t = i / 12, c8 = (i % 12) * 8; float fqv[8], fkv[8], fke[8];
#pragma unroll
            for (int e = 0; e < 4; ++e) { fqv[2 * e] = __uint_as_float(P.q[j][e] << 16); fqv[2 * e + 1] = __uint_as_float(P.q[j][e] & 0xffff0000u); fkv[2 * e] = __uint_as_float(P.k[j][e] << 16); fkv[2 * e + 1] = __uint_as_float(P.k[j][e] & 0xffff0000u); }
#pragma unroll
            for (int e = 0; e < 8; ++e) { const float eb = __expf(B32[t * GDK + c8 + e]), ei = __builtin_amdgcn_rcpf(eb); fqv[e] *= eb; fkv[e] *= ei; fke[e] = fkv[e] * EL[c8 + e]; }
            u32x4 o; o.x = cvtpk(fqv[0], fqv[1]); o.y = cvtpk(fqv[2], fqv[3]); o.z = cvtpk(fqv[4], fqv[5]); o.w = cvtpk(fqv[6], fqv[7]); *(u32x4*)(Z + (m0 + t) * NA + ZA_Q + h * GDK + c8) = o;
            o.x = cvtpk(fkv[0], fkv[1]); o.y = cvtpk(fkv[2], fkv[3]); o.z = cvtpk(fkv[4], fkv[5]); o.w = cvtpk(fkv[6], fkv[7]); *(u32x4*)(Z + (m0 + t) * NA + ZA_K + h * GDK + c8) = o;
            o.x = cvtpk(fke[0], fke[1]); o.y = cvtpk(fke[2], fke[3]); o.z = cvtpk(fke[4], fke[5]); o.w = cvtpk(fke[6], fke[7]); *(LAS u32x4*)(KE + t * QSTR + c8 * 2) = o; } }
#pragma unroll
        for (int j = 0; j < 3; ++j) { const int i = tid + NTHREADS * j, t = i / 24, ch = i % 24; *(LAS u32x4*)(VT + t * VSTR + ch * 16) = P.v[j]; }
        if (u + (int)gridDim.x < NU) g1_issue(P, a, u + gridDim.x);
        __syncthreads();
#pragma unroll 1
        for (int i = 0; i < 9; ++i) { const int bi = wave * 9 + i, cb = bi / 12, dvb = bi % 12; f32x4 acc = {0.f, 0.f, 0.f, 0.f};
#pragma unroll
            for (int ks = 0; ks < 2; ++ks) acc = MFMA16(tr_frag(VT, VSTR, 32 * ks, 16 * dvb, fr, fq), tr_frag(KE, QSTR, 32 * ks, 16 * cb, fr, fq), acc);
            u32x2 w; w.x = cvtpk(acc[0], acc[1]); w.y = cvtpk(acc[2], acc[3]);
            *(u32x2*)(KV + (size_t)u * (GDK * GDV) + (size_t)(16 * cb + fr) * GDV + 16 * dvb + 4 * fq) = w; }
    }
}
__device__ __forceinline__ void gla_scan(const Args& a, int skip) {
    const bf16* KV = (const bf16*)(a.ws + GK_KV); const float* DECB = (const float*)(a.ws + GK_DEC); bf16* ST = (bf16*)(a.ws + GK_ST);
    constexpr int NQ = NB * GH * GDK * (GDV / 4); const int nblk = (int)gridDim.x - skip, bi = (int)blockIdx.x - skip, QPB = (NQ + nblk - 1) / nblk;
    if (bi < 0) return;
    const int qend = (bi + 1) * QPB < NQ ? (bi + 1) * QPB : NQ;
    for (int q = bi * QPB + (int)threadIdx.x; q < qend; q += NTHREADS) {
        const int dv4 = q % (GDV / 4), c = (q / (GDV / 4)) % GDK, bh = q / ((GDV / 4) * GDK);
        f32x4 S = {0.f, 0.f, 0.f, 0.f};
        for (int n0 = 0; n0 < NCH; n0 += 16) { u32x2 kv[16]; float d[16];
#pragma unroll
            for (int i = 0; i < 16; ++i) { const size_t u = (size_t)bh * NCH + n0 + i; kv[i] = *(const u32x2*)(KV + u * (GDK * GDV) + (size_t)c * GDV + 4 * dv4); d[i] = DECB[u * GDK + c]; }
#pragma unroll
            for (int i = 0; i < 16; ++i) { const size_t u = (size_t)bh * NCH + n0 + i; u32x2 w; w.x = cvtpk(S[0], S[1]); w.y = cvtpk(S[2], S[3]); *(u32x2*)(ST + u * (GDK * GDV) + (size_t)c * GDV + 4 * dv4) = w;
                const f32x4 k4 = {__uint_as_float(kv[i].x << 16), __uint_as_float(kv[i].x & 0xffff0000u), __uint_as_float(kv[i].y << 16), __uint_as_float(kv[i].y & 0xffff0000u)}; S = S * d[i] + k4; } }
    }
}
struct G3Pref { u32x4 q[2], k[2], v[3], s[5]; };
__device__ __forceinline__ void g3_issue(G3Pref& P, const Args& a, int u) {
    const int tid = threadIdx.x; const int n = u % NCH, h = (u / NCH) % GH, b = u / (NCH * GH); const size_t m0 = (size_t)b * SEQ + (size_t)n * GCH;
    const bf16* Z = (const bf16*)(a.ws + WS_Z); const bf16* ST = (const bf16*)(a.ws + GK_ST);
#pragma unroll
    for (int j = 0; j < 2; ++j) { const int i = tid + NTHREADS * j; if (i < 64 * 12) { const int t = i / 12, c8 = (i % 12) * 8; P.q[j] = *(const u32x4*)(Z + (m0 + t) * NA + ZA_Q + h * GDK + c8); P.k[j] = *(const u32x4*)(Z + (m0 + t) * NA + ZA_K + h * GDK + c8); } }
#pragma unroll
    for (int j = 0; j < 3; ++j) { const int i = tid + NTHREADS * j, t = i / 24, ch = i % 24; P.v[j] = *(const u32x4*)(Z + (m0 + t) * NA + ZA_V + h * GDV + ch * 8); }
#pragma unroll
    for (int j = 0; j < 5; ++j) { const int i = tid + NTHREADS * j; if (i < GDK * 24) { const int c = i / 24, ch = i % 24; P.s[j] = *(const u32x4*)(ST + (size_t)u * (GDK * GDV) + (size_t)c * GDV + ch * 8); } }
}
__device__ __forceinline__ void gla_output(const Args& a, LAS unsigned char* lds) {
    const int tid = threadIdx.x, lane = tid & 63, wave = tid >> 6, fr = lane & 15, fq = lane >> 4, tb = wave & 3, dh = wave >> 2;
    const bf16* Z = (const bf16*)(a.ws + WS_Z); bf16* MIX = (bf16*)(a.ws + WS_MIX);
    LAS unsigned char* QD = lds + GL_QD; LAS unsigned char* KD = lds + GL_KD; LAS unsigned char* VT = lds + GL_VT; LAS unsigned char* SS = lds + GL_ST; LAS float* SSQ = (LAS float*)(lds + GL_SSQ);
    constexpr int NU = NB * GH * NCH;
    G3Pref P; int u = blockIdx.x; if (u < NU) g3_issue(P, a, u);
    for (; u < NU; u += gridDim.x) { const int n = u % NCH, h = (u / NCH) % GH, b = u / (NCH * GH); const size_t m0 = (size_t)b * SEQ + (size_t)n * GCH;
        __syncthreads();
#pragma unroll
        for (int j = 0; j < 2; ++j) { const int i = tid + NTHREADS * j; if (i < 64 * 12) { const int t = i / 12, c8 = (i % 12) * 8; *(LAS u32x4*)(QD + t * QSTR + c8 * 2) = P.q[j]; *(LAS u32x4*)(KD + t * QSTR + c8 * 2) = P.k[j]; } }
#pragma unroll
        for (int j = 0; j < 3; ++j) { const int i = tid + NTHREADS * j, t = i / 24, ch = i % 24; *(LAS u32x4*)(VT + t * VSTR + ch * 16) = P.v[j]; }
#pragma unroll
        for (int j = 0; j < 5; ++j) { const int i = tid + NTHREADS * j; if (i < GDK * 24) { const int c = i / 24, ch = i % 24; *(LAS u32x4*)(SS + c * VSTR + ch * 16) = P.s[j]; } }
        if (u + (int)gridDim.x < NU) g3_issue(P, a, u + gridDim.x);
        const size_t mr = m0 + 16 * tb + fr; u32x2 rr[6];
#pragma unroll
        for (int i = 0; i < 6; ++i) rr[i] = *(const u32x2*)(Z + mr * NA + ZA_R + h * GDV + 16 * (6 * dh + i) + 4 * fq);
        __syncthreads();
        f32x4 sacc[4];
#pragma unroll
        for (int sb = 0; sb < 4; ++sb) { sacc[sb] = (f32x4){0.f, 0.f, 0.f, 0.f};
            if (sb <= tb) {
#pragma unroll
                for (int ks = 0; ks < 3; ++ks) sacc[sb] = MFMA16(row_frag(KD, QSTR, 16 * sb, 32 * ks, fr, fq), row_frag(QD, QSTR, 16 * tb, 32 * ks, fr, fq), sacc[sb]);
                if (sb == tb) {
#pragma unroll
                    for (int r = 0; r < 4; ++r) if (4 * fq + r > fr) sacc[sb][r] = 0.f; } } }
        const bf16x8 pb0 = pack8(sacc[0], sacc[1]), pb1 = pack8(sacc[2], sacc[3]);
        bf16x8 qb[3];
#pragma unroll
        for (int ks = 0; ks < 3; ++ks) qb[ks] = row_frag(QD, QSTR, 16 * tb, 32 * ks, fr, fq);
        f32x4 oacc[6]; float ssq = 0.f;
#pragma unroll
        for (int i = 0; i < 6; ++i) { const int db = 6 * dh + i; f32x4 acc = {0.f, 0.f, 0.f, 0.f};
            acc = MFMA16(tr_frag_perm(VT, VSTR, 0, 16 * db, fr, fq), pb0, acc);
            if (tb >= 2) acc = MFMA16(tr_frag_perm(VT, VSTR, 32, 16 * db, fr, fq), pb1, acc);
#pragma unroll
            for (int ks = 0; ks < 3; ++ks) acc = MFMA16(tr_frag(SS, VSTR, 32 * ks, 16 * db, fr, fq), qb[ks], acc);
            oacc[i] = acc; ssq += (acc[0] * acc[0] + acc[1] * acc[1]) + (acc[2] * acc[2] + acc[3] * acc[3]); }
        ssq += __shfl_xor(ssq, 16); ssq += __shfl_xor(ssq, 32);
        if (fq == 0) SSQ[dh * 64 + 16 * tb + fr] = ssq;
        __syncthreads();
        const float rs = rsqrtf((SSQ[16 * tb + fr] + SSQ[64 + 16 * tb + fr]) * (1.0f / GDV) + EPS);
#pragma unroll
        for (int i = 0; i < 6; ++i) { const int dv = 16 * (6 * dh + i) + 4 * fq; const f32x4 gn = *(const f32x4*)(a.gla_out_norm + dv);
            const float r0 = __uint_as_float(rr[i].x << 16), r1 = __uint_as_float(rr[i].x & 0xffff0000u), r2 = __uint_as_float(rr[i].y << 16), r3 = __uint_as_float(rr[i].y & 0xffff0000u);
            const f32x4 o = oacc[i] * rs * gn; u32x2 w; w.x = cvtpk(o[0] * silu_f(r0), o[1] * silu_f(r1)); w.y = cvtpk(o[2] * silu_f(r2), o[3] * silu_f(r3));
            *(u32x2*)(MIX + mr * DM + h * GDV + dv) = w; }
    }
}


constexpr int GGC = 8, GNG = NCH / GGC;
constexpr size_t G2_AGG = WS_GK, G2_GST = WS_GK + 32 * MiB, G2_GD = WS_GK + 64 * MiB;
constexpr int GL_EL = GL_SSQ + 512;
__device__ __forceinline__ int gla2_chunk(int unit, int ci) { return (unit / GNG) * NCH + (unit % GNG) * GGC + ci; }
__device__ __forceinline__ void gla2_pass_a(const Args& a, LAS unsigned char* lds) {
    const int tid = threadIdx.x, lane = tid & 63, wave = tid >> 6, fr = lane & 15, fq = lane >> 4;
    bf16* Z = (bf16*)(a.ws + WS_Z); float* AGG = (float*)(a.ws + G2_AGG); float* GD = (float*)(a.ws + G2_GD); float* DECB = (float*)(a.ws + GK_DEC);
    LAS float* B32 = (LAS float*)(lds + GL_B); LAS unsigned char* KE = lds + GL_KD; LAS unsigned char* VT = lds + GL_VT;
    LAS float* GLT = (LAS float*)(lds + GL_GLR); LAS float* GW = (LAS float*)(lds + GL_GW); LAS float* GT = (LAS float*)(lds + GL_GT); LAS float* EL = (LAS float*)(lds + GL_EL);
    constexpr int NUNIT = NB * GH * GNG;
    for (int unit = blockIdx.x; unit < NUNIT; unit += gridDim.x) {
        f32x4 agg[9];
#pragma unroll
        for (int i = 0; i < 9; ++i) agg[i] = (f32x4){0.f, 0.f, 0.f, 0.f};
        float gd = 1.0f;
        G1Pref P; g1_issue(P, a, gla2_chunk(unit, 0));
#pragma unroll 1
        for (int ci = 0; ci < GGC; ++ci) { const int u = gla2_chunk(unit, ci); const int n = u % NCH, h = (u / NCH) % GH, b = u / (NCH * GH); const size_t m0 = (size_t)b * SEQ + (size_t)n * GCH;
            __syncthreads();
            if (tid < 256) *(LAS f32x4*)(GLT + tid * 4) = P.glr;
            if (tid < 384) *(LAS f32x4*)(GW + tid * 4) = P.gw;
            __syncthreads();
            const int c = tid % GDK, rg = tid / GDK;
            if (tid < 4 * GDK) { float gw[16];
#pragma unroll
                for (int j = 0; j < 16; ++j) gw[j] = GW[j * GDK + c];
                const float bias = a.gla_gate_b[h * GDK + c]; float run = 0.f;
#pragma unroll 4
                for (int tt = 0; tt < 16; ++tt) { const int t = rg * 16 + tt; float lg = bias;
#pragma unroll
                    for (int q = 0; q < 4; ++q) { const f32x4 g = *(LAS const f32x4*)(GLT + t * 16 + 4 * q); lg += g[0] * gw[4 * q] + g[1] * gw[4 * q + 1] + g[2] * gw[4 * q + 2] + g[3] * gw[4 * q + 3]; }
                    const float ls = (fminf(lg, 0.f) - __logf(1.0f + __expf(-fabsf(lg)))) * (1.0f / 16.0f); run += ls; B32[t * GDK + c] = run; }
                GT[rg * GDK + c] = run; }
            __syncthreads();
            if (tid < 4 * GDK) { float pre = 0.f; for (int r = 0; r < rg; ++r) pre += GT[r * GDK + c];
                if (rg > 0) {
#pragma unroll 4
                    for (int tt = 0; tt < 16; ++tt) B32[(rg * 16 + tt) * GDK + c] += pre; }
                if (rg == 3) { const float el = __expf(B32[63 * GDK + c]); EL[c] = el; DECB[(size_t)u * GDK + c] = el; } }
            __syncthreads();
            if (tid < GDK) gd *= EL[tid];
#pragma unroll
            for (int j = 0; j < 2; ++j) { const int i = tid + NTHREADS * j; if (i < 64 * 12) { const int t = i / 12, c8 = (i % 12) * 8; float fqv[8], fkv[8], fke[8];
#pragma unroll
                for (int e = 0; e < 4; ++e) { fqv[2 * e] = __uint_as_float(P.q[j][e] << 16); fqv[2 * e + 1] = __uint_as_float(P.q[j][e] & 0xffff0000u); fkv[2 * e] = __uint_as_float(P.k[j][e] << 16); fkv[2 * e + 1] = __uint_as_float(P.k[j][e] & 0xffff0000u); }
#pragma unroll
                for (int e = 0; e < 8; ++e) { const float eb = __expf(B32[t * GDK + c8 + e]), ei = __builtin_amdgcn_rcpf(eb); fqv[e] *= eb; fkv[e] *= ei; fke[e] = fkv[e] * EL[c8 + e]; }
                u32x4 o; o.x = cvtpk(fqv[0], fqv[1]); o.y = cvtpk(fqv[2], fqv[3]); o.z = cvtpk(fqv[4], fqv[5]); o.w = cvtpk(fqv[6], fqv[7]); *(u32x4*)(Z + (m0 + t) * NA + ZA_Q + h * GDK + c8) = o;
                o.x = cvtpk(fkv[0], fkv[1]); o.y = cvtpk(fkv[2], fkv[3]); o.z = cvtpk(fkv[4], fkv[5]); o.w = cvtpk(fkv[6], fkv[7]); *(u32x4*)(Z + (m0 + t) * NA + ZA_K + h * GDK + c8) = o;
                o.x = cvtpk(fke[0], fke[1]); o.y = cvtpk(fke[2], fke[3]); o.z = cvtpk(fke[4], fke[5]); o.w = cvtpk(fke[6], fke[7]); *(LAS u32x4*)(KE + t * QSTR + c8 * 2) = o; } }
#pragma unroll
            for (int j = 0; j < 3; ++j) { const int i = tid + NTHREADS * j, t = i / 24, ch = i % 24; *(LAS u32x4*)(VT + t * VSTR + ch * 16) = P.v[j]; }
            if (ci + 1 < GGC) g1_issue(P, a, gla2_chunk(unit, ci + 1));
            __syncthreads();
            { LAS const unsigned char* vp = VT + (8 * fq + (fr >> 2)) * VSTR + (48 * (wave >> 1) + 4 * (fr & 3)) * 2; LAS const unsigned char* kp = KE + (8 * fq + (fr >> 2)) * QSTR + (48 * (wave & 1) + 4 * (fr & 3)) * 2;
#pragma unroll
              for (int j = 0; j < 3; ++j) { const float el = EL[48 * (wave & 1) + 16 * j + fr];
#pragma unroll
                for (int k = 0; k < 3; ++k) { f32x4 acc = agg[3 * j + k] * el;
#pragma unroll
                    for (int ks = 0; ks < 2; ++ks) acc = MFMA16(tr2(vp + 32 * ks * VSTR + 32 * k, VSTR), tr2(kp + 32 * ks * QSTR + 32 * j, QSTR), acc);
                    agg[3 * j + k] = acc; }
                __builtin_amdgcn_sched_barrier(0); } }
        }
#pragma unroll
        for (int j = 0; j < 3; ++j)
#pragma unroll
            for (int k = 0; k < 3; ++k) *(f32x4*)(AGG + (size_t)unit * (GDK * GDV) + (size_t)(48 * (wave & 1) + 16 * j + fr) * GDV + 48 * (wave >> 1) + 16 * k + 4 * fq) = agg[3 * j + k];
        if (tid < GDK) GD[(size_t)unit * GDK + tid] = gd;
    }
}
__device__ __forceinline__ void gla2_scan(const Args& a, int skip) {
    const float* AGG = (const float*)(a.ws + G2_AGG); const float* GD = (const float*)(a.ws + G2_GD); float* GST = (float*)(a.ws + G2_GST);
    constexpr int NQ = NB * GH * GDK * (GDV / 4); const int nblk = (int)gridDim.x - skip, bi = (int)blockIdx.x - skip, QPB = (NQ + nblk - 1) / nblk;
    if (bi < 0) return;
    const int qend = (bi + 1) * QPB < NQ ? (bi + 1) * QPB : NQ;
    for (int q = bi * QPB + (int)threadIdx.x; q < qend; q += NTHREADS) { const int dv4 = q % (GDV / 4), c = (q / (GDV / 4)) % GDK, bh = q / ((GDV / 4) * GDK);
        f32x4 kv[GNG]; float d[GNG];
#pragma unroll
        for (int g = 0; g < GNG; ++g) { const size_t un = (size_t)bh * GNG + g; kv[g] = *(const f32x4*)(AGG + un * (GDK * GDV) + (size_t)c * GDV + 4 * dv4); d[g] = GD[un * GDK + c]; }
        f32x4 S = {0.f, 0.f, 0.f, 0.f};
#pragma unroll
        for (int g = 0; g < GNG; ++g) { const size_t un = (size_t)bh * GNG + g; *(f32x4*)(GST + un * (GDK * GDV) + (size_t)c * GDV + 4 * dv4) = S; S = S * d[g] + kv[g]; } }
}
struct G3bPref { u32x4 q[2], k[2], v[3]; float el; };
__device__ __forceinline__ void g3b_issue(G3bPref& P, const Args& a, int u) {
    const int tid = threadIdx.x; const int n = u % NCH, h = (u / NCH) % GH, b = u / (NCH * GH); const size_t m0 = (size_t)b * SEQ + (size_t)n * GCH; const bf16* Z = (const bf16*)(a.ws + WS_Z);
#pragma unroll
    for (int j = 0; j < 2; ++j) { const int i = tid + NTHREADS * j; if (i < 64 * 12) { const int t = i / 12, c8 = (i % 12) * 8; P.q[j] = __builtin_nontemporal_load((const u32x4*)(Z + (m0 + t) * NA + ZA_Q + h * GDK + c8)); P.k[j] = __builtin_nontemporal_load((const u32x4*)(Z + (m0 + t) * NA + ZA_K + h * GDK + c8)); } }
#pragma unroll
    for (int j = 0; j < 3; ++j) { const int i = tid + NTHREADS * j, t = i / 24, ch = i % 24; P.v[j] = __builtin_nontemporal_load((const u32x4*)(Z + (m0 + t) * NA + ZA_V + h * GDV + ch * 8)); }
    if (tid < GDK) P.el = ((const float*)(a.ws + GK_DEC))[(size_t)u * GDK + tid];
}
__device__ __forceinline__ void gla2_pass_b(const Args& a, LAS unsigned char* lds) {
    const int tid = threadIdx.x, lane = tid & 63, wave = tid >> 6, fr = lane & 15, fq = lane >> 4, tb = wave & 3, dh = wave >> 2;
    const bf16* Z = (const bf16*)(a.ws + WS_Z); bf16* MIX = (bf16*)(a.ws + WS_MIX); const float* GST = (const float*)(a.ws + G2_GST);
    LAS unsigned char* QD = lds + GL_QD; LAS unsigned char* KD = lds + GL_KD; LAS unsigned char* VT = lds + GL_VT; LAS unsigned char* SS = lds + GL_ST; LAS float* SSQ = (LAS float*)(lds + GL_SSQ); LAS float* EL = (LAS float*)(lds + GL_EL);
    constexpr int NUNIT = NB * GH * GNG;
    for (int unit = blockIdx.x; unit < NUNIT; unit += gridDim.x) {
        f32x4 st[9];
#pragma unroll
        for (int i = 0; i < 9; ++i) { const int j = i / 3, k = i % 3; st[i] = *(const f32x4*)(GST + (size_t)unit * (GDK * GDV) + (size_t)(48 * (wave & 1) + 16 * j + fr) * GDV + 48 * (wave >> 1) + 16 * k + 4 * fq); }
        G3bPref P; g3b_issue(P, a, gla2_chunk(unit, 0));
#pragma unroll 1
        for (int ci = 0; ci < GGC; ++ci) { const int u = gla2_chunk(unit, ci); const int n = u % NCH, h = (u / NCH) % GH, b = u / (NCH * GH); const size_t m0 = (size_t)b * SEQ + (size_t)n * GCH;
            __syncthreads();
#pragma unroll
            for (int j = 0; j < 2; ++j) { const int i = tid + NTHREADS * j; if (i < 64 * 12) { const int t = i / 12, c8 = (i % 12) * 8; *(LAS u32x4*)(QD + t * QSTR + c8 * 2) = P.q[j]; *(LAS u32x4*)(KD + t * QSTR + c8 * 2) = P.k[j]; } }
#pragma unroll
            for (int j = 0; j < 3; ++j) { const int i = tid + NTHREADS * j, t = i / 24, ch = i % 24; *(LAS u32x4*)(VT + t * VSTR + ch * 16) = P.v[j]; }
            if (tid < GDK) EL[tid] = P.el;
#pragma unroll
            for (int i = 0; i < 9; ++i) { const int j = i / 3, k = i % 3; u32x2 w; w.x = cvtpk(st[i][0], st[i][1]); w.y = cvtpk(st[i][2], st[i][3]); *(LAS u32x2*)(SS + (48 * (wave & 1) + fr) * VSTR + (48 * (wave >> 1) + 4 * fq) * 2 + j * 16 * VSTR + k * 32) = w; }
            if (ci + 1 < GGC) g3b_issue(P, a, gla2_chunk(unit, ci + 1));
            const size_t mr = m0 + 16 * tb + fr; u32x2 rr[6];
#pragma unroll
            for (int i = 0; i < 6; ++i) rr[i] = __builtin_nontemporal_load((const u32x2*)(Z + mr * NA + ZA_R + h * GDV + 16 * (6 * dh + i) + 4 * fq));
            __syncthreads();
            f32x4 sacc[4];
#pragma unroll
            for (int sb = 0; sb < 4; ++sb) { sacc[sb] = (f32x4){0.f, 0.f, 0.f, 0.f};
                if (sb <= tb) {
#pragma unroll
                    for (int ks = 0; ks < 3; ++ks) sacc[sb] = MFMA16(row_frag(KD, QSTR, 16 * sb, 32 * ks, fr, fq), row_frag(QD, QSTR, 16 * tb, 32 * ks, fr, fq), sacc[sb]);
                    if (sb == tb) {
#pragma unroll
                        for (int r = 0; r < 4; ++r) if (4 * fq + r > fr) sacc[sb][r] = 0.f; } } }
            const bf16x8 pb0 = pack8(sacc[0], sacc[1]), pb1 = pack8(sacc[2], sacc[3]);
            bf16x8 qb[3];
#pragma unroll
            for (int ks = 0; ks < 3; ++ks) qb[ks] = row_frag(QD, QSTR, 16 * tb, 32 * ks, fr, fq);
            f32x4 oacc[6]; float ssq = 0.f;
            LAS const unsigned char* vpp = VT + (4 * fq + (fr >> 2)) * VSTR + (96 * dh + 4 * (fr & 3)) * 2; LAS const unsigned char* spp = SS + (8 * fq + (fr >> 2)) * VSTR + (96 * dh + 4 * (fr & 3)) * 2;
#pragma unroll
            for (int i = 0; i < 6; ++i) { f32x4 acc = {0.f, 0.f, 0.f, 0.f};
                acc = MFMA16(cat8(ds_tr(vpp + 32 * i), ds_tr(vpp + 32 * i + 16 * VSTR)), pb0, acc);
                if (tb >= 2) acc = MFMA16(cat8(ds_tr(vpp + 32 * VSTR + 32 * i), ds_tr(vpp + 48 * VSTR + 32 * i)), pb1, acc);
#pragma unroll
                for (int ks = 0; ks < 3; ++ks) acc = MFMA16(tr2(spp + 32 * ks * VSTR + 32 * i, VSTR), qb[ks], acc);
                oacc[i] = acc; ssq += (acc[0] * acc[0] + acc[1] * acc[1]) + (acc[2] * acc[2] + acc[3] * acc[3]); if (i & 1) __builtin_amdgcn_sched_barrier(0); }
            ssq += __shfl_xor(ssq, 16); ssq += __shfl_xor(ssq, 32);
            if (fq == 0) SSQ[dh * 64 + 16 * tb + fr] = ssq;
            { LAS const unsigned char* vp = VT + (8 * fq + (fr >> 2)) * VSTR + (48 * (wave >> 1) + 4 * (fr & 3)) * 2; LAS const unsigned char* kp = KD + (8 * fq + (fr >> 2)) * QSTR + (48 * (wave & 1) + 4 * (fr & 3)) * 2;
#pragma unroll
              for (int j = 0; j < 3; ++j) { const float el = EL[48 * (wave & 1) + 16 * j + fr];
#pragma unroll
                for (int k = 0; k < 3; ++k) { f32x4 acc = st[3 * j + k];
#pragma unroll
                    for (int ks = 0; ks < 2; ++ks) acc = MFMA16(tr2(vp + 32 * ks * VSTR + 32 * k, VSTR), tr2(kp + 32 * ks * QSTR + 32 * j, QSTR), acc);
                    st[3 * j + k] = acc * el; }
                __builtin_amdgcn_sched_barrier(0); } }
            __syncthreads();
            const float rs = rsqrtf((SSQ[16 * tb + fr] + SSQ[64 + 16 * tb + fr]) * (1.0f / GDV) + EPS);
#pragma unroll
            for (int i = 0; i < 6; ++i) { const int dv = 16 * (6 * dh + i) + 4 * fq; const f32x4 gn = *(const f32x4*)(a.gla_out_norm + dv);
                const float r0 = __uint_as_float(rr[i].x << 16), r1 = __uint_as_float(rr[i].x & 0xffff0000u), r2 = __uint_as_float(rr[i].y << 16), r3 = __uint_as_float(rr[i].y & 0xffff0000u);
                const f32x4 o = oacc[i] * rs * gn; u32x2 w; w.x = cvtpk(o[0] * silu_f(r0), o[1] * silu_f(r1)); w.y = cvtpk(o[2] * silu_f(r2), o[3] * silu_f(r3));
                *(u32x2*)(MIX + mr * DM + h * GDV + dv) = w; }
        }
    }
}

__device__ __forceinline__ void memkv_tiles(const Args& a, LAS unsigned char* lds) {
    const int tid = threadIdx.x, lane = tid & 63, wave = tid >> 6, fr = lane & 15, fq = lane >> 4; constexpr int STR = 528;
    LAS unsigned char* At = lds; LAS unsigned char* Bt = lds + 64 * STR;
    for (int u = blockIdx.x; u < 256; u += gridDim.x) { const int l = u >> 7, rt = (u & 127) >> 3, ct = u & 7;
        const bf16* A = (const bf16*)(a.ws + WS_MEMN) + (size_t)l * NB * NMEM * DM + (size_t)(64 * rt) * DM; const bf16* B = (const bf16*)(a.ws + WT_MKV) + (size_t)l * 512 * DM + (size_t)(64 * ct) * DM;
        u32x4 pa[4], pb[4];
#pragma unroll
        for (int i = 0; i < 4; ++i) { const int c = tid + NTHREADS * i, row = c >> 5, pc = c & 31; pa[i] = *(const u32x4*)(A + (size_t)row * DM + pc * 8); pb[i] = *(const u32x4*)(B + (size_t)row * DM + pc * 8); }
        f32x4 acc0 = {0.f, 0.f, 0.f, 0.f}, acc1 = acc0;
#pragma unroll 1
        for (int kc = 0; kc < 4; ++kc) {
            __syncthreads();
#pragma unroll
            for (int i = 0; i < 4; ++i) { const int c = tid + NTHREADS * i, row = c >> 5, pc = c & 31; *(LAS u32x4*)(At + row * STR + pc * 16) = pa[i]; *(LAS u32x4*)(Bt + row * STR + pc * 16) = pb[i]; }
            if (kc < 3) {
#pragma unroll
                for (int i = 0; i < 4; ++i) { const int c = tid + NTHREADS * i, row = c >> 5, pc = c & 31; pa[i] = *(const u32x4*)(A + (size_t)row * DM + 256 * (kc + 1) + pc * 8); pb[i] = *(const u32x4*)(B + (size_t)row * DM + 256 * (kc + 1) + pc * 8); } }
            __syncthreads();
#pragma unroll
            for (int ks = 0; ks < 8; ++ks) { const bf16x8 af = row_frag(At, STR, 16 * (wave >> 1), 32 * ks, fr, fq);
                acc0 = MFMA16(row_frag(Bt, STR, 32 * (wave & 1), 32 * ks, fr, fq), af, acc0); acc1 = MFMA16(row_frag(Bt, STR, 32 * (wave & 1) + 16, 32 * ks, fr, fq), af, acc1); }
        }
        bf16* O = (bf16*)(a.ws + WS_MEMKV) + (size_t)l * NB * NMEM * 512 + (size_t)(64 * rt + 16 * (wave >> 1) + fr) * 512 + 64 * ct + 32 * (wave & 1) + 4 * fq;
        u32x2 w; w.x = cvtpk(acc0[0], acc0[1]); w.y = cvtpk(acc0[2], acc0[3]); *(u32x2*)O = w;
        w.x = cvtpk(acc1[0], acc1[1]); w.y = cvtpk(acc1[2], acc1[3]); *(u32x2*)(O + 16) = w; }
}

template <bool DUAL, class AF, class BF, class B2F, class EF>
__device__ __forceinline__ void simple_gemm(LAS float* sm, int Mrows, int N, int K, AF a_at, BF b_at, B2F b2_at, EF epi) {
    const int tid = threadIdx.x, ty = tid >> 4, tx = tid & 15;
    LAS float* As = sm; LAS float* Bs = sm + 16 * 132; LAS float* B2 = Bs + 16 * 68;
    const int tm = (Mrows + 127) / 128, tn = (N + 63) / 64;
    for (int t = blockIdx.x; t < tm * tn; t += gridDim.x) {
        const int m0 = (t / tn) * 128, n0 = (t % tn) * 64;
        float acc[4][4], acc2[4][4];
#pragma unroll
        for (int i = 0; i < 4; ++i)
#pragma unroll
            for (int j = 0; j < 4; ++j) { acc[i][j] = 0.f; acc2[i][j] = 0.f; }
        for (int k0 = 0; k0 < K; k0 += 16) {
#pragma unroll
            for (int i = 0; i < 4; ++i) { const int idx = tid + 512 * i, kk = idx & 15, mm = idx >> 4; As[kk * 132 + mm] = (m0 + mm < Mrows) ? a_at(m0 + mm, k0 + kk) : 0.f; }
#pragma unroll
            for (int i = 0; i < 2; ++i) { const int idx = tid + 512 * i, nn = idx & 63, kk = idx >> 6; const bool ok = n0 + nn < N;
                Bs[kk * 68 + nn] = ok ? b_at(k0 + kk, n0 + nn, m0) : 0.f; if (DUAL) B2[kk * 68 + nn] = ok ? b2_at(k0 + kk, n0 + nn, m0) : 0.f; }
            __syncthreads();
#pragma unroll
            for (int kk = 0; kk < 16; ++kk) {
                const f32x4 a = *(const LAS f32x4*)(As + kk * 132 + 4 * ty), b = *(const LAS f32x4*)(Bs + kk * 68 + 4 * tx);
                f32x4 b2 = b; if (DUAL) b2 = *(const LAS f32x4*)(B2 + kk * 68 + 4 * tx);
#pragma unroll
                for (int i = 0; i < 4; ++i)
#pragma unroll
                    for (int j = 0; j < 4; ++j) { acc[i][j] += a[i] * b[j]; if (DUAL) acc2[i][j] += a[i] * b2[j]; }
            }
            __syncthreads();
        }
#pragma unroll
        for (int i = 0; i < 4; ++i)
#pragma unroll
            for (int j = 0; j < 4; ++j) { const int m = m0 + 4 * ty + i, n = n0 + 4 * tx + j; if (m < Mrows && n < N) epi(m, n, acc[i][j], acc2[i][j]); }
    }
}

__constant__ float c_inv_freq[8] = {1.0f, 0.1939227432012558f, 0.03760603070259094f, 0.007292664609849453f, 0.0014142135623842478f, 0.00027424818836152554f, 5.318296098266728e-05f, 1.0313386155758053e-05f};

template <bool WITH_GLR>
__device__ __forceinline__ void prep_rows(const Args& a, LAS unsigned char* lds) {
    const int lane = threadIdx.x & 63, wave = threadIdx.x >> 6, gw = blockIdx.x * NWAVES + wave, NGW = gridDim.x * NWAVES;
    bf16* XB = (bf16*)(a.ws + WS_XB); float* SS0 = (float*)(a.ws + WS_SS0); float* GLR = (float*)(a.ws + WS_GLR);
    LAS float* wl = (LAS float*)lds;
    if (WITH_GLR) { __syncthreads();
        for (int idx = threadIdx.x; idx < 16 * DM; idx += NTHREADS) { const int k = idx >> 4, j = idx & 15; wl[j * DM + k] = a.w_in_a[(size_t)k * WINA + 1536 + j] * a.mix_norm[k]; }
        __syncthreads(); }
    f32x4 nxt[4];
    if (gw < M) { const f32x4* xr = (const f32x4*)(a.x + (size_t)gw * DM) + lane;
#pragma unroll
        for (int j = 0; j < 4; ++j) nxt[j] = __builtin_nontemporal_load(xr + 64 * j); }
    for (int m = gw; m < M; m += NGW) {
        f32x4 v[4]; float s = 0.f;
#pragma unroll
        for (int j = 0; j < 4; ++j) { v[j] = nxt[j]; s += (v[j].x * v[j].x + v[j].y * v[j].y) + (v[j].z * v[j].z + v[j].w * v[j].w); }
        if (m + NGW < M) { const f32x4* xr = (const f32x4*)(a.x + (size_t)(m + NGW) * DM) + lane;
#pragma unroll
            for (int j = 0; j < 4; ++j) nxt[j] = __builtin_nontemporal_load(xr + 64 * j); }
        s = wave_sum(s);
        u32x2* o = (u32x2*)(XB + (size_t)m * DM) + lane;
#pragma unroll
        for (int j = 0; j < 4; ++j) { u32x2 w; w.x = pk2(v[j].x, v[j].y); w.y = pk2(v[j].z, v[j].w); o[64 * j] = w; }
        if (lane == 0) SS0[m] = s;
        if (WITH_GLR) { const float rs = rsqrtf(s * (1.0f / DM) + EPS); float p[16];
#pragma unroll
            for (int o = 0; o < 16; ++o) { float acc = 0.f;
#pragma unroll
                for (int j = 0; j < 4; ++j) { const f32x4 w = *(const LAS f32x4*)(wl + o * DM + 4 * lane + 256 * j); acc += (v[j].x * w.x + v[j].y * w.y) + (v[j].z * w.z + v[j].w * w.w); }
                p[o] = acc; if (o & 1) asm volatile("" ::: "memory"); }
            float q8[8], q4[4], q2[2], q1;
            { const bool hi = (lane & 32) != 0;
#pragma unroll
              for (int i = 0; i < 8; ++i) { const float keep = hi ? p[i + 8] : p[i], give = hi ? p[i] : p[i + 8]; q8[i] = keep + __shfl_xor(give, 32); } }
            { const bool hi = (lane & 16) != 0;
#pragma unroll
              for (int i = 0; i < 4; ++i) { const float keep = hi ? q8[i + 4] : q8[i], give = hi ? q8[i] : q8[i + 4]; q4[i] = keep + __shfl_xor(give, 16); } }
            { const bool hi = (lane & 8) != 0;
#pragma unroll
              for (int i = 0; i < 2; ++i) { const float keep = hi ? q4[i + 2] : q4[i], give = hi ? q4[i] : q4[i + 2]; q2[i] = keep + __shfl_xor(give, 8); } }
            { const bool hi = (lane & 4) != 0; const float keep = hi ? q2[1] : q2[0], give = hi ? q2[0] : q2[1]; q1 = keep + __shfl_xor(give, 4); }
            q1 += __shfl_xor(q1, 2); q1 += __shfl_xor(q1, 1);
            if ((lane & 3) == 0) { const int o = 8 * ((lane >> 5) & 1) + 4 * ((lane >> 4) & 1) + 2 * ((lane >> 3) & 1) + ((lane >> 2) & 1); GLR[m * 16 + o] = q1 * rs; } }
    }
    if (WITH_GLR) __syncthreads();
    bf16* MEMN = (bf16*)(a.ws + WS_MEMN);
    for (int r = gw; r < NB * NMEM; r += NGW) {
        const f32x4* xr = (const f32x4*)(a.mem + (size_t)r * DM) + lane; f32x4 v[4]; float s = 0.f;
#pragma unroll
        for (int j = 0; j < 4; ++j) { v[j] = xr[64 * j]; s += (v[j].x * v[j].x + v[j].y * v[j].y) + (v[j].z * v[j].z + v[j].w * v[j].w); }
        const float rs = rsqrtf(wave_sum(s) * (1.0f / DM) + EPS);
#pragma unroll
        for (int l = 0; l < 2; ++l) { u32x2* o = (u32x2*)(MEMN + ((size_t)l * NB * NMEM + r) * DM) + lane;
#pragma unroll
            for (int j = 0; j < 4; ++j) { const f32x4 g = *((const f32x4*)(a.mem_norm + l * DM) + lane + 64 * j); u32x2 w; w.x = pk2(v[j].x * rs * g.x, v[j].y * rs * g.y); w.y = pk2(v[j].z * rs * g.z, v[j].w * rs * g.w); o[64 * j] = w; } }
    }
    float* ROPE = (float*)(a.ws + WS_ROPE);
    for (int idx = blockIdx.x * NTHREADS + threadIdx.x; idx < M * 8; idx += gridDim.x * NTHREADS) {
        const int m = idx >> 3, i = idx & 7; const float ang = (float)a.positions[m] * c_inv_freq[i];
        const double t = (double)ang * 0.15915494309189533577; const float fr = (float)(t - floor(t));
        ROPE[m * 16 + i] = __builtin_amdgcn_cosf(fr); ROPE[m * 16 + 8 + i] = __builtin_amdgcn_sinf(fr);
    }
}

__device__ __forceinline__ void s_inproj_a(const Args& a, LAS float* sm) {
    const bf16* XB = (const bf16*)(a.ws + WS_XB); const float* SS0 = (const float*)(a.ws + WS_SS0); bf16* Z = (bf16*)(a.ws + WS_Z); float* GLR = (float*)(a.ws + WS_GLR);
    const float* W = a.w_in_a; const float* g = a.mix_norm;
    simple_gemm<false>(sm, M, WINA, DM,
        [&](int m, int k) { return bf2f(XB[(size_t)m * DM + k]) * g[k]; },
        [&](int k, int n, int) { return W[(size_t)k * WINA + n]; }, [&](int, int, int) { return 0.f; },
        [&](int m, int n, float acc, float) { const float v = acc * rsqrtf(SS0[m] * (1.0f / DM) + EPS);
            if (n < 384) Z[(size_t)m * NA + ZA_Q + n] = (bf16)f2bf(v * 0.10206207261596575f);
            else if (n < 768) Z[(size_t)m * NA + ZA_K + (n - 384)] = (bf16)f2bf(v);
            else if (n < 1536) Z[(size_t)m * NA + ZA_V + (n - 768)] = (bf16)f2bf(v);
            else if (n < 1552) GLR[m * 16 + (n - 1536)] = v;
            else if (n < 2320) Z[(size_t)m * NA + ZA_R + (n - 1552)] = (bf16)f2bf(v);
            else Z[(size_t)m * NA + ZA_QM + (n - 2320)] = (bf16)f2bf(v * QS); });
}
__device__ __forceinline__ void s_memkv(const Args& a, LAS float* sm) {
    const bf16* MEMN = (const bf16*)(a.ws + WS_MEMN); bf16* MEMKV = (bf16*)(a.ws + WS_MEMKV);
    for (int l = 0; l < 2; ++l) { const float* W = a.w_mem_kv + (size_t)l * DM * 512; const bf16* A = MEMN + (size_t)l * NB * NMEM * DM; bf16* O = MEMKV + (size_t)l * NB * NMEM * 512;
        simple_gemm<false>(sm, NB * NMEM, 512, DM, [&](int m, int k) { return bf2f(A[(size_t)m * DM + k]); }, [&](int k, int n, int) { return W[(size_t)k * 512 + n]; }, [&](int, int, int) { return 0.f; },
            [&](int m, int n, float acc, float) { O[(size_t)m * 512 + n] = (bf16)f2bf(acc); }); }
}
__device__ __forceinline__ void s_gla_alpha(const Args& a) {
    const float* GLR = (const float*)(a.ws + WS_GLR); float* ALPHA = (float*)(a.ws + GK_ALPHA);
    for (int idx = blockIdx.x * NTHREADS + threadIdx.x; idx < M * 384; idx += gridDim.x * NTHREADS) {
        const int m = idx / 384, c = idx % 384; float lg = a.gla_gate_b[c];
#pragma unroll
        for (int j = 0; j < 16; ++j) lg += GLR[m * 16 + j] * a.gla_gate_w[j * 384 + c];
        const float ls = fminf(lg, 0.f) - log1pf(__expf(-fabsf(lg)));
        ALPHA[idx] = __expf(ls * (1.0f / 16.0f));
    }
}
__device__ __forceinline__ void s_gla_rec(const Args& a) {
    const bf16* Z = (const bf16*)(a.ws + WS_Z); const float* ALPHA = (const float*)(a.ws + GK_ALPHA); float* ORAW = (float*)(a.ws + GK_ORAW);
    for (int item = blockIdx.x; item < NB * GH * 12; item += gridDim.x) {
        const int bh = item / 12, dvg = item % 12, b = bh / GH, h = bh % GH;
        if (threadIdx.x < 64) { const int dv = dvg * 16 + (threadIdx.x & 15), cp = threadIdx.x >> 4, c0 = cp * 24;
            float S[24];
#pragma unroll
            for (int c = 0; c < 24; ++c) S[c] = 0.f;
            for (int t = 0; t < SEQ; ++t) { const size_t m = (size_t)b * SEQ + t; const bf16* zr = Z + m * NA; const float* ar = ALPHA + m * 384 + h * GDK + c0;
                const float vv = bf2f(zr[ZA_V + h * GDV + dv]); float o = 0.f;
#pragma unroll
                for (int c = 0; c < 24; ++c) { S[c] = ar[c] * S[c] + bf2f(zr[ZA_K + h * GDK + c0 + c]) * vv; o += bf2f(zr[ZA_Q + h * GDK + c0 + c]) * S[c]; }
                o += __shfl_xor(o, 16); o += __shfl_xor(o, 32);
                if (cp == 0) ORAW[m * MAINW + h * GDV + dv] = o; }
        }
    }
}
__device__ __forceinline__ void s_gla_out(const Args& a) {
    const int lane = threadIdx.x & 63, gw = blockIdx.x * NWAVES + (threadIdx.x >> 6), NGW = gridDim.x * NWAVES;
    const bf16* Z = (const bf16*)(a.ws + WS_Z); const float* ORAW = (const float*)(a.ws + GK_ORAW); bf16* MIX = (bf16*)(a.ws + WS_MIX);
    for (int it = gw; it < M * GH; it += NGW) { const int m = it / GH, h = it % GH; float o[3]; float s = 0.f;
#pragma unroll
        for (int j = 0; j < 3; ++j) { o[j] = ORAW[(size_t)m * MAINW + h * GDV + lane + 64 * j]; s += o[j] * o[j]; }
        const float rs = rsqrtf(wave_sum(s) * (1.0f / GDV) + EPS);
#pragma unroll
        for (int j = 0; j < 3; ++j) { const int dv = lane + 64 * j; const float r = bf2f(Z[(size_t)m * NA + ZA_R + h * GDV + dv]);
            MIX[(size_t)m * DM + h * GDV + dv] = (bf16)f2bf(o[j] * rs * a.gla_out_norm[dv] * silu_f(r)); } }
}
__device__ __forceinline__ void s_memattn(const Args& a, int layer, int ldz, int qoff) {
    const int lane = threadIdx.x & 63, gw = blockIdx.x * NWAVES + (threadIdx.x >> 6), NGW = gridDim.x * NWAVES;
    const bf16* Z = (const bf16*)(a.ws + WS_Z); const bf16* KV = (const bf16*)(a.ws + WS_MEMKV) + (size_t)layer * NB * NMEM * 512; bf16* MIX = (bf16*)(a.ws + WS_MIX);
    for (int it = gw; it < M * MEMH; it += NGW) { const int m = it / MEMH, h = it % MEMH, b = m / SEQ; const bf16* q = Z + (size_t)m * ldz + qoff + h * HD;
        float s[4];
#pragma unroll
        for (int i = 0; i < 4; ++i) { const bf16* kr = KV + ((size_t)b * NMEM + lane + 64 * i) * 512 + h * HD; float d = 0.f;
            for (int e = 0; e < HD; ++e) d += bf2f(q[e]) * bf2f(kr[e]);
            s[i] = d; }
        const float mx = wave_max(fmaxf(fmaxf(s[0], s[1]), fmaxf(s[2], s[3]))); float p[4], ps = 0.f;
#pragma unroll
        for (int i = 0; i < 4; ++i) { p[i] = exp2f(s[i] - mx); ps += p[i]; }
        const float den = wave_sum(ps); float acc = 0.f;
#pragma unroll
        for (int i = 0; i < 4; ++i) for (int jl = 0; jl < 64; ++jl) acc += __shfl(p[i], jl) * bf2f(KV[((size_t)b * NMEM + jl + 64 * i) * 512 + 256 + h * HD + lane]);
        MIX[(size_t)m * DM + MAINW + h * HD + lane] = (bf16)f2bf(acc / den); }
}
__device__ __forceinline__ void s_swa(const Args& a) {
    const int lane = threadIdx.x & 63, gw = blockIdx.x * NWAVES + (threadIdx.x >> 6), NGW = gridDim.x * NWAVES;
    const bf16* Z = (const bf16*)(a.ws + WS_Z); bf16* MIX = (bf16*)(a.ws + WS_MIX);
    for (int it = gw; it < M * SWH; it += NGW) { const int m = it / SWH, hq = it % SWH, t = m % SEQ, kvh = hq / 3; const bf16* q = Z + (size_t)m * WINB + ZB_Q + hq * HD;
        float s[2]; bool ok[2];
#pragma unroll
        for (int i = 0; i < 2; ++i) { const int off = lane + 64 * i; ok[i] = (t - off) >= 0; const bf16* kr = Z + (size_t)(ok[i] ? m - off : m) * WINB + ZB_K + kvh * HD; float d = 0.f;
            for (int e = 0; e < HD; ++e) d += bf2f(q[e]) * bf2f(kr[e]);
            s[i] = ok[i] ? d : -INFINITY; }
        const float sink = a.swa_sinks[hq] * LOG2E; const float mx = fmaxf(wave_max(fmaxf(s[0], s[1])), sink); float p[2];
#pragma unroll
        for (int i = 0; i < 2; ++i) p[i] = ok[i] ? exp2f(s[i] - mx) : 0.f;
        const float den = wave_sum(p[0] + p[1]) + exp2f(sink - mx); float acc = 0.f;
#pragma unroll
        for (int i = 0; i < 2; ++i) for (int jl = 0; jl < 64; ++jl) { const int off = jl + 64 * i; const float pj = __shfl(p[i], jl); const size_t mr = (t - off) >= 0 ? (size_t)(m - off) : (size_t)m;
            acc += pj * bf2f(Z[mr * WINB + ZB_V + kvh * HD + lane]); }
        MIX[(size_t)m * DM + hq * HD + lane] = (bf16)f2bf(acc / den); }
}
__device__ __forceinline__ void s_outproj(const Args& a, LAS float* sm, int layer) {
    const bf16* MIX = (const bf16*)(a.ws + WS_MIX); const float* W = a.w_out + (size_t)layer * DM * DM; bf16* XB = (bf16*)(a.ws + WS_XB);
    simple_gemm<false>(sm, M, DM, DM, [&](int m, int k) { return bf2f(MIX[(size_t)m * DM + k]); }, [&](int k, int n, int) { return W[(size_t)k * DM + n]; }, [&](int, int, int) { return 0.f; },
        [&](int m, int n, float acc, float) { XB[(size_t)m * DM + n] = (bf16)f2bf(bf2f(XB[(size_t)m * DM + n]) + acc); });
}
__device__ __forceinline__ void s_xb_ss(const Args& a, float* SS) {
    const int lane = threadIdx.x & 63, gw = blockIdx.x * NWAVES + (threadIdx.x >> 6), NGW = gridDim.x * NWAVES; const bf16* XB = (const bf16*)(a.ws + WS_XB);
    for (int m = gw; m < M; m += NGW) { const u32x2* xr = (const u32x2*)(XB + (size_t)m * DM) + lane; float s = 0.f;
#pragma unroll
        for (int j = 0; j < 4; ++j) { const u32x2 w = xr[64 * j]; const float x0 = __uint_as_float(w.x << 16), x1 = __uint_as_float(w.x & 0xffff0000u), x2 = __uint_as_float(w.y << 16), x3 = __uint_as_float(w.y & 0xffff0000u); s += (x0 * x0 + x1 * x1) + (x2 * x2 + x3 * x3); }
        s = wave_sum(s);
        if (lane < 16) SS[(size_t)m * 16 + lane] = lane == 0 ? s : 0.f; }
}
__device__ __forceinline__ void s_ffn_gu(const Args& a, LAS float* sm) {
    const bf16* XB = (const bf16*)(a.ws + WS_XB); const float* SS = (const float*)(a.ws + WS_SSP1); bf16* ACT = (bf16*)(a.ws + GK_ACTF); const float* W = a.ffn_w_gate_up; const float* g = a.ffn_norm;
    simple_gemm<true>(sm, M, DFF, DM, [&](int m, int k) { return bf2f(XB[(size_t)m * DM + k]) * g[k]; },
        [&](int k, int n, int) { return W[(size_t)k * 2 * DFF + n]; }, [&](int k, int n, int) { return W[(size_t)k * 2 * DFF + DFF + n]; },
        [&](int m, int n, float gg, float uu) { const float rs = pg8::rs_from16(SS + (size_t)m * 16); ACT[(size_t)m * DFF + n] = (bf16)f2bf(silu_f(gg * rs) * (uu * rs)); });
}
__device__ __forceinline__ void s_ffn_dn(const Args& a, LAS float* sm) {
    const bf16* ACT = (const bf16*)(a.ws + GK_ACTF); const float* W = a.ffn_w_down; bf16* XB = (bf16*)(a.ws + WS_XB);
    simple_gemm<false>(sm, M, DM, DFF, [&](int m, int k) { return bf2f(ACT[(size_t)m * DFF + k]); }, [&](int k, int n, int) { return W[(size_t)k * DM + n]; }, [&](int, int, int) { return 0.f; },
        [&](int m, int n, float acc, float) { XB[(size_t)m * DM + n] = (bf16)f2bf(bf2f(XB[(size_t)m * DM + n]) + acc); });
}
__device__ __forceinline__ void s_inproj_b(const Args& a, LAS float* sm) {
    const bf16* XB = (const bf16*)(a.ws + WS_XB); const float* SS = (const float*)(a.ws + WS_SSP2); float* ZF = (float*)(a.ws + GK_ZF); const float* W = a.w_in_b; const float* g = a.mix_norm + DM;
    simple_gemm<false>(sm, M, WINB, DM, [&](int m, int k) { return bf2f(XB[(size_t)m * DM + k]) * g[k]; }, [&](int k, int n, int) { return W[(size_t)k * WINB + n]; }, [&](int, int, int) { return 0.f; },
        [&](int m, int n, float acc, float) { float v = acc * pg8::rs_from16(SS + (size_t)m * 16); if (n < ZB_K || n >= ZB_QM) v *= QS; ZF[(size_t)m * WINB + n] = v; });
}
__device__ __forceinline__ void s_rope(const Args& a) {
    const float* ZF = (const float*)(a.ws + GK_ZF); const float* ROPE = (const float*)(a.ws + WS_ROPE); bf16* Z = (bf16*)(a.ws + WS_Z);
    for (size_t idx = (size_t)blockIdx.x * NTHREADS + threadIdx.x; idx < (size_t)M * WINB; idx += (size_t)gridDim.x * NTHREADS) {
        const int m = (int)(idx / WINB), n = (int)(idx % WINB); float v = ZF[idx];
        if (n < ZB_V) { const int d = n & 63; if (d < 16) { const int i = d & 7; const float c = ROPE[m * 16 + i], s = ROPE[m * 16 + 8 + i];
            v = (d < 8) ? v * c - ZF[idx + 8] * s : v * c + ZF[idx - 8] * s; } }
        Z[idx] = (bf16)f2bf(v); }
}
__device__ __forceinline__ void route_token(const Args& a, int m, const f32x4 (&v)[4], float (&lg)[8], float ss, int lane, LAS unsigned* scnt) {
    int* TOPI = (int*)(a.ws + RT_TOPI); float* TOPG = (float*)(a.ws + RT_TOPG); float* RS3 = (float*)(a.ws + RT_RS3); unsigned char* X8 = (unsigned char*)(a.ws + WS_X8);
    ss = wave_sum(ss); const float rs = rsqrtf(ss * (1.0f / DM) + EPS);
    if (MOE_F8 && FAST(18)) { unsigned* dst = (unsigned*)(X8 + (size_t)m * DM) + lane;
#pragma unroll
        for (int j = 0; j < 4; ++j) dst[64 * j] = pg8::pk4_fp8(v[j].x * rs, v[j].y * rs, v[j].z * rs, v[j].w * rs); }
    float q4[4], q2[2], q1;
    { const bool hi = (lane & 32) != 0;
#pragma unroll
      for (int t = 0; t < 4; ++t) { const float keep = hi ? lg[t + 4] : lg[t], give = hi ? lg[t] : lg[t + 4]; q4[t] = keep + __shfl_xor(give, 32); } }
    { const bool hi = (lane & 16) != 0;
#pragma unroll
      for (int t = 0; t < 2; ++t) { const float keep = hi ? q4[t + 2] : q4[t], give = hi ? q4[t] : q4[t + 2]; q2[t] = keep + __shfl_xor(give, 16); } }
    { const bool hi = (lane & 8) != 0; const float keep = hi ? q2[1] : q2[0], give = hi ? q2[0] : q2[1]; q1 = keep + __shfl_xor(give, 8); }
    q1 += __shfl_xor(q1, 4); q1 += __shfl_xor(q1, 2); q1 += __shfl_xor(q1, 1);
    float l8[8];
#pragma unroll
    for (int e = 0; e < 8; ++e) l8[e] = __shfl(q1, 8 * e) * rs;
    int i0 = 0; float v0 = l8[0];
#pragma unroll
    for (int e = 1; e < 8; ++e) if (l8[e] > v0) { v0 = l8[e]; i0 = e; }
    int i1 = -1; float v1 = -INFINITY;
#pragma unroll
    for (int e = 0; e < 8; ++e) if (e != i0 && l8[e] > v1) { v1 = l8[e]; i1 = e; }
    const float g0 = 1.0f / (1.0f + __expf(v1 - v0));
    if (lane == 0) { TOPI[2 * m] = i0; TOPI[2 * m + 1] = i1; TOPG[2 * m] = g0; TOPG[2 * m + 1] = 1.0f - g0; RS3[m] = rs;
        __hip_atomic_fetch_add(&scnt[i0], 1u, __ATOMIC_RELAXED, __HIP_MEMORY_SCOPE_WORKGROUP); __hip_atomic_fetch_add(&scnt[i1], 1u, __ATOMIC_RELAXED, __HIP_MEMORY_SCOPE_WORKGROUP); }
}
__device__ __forceinline__ void route_top2(const Args& a, LAS unsigned char* lds, LAS unsigned* scnt) {
    const int lane = threadIdx.x & 63, wave = threadIdx.x >> 6;
    int* BCNT = (int*)(a.ws + RT_BCNT); const bf16* XB = (const bf16*)(a.ws + WS_XB);
    LAS float* rwl = (LAS float*)lds;
    __syncthreads();
    for (int idx = threadIdx.x; idx < 8 * DM; idx += NTHREADS) { const int k = idx >> 3, e = idx & 7; rwl[e * DM + k] = a.router_w[idx] * a.ffn_norm[DM + k]; }
    __syncthreads();
    for (int vb = blockIdx.x; vb < 256; vb += gridDim.x) {
        if (threadIdx.x < 8) scnt[threadIdx.x] = 0u;
        __syncthreads();
        const int mw = vb * 128 + wave * 16;
        u32x2 nv[4][4];
#pragma unroll
        for (int t = 0; t < 4; ++t) { const u32x2* xr = (const u32x2*)(XB + (size_t)(mw + t) * DM) + lane;
#pragma unroll
            for (int j = 0; j < 4; ++j) nv[t][j] = __builtin_nontemporal_load(xr + 64 * j); }
#pragma unroll 1
        for (int g4 = 0; g4 < 4; ++g4) { f32x4 v[4][4]; float ss[4], lg[4][8];
#pragma unroll
            for (int t = 0; t < 4; ++t) { ss[t] = 0.f;
#pragma unroll
                for (int j = 0; j < 4; ++j) { v[t][j].x = __uint_as_float(nv[t][j].x << 16); v[t][j].y = __uint_as_float(nv[t][j].x & 0xffff0000u); v[t][j].z = __uint_as_float(nv[t][j].y << 16); v[t][j].w = __uint_as_float(nv[t][j].y & 0xffff0000u);
                    ss[t] += (v[t][j].x * v[t][j].x + v[t][j].y * v[t][j].y) + (v[t][j].z * v[t][j].z + v[t][j].w * v[t][j].w); } }
            if (g4 < 3) {
#pragma unroll
                for (int t = 0; t < 4; ++t) { const u32x2* xr = (const u32x2*)(XB + (size_t)(mw + 4 * (g4 + 1) + t) * DM) + lane;
#pragma unroll
                    for (int j = 0; j < 4; ++j) nv[t][j] = __builtin_nontemporal_load(xr + 64 * j); } }
#pragma unroll
            for (int e = 0; e < 8; ++e) { float acc[4] = {0.f, 0.f, 0.f, 0.f};
#pragma unroll
                for (int j = 0; j < 4; ++j) { const f32x4 w = *(const LAS f32x4*)(rwl + e * DM + 4 * lane + 256 * j);
#pragma unroll
                    for (int t = 0; t < 4; ++t) acc[t] += (v[t][j].x * w.x + v[t][j].y * w.y) + (v[t][j].z * w.z + v[t][j].w * w.w); }
#pragma unroll
                for (int t = 0; t < 4; ++t) lg[t][e] = acc[t];
                if (e & 1) asm volatile("" ::: "memory"); }
#pragma unroll
            for (int t = 0; t < 4; ++t) route_token(a, mw + 4 * g4 + t, v[t], lg[t], ss[t], lane, scnt);
        }
        __syncthreads();
        if (threadIdx.x < 8) BCNT[vb * 8 + threadIdx.x] = (int)scnt[threadIdx.x];
        __syncthreads();
    }
}
__device__ __forceinline__ void route_build(const Args& a, LAS unsigned* sc) {
    const int tid = threadIdx.x, lane = tid & 63, wave = tid >> 6;
    const int* TOPI = (const int*)(a.ws + RT_TOPI); const float* TOPG = (const float*)(a.ws + RT_TOPG); const float* RS3 = (const float*)(a.ws + RT_RS3); const int* BCNT = (const int*)(a.ws + RT_BCNT);
    int* POS = (int*)(a.ws + RT_POS); int* ROWTOK = (int*)(a.ws + RT_ROWTOK); float* ROWGATE = (float*)(a.ws + RT_ROWGATE); float* ROWRS = (float*)(a.ws + RT_ROWRS); int* TILEE = (int*)(a.ws + RT_TILEE);
    const bf16* XB = (const bf16*)(a.ws + WS_XB); bf16* XG = (bf16*)(a.ws + WS_XG);
    for (int vb = blockIdx.x; vb < 256; vb += gridDim.x) {
        __syncthreads();
        for (int i = tid; i < 2048; i += NTHREADS) sc[320 + i] = (unsigned)BCNT[i];
        if (tid < 32) sc[288 + tid] = 0u;
        __syncthreads();
        if (tid < 64) {
            const int e = tid >> 3, j = tid & 7; unsigned tot = 0, pre = 0;
            for (int b = j; b < 256; b += 8) { const unsigned c = sc[320 + b * 8 + e]; tot += c; pre += (b < vb) ? c : 0u; }
            tot += __shfl_xor(tot, 1); tot += __shfl_xor(tot, 2); tot += __shfl_xor(tot, 4); pre += __shfl_xor(pre, 1); pre += __shfl_xor(pre, 2); pre += __shfl_xor(pre, 4);
            if (j == 0) { sc[e] = tot; sc[16 + e] = pre; } }
        __syncthreads();
        if (tid == 0) { unsigned base = 0; for (int e = 0; e < 8; ++e) { sc[8 + e] = base; base += (sc[e] + 255u) & ~255u; } sc[24] = base; }
        int my_e = -1; unsigned my_rank = 0;
        if (tid < 256) { my_e = TOPI[2 * (vb * 128) + tid];
#pragma unroll
            for (int e = 0; e < 8; ++e) { const unsigned long long mk = __ballot(my_e == e); if (my_e == e) my_rank = (unsigned)__popcll(mk & ((1ull << lane) - 1ull)); if (lane == 0) sc[288 + wave * 8 + e] = (unsigned)__popcll(mk); } }
        __syncthreads();
        if (tid < 256) { unsigned off = sc[8 + my_e] + sc[16 + my_e]; for (int w = 0; w < wave; ++w) off += sc[288 + w * 8 + my_e]; sc[32 + tid] = off + my_rank; }
        __syncthreads();
        if (tid < 256) { const int i = tid >> 1, s = tid & 1, m = vb * 128 + i; const int row = (int)sc[32 + tid]; POS[2 * m + s] = row; ROWTOK[row] = m; ROWGATE[row] = TOPG[2 * m + s]; ROWRS[row] = RS3[m]; }
        if (MOE_F8 && FAST(18)) { const unsigned char* X8 = (const unsigned char*)(a.ws + WS_X8);
#pragma unroll 1
            for (int p0 = wave * 32; p0 < wave * 32 + 32; p0 += 8) { u32x4 t[8];
#pragma unroll
                for (int q = 0; q < 8; ++q) { const int p = p0 + q, m = vb * 128 + (p >> 1); t[q] = __builtin_nontemporal_load((const u32x4*)(X8 + (size_t)m * DM) + lane); }
#pragma unroll
                for (int q = 0; q < 8; ++q) { const int row = (int)sc[32 + p0 + q]; *((u32x4*)((unsigned char*)XG + (size_t)row * DM) + lane) = t[q]; } } }
        else { for (int p = wave; p < 256; p += NWAVES) { const int i = p >> 1, m = vb * 128 + i; const int row = (int)sc[32 + p];
            const u32x4* src = (const u32x4*)(XB + (size_t)m * DM); u32x4* dst = (u32x4*)(XG + (size_t)row * DM); dst[lane] = src[lane]; dst[lane + 64] = src[lane + 64]; } }
        if (vb == 0) {
            if (tid < 8) { const unsigned b0 = sc[8 + tid], cnt = sc[tid], pe = (cnt + 255u) & ~255u; for (unsigned t = 0; t < pe / 256u; ++t) TILEE[b0 / 256u + t] = tid; }
            if (tid == 0) TILEE[MAXRT] = (int)(sc[24] / 256u);
            for (int e = 0; e < 8; ++e) { const unsigned b0 = sc[8 + e], cnt = sc[e], pe = (cnt + 255u) & ~255u; for (unsigned r = b0 + cnt + tid; r < b0 + pe; r += NTHREADS) { ROWTOK[r] = -1; ROWGATE[r] = 0.f; ROWRS[r] = 0.f; } }
        }
    }
}
__device__ __forceinline__ void s_moe_gu(const Args& a, LAS float* sm) {
    const bf16* XG = (const bf16*)(a.ws + WS_XG); const int* ROWTOK = (const int*)(a.ws + RT_ROWTOK); const float* ROWRS = (const float*)(a.ws + RT_ROWRS); const int* TILEE = (const int*)(a.ws + RT_TILEE);
    bf16* ACT = (bf16*)(a.ws + WS_ACTM); const float* W = a.exp_w_gate_up; const float* g = a.ffn_norm + DM; const int nrows = TILEE[MAXRT] * 256;
    simple_gemm<true>(sm, nrows, DFE, DM, [&](int m, int k) { return ROWTOK[m] >= 0 ? bf2f(XG[(size_t)m * DM + k]) * g[k] : 0.f; },
        [&](int k, int n, int m0) { return W[((size_t)TILEE[m0 >> 8] * DM + k) * 2 * DFE + n]; }, [&](int k, int n, int m0) { return W[((size_t)TILEE[m0 >> 8] * DM + k) * 2 * DFE + DFE + n]; },
        [&](int m, int n, float gg, float uu) { const float rs = ROWRS[m]; ACT[(size_t)m * DFE + n] = (bf16)f2bf(silu_f(gg * rs) * (uu * rs)); });
}
__device__ __forceinline__ void s_moe_dn(const Args& a, LAS float* sm) {
    const bf16* ACT = (const bf16*)(a.ws + WS_ACTM); const float* ROWGATE = (const float*)(a.ws + RT_ROWGATE); const int* TILEE = (const int*)(a.ws + RT_TILEE);
    bf16* Y = (bf16*)(a.ws + WS_XG); const float* W = a.exp_w_down; const int nrows = TILEE[MAXRT] * 256;
    simple_gemm<false>(sm, nrows, DM, DFE, [&](int m, int k) { return bf2f(ACT[(size_t)m * DFE + k]); }, [&](int k, int n, int m0) { return W[((size_t)TILEE[m0 >> 8] * DFE + k) * DM + n]; }, [&](int, int, int) { return 0.f; },
        [&](int m, int n, float acc, float) { Y[(size_t)m * DM + n] = (bf16)f2bf(acc * ROWGATE[m]); });
}
__device__ __forceinline__ void final_tail_y(const Args& a, int row, int lane, f32x4 (&y)[4]) {
    const float* P = (const float*)(a.ws + WS_Z); const float gate = ((const float*)(a.ws + RT_ROWGATE))[row]; const int rt = (row >> 8) - 256, rl = row & 255;
#pragma unroll
    for (int j = 0; j < 4; ++j) { f32x4 acc = {0.f, 0.f, 0.f, 0.f};
#pragma unroll
        for (int sl = 0; sl < pg8::TAIL_SL; ++sl) acc += *(const f32x4*)(P + (size_t)((rt * 4 + j) * pg8::TAIL_SL + sl) * 65536 + (size_t)rl * 256 + 4 * lane);
        y[j] = acc * gate; }
}
__device__ __forceinline__ void final_rows(const Args& a) {
    const int lane = threadIdx.x & 63, gw = blockIdx.x * NWAVES + (threadIdx.x >> 6), NGW = gridDim.x * NWAVES; const int* POS = (const int*)(a.ws + RT_POS); const bf16* XB = (const bf16*)(a.ws + WS_XB);
    constexpr bool tailfix = (MOE_F8 != 0) && (FAST(19) != 0) && (MOE_TAILFIX != 0), yf8 = (Y_F8 != 0) && (MOE_F8 != 0) && (FAST(19) != 0);
    constexpr int YB = yf8 ? 1 : 2;
    const unsigned char* Y = (const unsigned char*)(a.ws + WS_XG);
    int m = gw, pr0 = 0, pr1 = 0, qr0 = 0, qr1 = 0; u32x2 nx[4], n0[4], n1[4];
    auto ldy = [&](int row, u32x2 (&d)[4]) {
#pragma unroll
        for (int j = 0; j < 4; ++j) { if (yf8) { d[j].x = __builtin_nontemporal_load((const unsigned*)(Y + (size_t)row * DM) + lane + 64 * j); d[j].y = 0u; } else d[j] = __builtin_nontemporal_load((const u32x2*)(Y + (size_t)row * DM * 2) + lane + 64 * j); } };
    auto dec = [&](const u32x2 w) -> f32x4 {
        if (yf8) { const f32x2 lo = __builtin_amdgcn_cvt_pk_f32_fp8(w.x, false), hi = __builtin_amdgcn_cvt_pk_f32_fp8(w.x, true); return (f32x4){lo.x, lo.y, hi.x, hi.y} * 0.0625f; }
        return (f32x4){__uint_as_float(w.x << 16), __uint_as_float(w.x & 0xffff0000u), __uint_as_float(w.y << 16), __uint_as_float(w.y & 0xffff0000u)}; };
    (void)YB;
    if (m < M) { pr0 = __builtin_amdgcn_readfirstlane(POS[2 * m]); pr1 = __builtin_amdgcn_readfirstlane(POS[2 * m + 1]); }
    if (m + NGW < M) { qr0 = __builtin_amdgcn_readfirstlane(POS[2 * (m + NGW)]); qr1 = __builtin_amdgcn_readfirstlane(POS[2 * (m + NGW) + 1]); }
    if (m < M) { const u32x2* x3 = (const u32x2*)(XB + (size_t)m * DM) + lane;
#pragma unroll
        for (int j = 0; j < 4; ++j) nx[j] = __builtin_nontemporal_load(x3 + 64 * j);
        ldy(pr0, n0); ldy(pr1, n1); }
    for (; m < M; m += NGW) { const int r0 = pr0, r1 = pr1; u32x2 xv[4], a0[4], a1[4];
#pragma unroll
        for (int j = 0; j < 4; ++j) { xv[j] = nx[j]; a0[j] = n0[j]; a1[j] = n1[j]; }
        pr0 = qr0; pr1 = qr1;
        if (m + NGW < M) { const int mn = m + NGW; const u32x2* x3 = (const u32x2*)(XB + (size_t)mn * DM) + lane;
#pragma unroll
            for (int j = 0; j < 4; ++j) nx[j] = __builtin_nontemporal_load(x3 + 64 * j);
            ldy(pr0, n0); ldy(pr1, n1); }
        if (m + 2 * NGW < M) { qr0 = __builtin_amdgcn_readfirstlane(POS[2 * (m + 2 * NGW)]); qr1 = __builtin_amdgcn_readfirstlane(POS[2 * (m + 2 * NGW) + 1]); }
        f32x4* xr = (f32x4*)(a.out + (size_t)m * DM) + lane;
        f32x4 y0[4], y1[4];
#pragma unroll
        for (int j = 0; j < 4; ++j) { y0[j] = dec(a0[j]); y1[j] = dec(a1[j]); }
        if (tailfix && r0 >= 65536) final_tail_y(a, r0, lane, y0);
        if (tailfix && r1 >= 65536) final_tail_y(a, r1, lane, y1);
        f32x4 v[4]; float s = 0.f;
#pragma unroll
        for (int j = 0; j < 4; ++j) { v[j].x = __uint_as_float(xv[j].x << 16) + (y0[j].x + y1[j].x); v[j].y = __uint_as_float(xv[j].x & 0xffff0000u) + (y0[j].y + y1[j].y);
            v[j].z = __uint_as_float(xv[j].y << 16) + (y0[j].z + y1[j].z); v[j].w = __uint_as_float(xv[j].y & 0xffff0000u) + (y0[j].w + y1[j].w);
            s += (v[j].x * v[j].x + v[j].y * v[j].y) + (v[j].z * v[j].z + v[j].w * v[j].w); }
        const float rs = rsqrtf(wave_sum(s) * (1.0f / DM) + EPS);
#pragma unroll
        for (int j = 0; j < 4; ++j) { const f32x4 g = *((const f32x4*)a.final_norm + lane + 64 * j); __builtin_nontemporal_store((f32x4){v[j].x * rs * g.x, v[j].y * rs * g.y, v[j].z * rs * g.z, v[j].w * rs * g.w}, xr + 64 * j); } }
}

constexpr int NSTEPS = 21;
__global__ void __launch_bounds__(NTHREADS, 2) fwd(Args args) {
    extern __shared__ __attribute__((aligned(16))) unsigned char lds_raw[];
    LAS unsigned char* lds = (LAS unsigned char*)lds_raw;
    LAS float* smf = (LAS float*)lds;
    volatile LAS unsigned* MISC = (volatile LAS unsigned*)(lds + MISC_OFF);
    for (int u = threadIdx.x; u < 512 / 4; u += NTHREADS) ((LAS unsigned*)(lds + MISC_OFF))[u] = 0u;
    __syncthreads();
    unsigned* barw = (unsigned*)(args.ws + WS_CTL) + CW_BAR;
    XcdBarrier bar; bar.bar = barw; bar.x = 0; bar.st = nullptr;
    const int lo = args.lo, hi = args.hi;
    if (hi - lo > 1) bar = xcd_barrier_post(barw, MISC + 8);
#define RUN(s) (lo <= (s) && (s) < hi)
#define SEAM(s) do { if ((s) + 1 < hi) xcd_barrier(bar); } while (0)
    LAS unsigned* sc = (LAS unsigned*)(lds + 65536);

    const int G = gridDim.x, bid = blockIdx.x;
    bf16* const XB = (bf16*)(args.ws + (args.li ? WS_XG : WS_XB));     bf16* const Zb = (bf16*)(args.ws + WS_Z); bf16* const MIX = (bf16*)(args.ws + WS_MIX);
    float* const SS0 = (float*)(args.ws + WS_SS0); float* const SS1 = (float*)(args.ws + (args.li ? WS_XG + 64 * MiB : WS_SSP1)); float* const SS2 = (float*)(args.ws + (args.li ? WS_XG + 64 * MiB : WS_SSP2)); float* const SS3 = nullptr;

    if (RUN(0)) { if (FAST(1)) prep_rows<true>(args, lds); else prep_rows<false>(args, lds); if (FAST(0)) conv_weights(args, lds); SEAM(0); }
    if (RUN(1)) {
        if (FAST(1)) {
            { pg8::Gemm g{XB, (const bf16*)(args.ws + WT_INA), M, NA, DM, DM}; pg8::StaticOrder S; S.init(M, NA, G, bid); pg8::EpiScaleBf16<1> E{Zb, NA, SS0, 0};
              pg8::gemm_phase<pg8::EpiScaleBf16<1>, pg8::StaticOrder, true, true>(lds, g, S, E); }
        } else { s_inproj_a(args, smf); s_memkv(args, smf); }
        SEAM(1); }
    if (RUN(2)) { if (FAST(2)) { if (GLA2) gla2_pass_a(args, lds); else gla_chunk_kv(args, lds); } else s_gla_alpha(args); SEAM(2); }
    if (RUN(3)) {
        if (FAST(1)) memkv_tiles(args, lds);
        if (FAST(2)) { if (GLA2) gla2_scan(args, 0); else gla_scan(args, 0); } else s_gla_rec(args);
        SEAM(3); }
    if (RUN(4)) { if (FAST(2)) { if (GLA2) gla2_pass_b(args, lds); else gla_output(args, lds); } else s_gla_out(args); if (FAST(4)) fast_attn(args, lds, 0, false, true); else s_memattn(args, 0, NA, ZA_QM); SEAM(4); }
    if (RUN(5)) {
        if (FAST(5)) { pg8::Gemm g{MIX, (const bf16*)(args.ws + WT_OUT), M, DM, DM, DM}; pg8::StaticOrder S; S.init(M, DM, G, bid); pg8::EpiResid<true, FFN_F8 != 0> E{XB, SS1, (unsigned char*)(args.ws + WS_Z)};
            pg8::gemm_phase<pg8::EpiResid<true, FFN_F8 != 0>, pg8::StaticOrder, true, true>(lds, g, S, E); }
        else s_outproj(args, smf, 0);
        SEAM(5); }
    if (!FAST(5) && RUN(6)) { s_xb_ss(args, SS1); SEAM(6); }
    if (RUN(7)) {
        if (FAST(7)) { pg8::StaticOrder S; S.init(M, 2 * DFF, G, bid, GEMM_PB);
            if (FFN_F8) { pg8::Gemm g{(const bf16*)(args.ws + WS_Z), (const bf16*)(args.ws + WT_FGU), M, 2 * DFF, DM / 2, DM / 2}; pg8::EpiSwiGLUF8<3> E{(unsigned char*)(args.ws + GK_ACTF), DFF, SS1, 0};
                pg8::gemm_phase<pg8::EpiSwiGLUF8<3>, pg8::StaticOrder, true, true, true>(lds, g, S, E); }
            else if (FFN_DN_F8) { pg8::Gemm g{XB, (const bf16*)(args.ws + WT_FGU), M, 2 * DFF, DM, DM}; pg8::EpiSwiGLUF8<3> E{(unsigned char*)(args.ws + GK_ACTF), DFF, SS1, 0};
                pg8::gemm_phase<pg8::EpiSwiGLUF8<3>, pg8::StaticOrder, true, true>(lds, g, S, E); }
            else { pg8::Gemm g{XB, (const bf16*)(args.ws + WT_FGU), M, 2 * DFF, DM, DM}; pg8::EpiSwiGLU<3> E{(bf16*)(args.ws + GK_ACTF), DFF, SS1, 0};
                pg8::gemm_phase<pg8::EpiSwiGLU<3>, pg8::StaticOrder, true, true>(lds, g, S, E); } }
        else s_ffn_gu(args, smf);
        SEAM(7); }
    if (RUN(8)) {
        if (FAST(8)) { pg8::StaticOrder S; S.init(M, DM, G, bid); pg8::EpiResid<true> E{XB, SS2, nullptr};
            if (FFN_F8 || FFN_DN_F8) { pg8::Gemm g{(const bf16*)(args.ws + GK_ACTF), (const bf16*)(args.ws + WT_FDN), M, DM, DFF / 2, DFF / 2}; pg8::gemm_phase<pg8::EpiResid<true>, pg8::StaticOrder, true, true, true>(lds, g, S, E); }
            else { pg8::Gemm g{(const bf16*)(args.ws + GK_ACTF), (const bf16*)(args.ws + WT_FDN), M, DM, DFF, DFF}; pg8::gemm_phase<pg8::EpiResid<true>, pg8::StaticOrder, true, true>(lds, g, S, E); } }
        else s_ffn_dn(args, smf);
        SEAM(8); }
    if (!FAST(8) && RUN(9)) { s_xb_ss(args, SS2); SEAM(9); }
    if (RUN(10)) {
        if (FAST(10)) { pg8::Gemm g{XB, (const bf16*)(args.ws + WT_INB), M, WINB, DM, DM}; pg8::StaticOrder S; S.init(M, WINB, G, bid); pg8::EpiRope E{Zb, WINB, SS2, (const float*)(args.ws + WS_ROPE)};
            pg8::gemm_phase<pg8::EpiRope, pg8::StaticOrder, true, true>(lds, g, S, E); }
        else s_inproj_b(args, smf);
        SEAM(10); }
    if (!FAST(10) && RUN(11)) { s_rope(args); SEAM(11); }
    if (RUN(12)) { if (FAST(12) || FAST(4)) fast_attn(args, lds, 1, FAST(12) != 0, FAST(4) != 0); if (!FAST(12)) s_swa(args); if (!FAST(4)) s_memattn(args, 1, WINB, ZB_QM); SEAM(12); }
    if (RUN(13)) {
        if (FAST(13)) { pg8::Gemm g{MIX, (const bf16*)(args.ws + WT_OUT) + (size_t)DM * DM, M, DM, DM, DM}; pg8::StaticOrder S; S.init(M, DM, G, bid); pg8::EpiResid<false> E{XB, SS3, nullptr};
            pg8::gemm_phase<pg8::EpiResid<false>, pg8::StaticOrder, true, true>(lds, g, S, E); }
        else s_outproj(args, smf, 1);
        SEAM(13); }
    if (!FAST(13) && RUN(14)) { s_xb_ss(args, SS1); SEAM(14); }
    if (RUN(15)) { route_top2(args, lds, sc); SEAM(15); }
    if (RUN(16)) { route_build(args, sc); SEAM(16); }
    if (RUN(18)) {
        if (FAST(18)) { const int* TILEE = (const int*)(args.ws + RT_TILEE); const int nrt = TILEE[MAXRT]; pg8::MoeOrder S; S.init(nrt, 2 * DFE / 256, G, bid, TILEE, GEMM_PB);
            if (MOE_F8) { pg8::Gemm g{(const bf16*)(args.ws + WS_XG), (const bf16*)(args.ws + WT_EGU), nrt * 256, NE * 2 * DFE, DM / 2, DM / 2};
                pg8::EpiSwiGLUF8<0> E{(unsigned char*)(args.ws + WS_ACTM), DFE, nullptr, 2 * DFE / 256};
                pg8::gemm_phase<pg8::EpiSwiGLUF8<0>, pg8::MoeOrder, true, true, true>(lds, g, S, E); }
            else { pg8::Gemm g{(const bf16*)(args.ws + WS_XG), (const bf16*)(args.ws + WT_EGU), nrt * 256, NE * 2 * DFE, DM, DM};
                pg8::EpiSwiGLU<2> E{(bf16*)(args.ws + WS_ACTM), DFE, (const float*)(args.ws + RT_ROWRS), 2 * DFE / 256};
                pg8::gemm_phase<pg8::EpiSwiGLU<2>, pg8::MoeOrder, true, true>(lds, g, S, E); } }
        else s_moe_gu(args, smf);
        SEAM(18); }
    if (RUN(19)) {
        if (FAST(19)) { const int* TILEE = (const int*)(args.ws + RT_TILEE); const int nrt = TILEE[MAXRT];
            if (MOE_F8) { pg8::MoeOrder S; S.init((MOE_TAILFIX && nrt > 256) ? 256 : nrt, DM / 256, G, bid, TILEE);
                pg8::Gemm g{(const bf16*)(args.ws + WS_ACTM), (const bf16*)(args.ws + WT_EDN), nrt * 256, NE * DM, DFE / 2, DFE / 2};
                if (Y_F8) { pg8::EpiGateF8 E{(unsigned char*)(args.ws + WS_XG), DM, (const float*)(args.ws + RT_ROWGATE), DM / 256}; pg8::gemm_phase<pg8::EpiGateF8, pg8::MoeOrder, true, true, true>(lds, g, S, E); }
                else { pg8::EpiScaleBf16<2> E{(bf16*)(args.ws + WS_XG), DM, (const float*)(args.ws + RT_ROWGATE), DM / 256}; pg8::gemm_phase<pg8::EpiScaleBf16<2>, pg8::MoeOrder, true, true, true>(lds, g, S, E); }
                if (MOE_TAILFIX && nrt > 256) { pg8::TailOrder T; T.init(nrt, G, bid, TILEE); pg8::EpiTailPart EP{(float*)(args.ws + WS_Z)};
                    pg8::Gemm gt{(const bf16*)(args.ws + WS_ACTM), (const bf16*)(args.ws + WT_EDN), nrt * 256, NE * DM, pg8::TAIL_KB / 2, DFE / 2}; pg8::gemm_phase<pg8::EpiTailPart, pg8::TailOrder, true, true, true>(lds, gt, T, EP); } }
            else { pg8::EpiScaleBf16<2> E{(bf16*)(args.ws + WS_XG), DM, (const float*)(args.ws + RT_ROWGATE), DM / 256}; pg8::MoeOrder S; S.init(nrt, DM / 256, G, bid, TILEE); pg8::Gemm g{(const bf16*)(args.ws + WS_ACTM), (const bf16*)(args.ws + WT_EDN), nrt * 256, NE * DM, DFE, DFE}; pg8::gemm_phase<pg8::EpiScaleBf16<2>, pg8::MoeOrder, true, true>(lds, g, S, E); } }
        else s_moe_dn(args, smf);
        SEAM(19); }
    if (RUN(20)) { final_rows(args); }
#undef RUN
#undef SEAM
}

extern "C" void kernel_launch(void* const* d_in, const int* in_sizes, int n_in, void* d_out, int out_size, void* d_ws, size_t ws_size, hipStream_t stream) {
    static int grid = 0;
    if (grid == 0) {
        if (n_in != 20 || out_size != M * DM || ws_size < WS_END) { fprintf(stderr, "kernel_launch: unexpected shapes (n_in %d, out %d, ws %zu < %zu); nothing launched\n", n_in, out_size, ws_size, (size_t)WS_END); grid = -1; return; }
        int dev = 0, cus = 0, per_cu = 0;
        if (hipGetDevice(&dev) != hipSuccess || hipDeviceGetAttribute(&cus, hipDeviceAttributeMultiprocessorCount, dev) != hipSuccess) { grid = -1; return; }
        if (hipFuncSetAttribute((const void*)fwd, hipFuncAttributeMaxDynamicSharedMemorySize, LDS_BYTES) != hipSuccess) { fprintf(stderr, "kernel_launch: hipFuncSetAttribute failed\n"); grid = -1; return; }
        if (hipOccupancyMaxActiveBlocksPerMultiprocessor(&per_cu, (const void*)fwd, NTHREADS, LDS_BYTES) != hipSuccess || per_cu < 1) { fprintf(stderr, "kernel_launch: occupancy query says %d\n", per_cu); }
        (void)hipGetLastError();
        grid = cus;
    }
    if (grid < 0) return;
    if (hipMemsetAsync((char*)d_ws + WS_CTL, 0, CTL_ZERO_BYTES, stream) != hipSuccess) return;
    Args a{};
    a.x = (const float*)d_in[0]; a.mem = (const float*)d_in[1]; a.positions = (const int*)d_in[2]; a.mix_norm = (const float*)d_in[3]; a.w_in_a = (const float*)d_in[4];
    a.gla_gate_w = (const float*)d_in[5]; a.gla_gate_b = (const float*)d_in[6]; a.gla_out_norm = (const float*)d_in[7]; a.w_in_b = (const float*)d_in[8]; a.swa_sinks = (const float*)d_in[9];
    a.mem_norm = (const float*)d_in[10]; a.w_mem_kv = (const float*)d_in[11]; a.w_out = (const float*)d_in[12]; a.ffn_norm = (const float*)d_in[13]; a.ffn_w_gate_up = (const float*)d_in[14];
    a.ffn_w_down = (const float*)d_in[15]; a.router_w = (const float*)d_in[16]; a.exp_w_gate_up = (const float*)d_in[17]; a.exp_w_down = (const float*)d_in[18]; a.final_norm = (const float*)d_in[19];
    a.out = (float*)d_out; a.ws = (unsigned char*)d_ws; a.li = 0; a.pad = 0;
#if N_LAUNCH_MODE == 1
    a.lo = 0; a.hi = NSTEPS;
    hipLaunchKernelGGL(fwd, dim3(grid), dim3(NTHREADS), LDS_BYTES, stream, a);
#else
    for (int s = 0; s < NSTEPS; ++s) { if (s == 17 || (s == 6 && FAST(5)) || (s == 9 && FAST(8)) || (s == 11 && FAST(10)) || (s == 14 && FAST(13))) continue;
        const int nrep = 1 + (int)((PROBE_REPEAT_MASK >> s) & 1u);
        for (int rep = 0; rep < nrep; ++rep) { a.lo = s; a.hi = s + 1; a.li = (nrep == 2 && rep == 0) ? 1 : 0; hipLaunchKernelGGL(fwd, dim3(grid), dim3(NTHREADS), LDS_BYTES, stream, a); } }
#endif
}
```

```cpp
#include <hip/hip_runtime.h>
#include <cstdio>
#include <cstdint>
#include <type_traits>

#ifndef N_LAUNCH_MODE
#define N_LAUNCH_MODE 1
#endif
#ifndef PROBE_REPEAT_MASK
#define PROBE_REPEAT_MASK 0u
#endif
#ifndef FASTMASK
#define FASTMASK 0xC35B7u
#endif

#define LAS __attribute__((address_space(3)))
#define GAS __attribute__((address_space(1)))
typedef unsigned short bf16;
typedef float f32x4 __attribute__((ext_vector_type(4)));
typedef float f32x2 __attribute__((ext_vector_type(2)));
typedef unsigned u32x4 __attribute__((ext_vector_type(4)));
typedef unsigned u32x2 __attribute__((ext_vector_type(2)));
typedef short bf16x8 __attribute__((ext_vector_type(8)));

constexpr int NB = 4, SEQ = 8192, DM = 1024, M = NB * SEQ;
constexpr int NMEM = 256, HD = 64, MEMH = 4, MEMW = 256, MAINW = 768;
constexpr int GH = 4, GDV = 192, GDK = 96, GLRK = 16, GCH = 64, NCH = SEQ / GCH;
constexpr int SWH = 12, SWKV = 4, WIN = 128;
constexpr int DFF = 2816, NE = 8, DFE = 3584;
constexpr int WINA = 2576, WINB = 1536;
constexpr int NA = 2560;
constexpr int ZA_Q = 0, ZA_K = 384, ZA_V = 768, ZA_R = 1536, ZA_QM = 2304;
constexpr size_t ZH_Q = 0, ZH_K = (size_t)M * 384, ZH_V = (size_t)M * 768, ZH_R = (size_t)M * 1536, ZH_QM = (size_t)M * 2304;
constexpr int ZB_Q = 0, ZB_K = 768, ZB_V = 1024, ZB_QM = 1280;
constexpr size_t ZI_Q = 0, ZI_K = (size_t)M * 768, ZI_V = (size_t)M * 1024, ZI_QM = (size_t)M * 1280;
constexpr float EPS = 1e-6f;
constexpr float LOG2E = 1.4426950408889634f, QS = 0.125f * LOG2E;
constexpr int MAXROWS = 67584;
constexpr int MAXRT = MAXROWS / 256;

constexpr size_t MiB = 1u << 20;
constexpr size_t WS_CTL = 0, CTL_ZERO_BYTES = 1 * MiB;
constexpr int CW_BAR = 4096;
constexpr size_t CTL_SS1 = 128 * 1024, CTL_SS2 = 256 * 1024, CTL_SS3 = 384 * 1024;
constexpr size_t WS_SS0 = 1 * MiB;
constexpr size_t GK_DEC = 1 * MiB + 256 * 1024;
constexpr size_t WS_GLR = 2 * MiB;
constexpr size_t WS_ROPE = 4 * MiB;
constexpr size_t WS_MEMKV = 6 * MiB;
constexpr size_t WS_MEMN = 8 * MiB;
constexpr size_t WS_ROUTE = 12 * MiB;
constexpr size_t RT_TOPI = WS_ROUTE;
constexpr size_t RT_TOPG = RT_TOPI + 256 * 1024;
constexpr size_t RT_POS = RT_TOPG + 256 * 1024;
constexpr size_t RT_RS3 = RT_POS + 256 * 1024;
constexpr size_t RT_ROWTOK = RT_RS3 + 128 * 1024;
constexpr size_t RT_ROWGATE = RT_ROWTOK + 272 * 1024;
constexpr size_t RT_ROWRS = RT_ROWGATE + 272 * 1024;
constexpr size_t RT_BCNT = RT_ROWRS + 272 * 1024;
constexpr size_t RT_TILEE = RT_BCNT + 8 * 1024;
static_assert(RT_TILEE + 4096 <= 16 * MiB, "route map");
constexpr size_t WT_INA = 16 * MiB, WT_INB = 21 * MiB, WT_MKV = 24 * MiB, WT_OUT = 26 * MiB, WT_FGU = 30 * MiB, WT_FDN = 41 * MiB, WT_EGU = 47 * MiB, WT_EDN = 159 * MiB;
constexpr size_t WS_Z = 216 * MiB;
constexpr size_t WS_XB = 376 * MiB;
constexpr size_t WS_MIX = 440 * MiB;
constexpr size_t WS_GK = 504 * MiB;
constexpr size_t WS_ACTM = 504 * MiB;
constexpr size_t WS_X8 = 440 * MiB;
constexpr size_t WS_XG = 736 * MiB;
constexpr size_t WS_SSP1 = 868 * MiB, WS_SSP2 = 870 * MiB;
constexpr size_t WS_END = 872 * MiB;
static_assert(WS_ACTM + (size_t)MAXROWS * DFE <= WS_XG, "ACT_MOE (fp8) fits");
constexpr size_t GK_KV = WS_GK;
constexpr size_t GK_ST = WS_GK + 144 * MiB;
constexpr size_t GK_ALPHA = WS_GK;
constexpr size_t GK_ORAW = WS_GK + 48 * MiB;
constexpr size_t GK_ACTF = WS_GK;
constexpr size_t GK_ZF = WS_GK;

constexpr int NWAVES = 8, NTHREADS = 512;
constexpr int LDS_BYTES = 147456;
constexpr int LDS_TOTAL = 163840, TOK_OFF = LDS_BYTES;
constexpr int MISC_OFF = LDS_BYTES - 512;

__device__ __forceinline__ float bf2f(bf16 b) { return __uint_as_float(((unsigned)b) << 16); }
__device__ __forceinline__ unsigned f2bf(float f) { unsigned u = __float_as_uint(f); return (u + 0x7fffu + ((u >> 16) & 1u)) >> 16; }
__device__ __forceinline__ unsigned pk2(float lo, float hi) { return f2bf(lo) | (f2bf(hi) << 16); }
__device__ __forceinline__ float wave_sum(float v) {
#pragma unroll
    for (int o = 1; o < 64; o <<= 1) v += __shfl_xor(v, o);
    return v;
}
__device__ __forceinline__ float wave_max(float v) {
#pragma unroll
    for (int o = 1; o < 64; o <<= 1) v = fmaxf(v, __shfl_xor(v, o));
    return v;
}
__device__ __forceinline__ float silu_f(float x) { return x / (1.0f + __expf(-x)); }
__device__ __forceinline__ float silu_fast(float x) { return x * __builtin_amdgcn_rcpf(1.0f + __builtin_amdgcn_exp2f(x * -1.4426950408889634f)); }

#define XB_TMO      128
#define XB_XCNT(j)  (256  + 64 * (j))
#define XB_XSUB(j)  (1280 + 64 * (j))
#define XB_XGEN(j)  (2304 + 64 * (j))
#define XB_TOP      3328
#define XB_TOPGEN   3392
#define XCD_BAR_WORDS 3456
#define XB_SPIN_CAP (1u << 18)

__device__ __forceinline__ unsigned xb_ld(unsigned* p)              { return __hip_atomic_load(p, __ATOMIC_RELAXED, __HIP_MEMORY_SCOPE_AGENT); }
__device__ __forceinline__ unsigned xb_add(unsigned* p, unsigned v) { return __hip_atomic_fetch_add(p, v, __ATOMIC_RELAXED, __HIP_MEMORY_SCOPE_AGENT); }
__device__ __forceinline__ unsigned xb_xcc_id() { return (unsigned)__builtin_amdgcn_s_getreg((3 << 11) | 20) & 0xFu; }
#define XB_SPIN(cond, bar) do { unsigned _sp = 0; while (cond) { __builtin_amdgcn_s_sleep(1); \
    if ((++_sp & 255u) == 0u) { if (xb_ld(&(bar)[XB_TMO])) break; if (_sp > XB_SPIN_CAP) { atomicAdd(&(bar)[XB_TMO], 1u); break; } } } } while (0)

struct XcdBarrier {
    unsigned* bar; unsigned x;
    volatile LAS unsigned* st;
};

__device__ __forceinline__ XcdBarrier xcd_barrier_post(unsigned* bar, volatile LAS unsigned* st) {
    XcdBarrier b; b.bar = bar; b.x = xb_xcc_id(); b.st = st;
    if (threadIdx.x == 0) (void)xb_add(&bar[XB_XCNT(b.x)], 1u);
    return b;
}
__device__ __forceinline__ void xcd_barrier_complete(unsigned* bar, unsigned x, unsigned& nloc, unsigned& nx) {
    const unsigned G = gridDim.x * gridDim.y * gridDim.z;
    unsigned sum, cnt, mine, sp = 0u;
    for (;;) {
        sum = 0u; cnt = 0u; mine = 0u;
#pragma unroll
        for (unsigned j = 0; j < 16; ++j) { const unsigned c = xb_ld(&bar[XB_XCNT(j)]); sum += c; cnt += (c > 0u) ? 1u : 0u; mine = (j == x) ? c : mine; }
        if (sum == G) break;
        __builtin_amdgcn_s_sleep(1);
        if ((++sp & 255u) == 0u) { if (xb_ld(&bar[XB_TMO])) break; if (sp > XB_SPIN_CAP) { atomicAdd(&bar[XB_TMO], 1u); break; } }
    }
    nloc = mine > 0u ? mine : 1u; nx = cnt > 0u ? cnt : 1u;
}

__device__ __forceinline__ void xcd_barrier(const XcdBarrier& b) {
    asm volatile("s_waitcnt vmcnt(0)" ::: "memory");
    __syncthreads();
    if (threadIdx.x == 0) {
        unsigned* bar = b.bar;
        __builtin_amdgcn_s_waitcnt(0);
        unsigned nloc = b.st[0], nx = b.st[1];
        if (nloc == 0u) { xcd_barrier_complete(bar, b.x, nloc, nx); b.st[0] = nloc; b.st[1] = nx; }
        const unsigned old = xb_add(&bar[XB_XSUB(b.x)], 1u);
        const unsigned gen = old / nloc;
        if (old + 1u == (gen + 1u) * nloc) {
            __builtin_amdgcn_fence(__ATOMIC_RELEASE, "agent");
            asm volatile("s_waitcnt vmcnt(0)" ::: "memory");
            const unsigned og = xb_add(&bar[XB_TOP], 1u);
            const unsigned tg = og / nx;
            if (og + 1u == (tg + 1u) * nx) xb_add(&bar[XB_TOPGEN], 1u);
            else XB_SPIN(xb_ld(&bar[XB_TOPGEN]) == tg, bar);
            __builtin_amdgcn_fence(__ATOMIC_ACQUIRE, "agent");
            xb_add(&bar[XB_XGEN(b.x)], 1u);
            asm volatile("s_waitcnt vmcnt(0)" ::: "memory");
        } else {
            XB_SPIN(xb_ld(&bar[XB_XGEN(b.x)]) == gen, bar);
            __builtin_amdgcn_fence(__ATOMIC_ACQUIRE, "agent");
            asm volatile("s_waitcnt vmcnt(0)" ::: "memory");
        }
    }
    __syncthreads();
}

struct Args {
    const float* x; const float* mem; const int* positions; const float* mix_norm; const float* w_in_a; const float* gla_gate_w; const float* gla_gate_b; const float* gla_out_norm;
    const float* w_in_b; const float* swa_sinks; const float* mem_norm; const float* w_mem_kv; const float* w_out; const float* ffn_norm; const float* ffn_w_gate_up; const float* ffn_w_down;
    const float* router_w; const float* exp_w_gate_up; const float* exp_w_down; const float* final_norm;
    float* out; unsigned char* ws; int lo, hi, li, pad;
};


namespace pg8 {
#define PG8_LAS __attribute__((address_space(3)))
typedef unsigned short bf16_t;
typedef short bf16x8 __attribute__((ext_vector_type(8)));
typedef float f32x4 __attribute__((ext_vector_type(4)));
typedef unsigned u32x4 __attribute__((ext_vector_type(4)));
typedef int v8i32 __attribute__((ext_vector_type(8)));
constexpr int BM = 256, BK = 64, HALF = 128, HTB = HALF * BK * 2  , STAGE_BYTES = 8 * HTB, NXCD = 8, WGM = 8;

__host__ __device__ __forceinline__ int lds_byte(int r, int c) { const int st = (r >> 4) * 2 + (c >> 5), rr = r & 15, cc = c & 31, ob = rr * 64 + cc * 2; return st * 1024 + (ob ^ (((ob >> 9) & 1) << 5)); }
__host__ __device__ __forceinline__ void stage_rc(int b, int& R, int& C) { const int st = b / 1024, sb = b % 1024, swz = sb ^ (((sb >> 9) & 1) << 5); R = (st >> 1) * 16 + swz / 64; C = (st & 1) * 32 + (swz % 64) / 2; }
__host__ __device__ __forceinline__ int perm32(int rho) { const int n = rho >> 4, i = rho & 15; return 8 * (i >> 2) + 4 * n + (i & 3); }

struct Unit { int pm, pn, koff; };
struct Gemm { const bf16_t* A; const bf16_t* Bt; int M, N, K, ld; int asc = 0x7F7F7F7F; };

struct StaticOrder {
    static constexpr bool HAS_KOFF = false, GATHER_A = false;
    int nM, nN, nwg, G, c;
    __host__ __device__ void init(int M, int N, int G_, int c_) { nM = M / BM; nN = N / BM; nwg = nM * nN; G = G_; c = c_; }
    __host__ __device__ __forceinline__ bool next(int i, Unit& u) const {
        const long L = (long)i * G + c; if (L >= nwg) return false;
        int wgid = (int)L; { const int q = nwg / NXCD, r = nwg % NXCD, xcd = wgid % NXCD, off = wgid / NXCD; wgid = (xcd < r ? xcd * (q + 1) : r * (q + 1) + (xcd - r) * q) + off; }
        const int nig = WGM * nN, gid = wgid / nig, fm = gid * WGM, gsz = (nM - fm) < WGM ? (nM - fm) : WGM;
        u.pm = fm + ((wgid % nig) % gsz); u.pn = (wgid % nig) / gsz; return true;
    }
    __device__ __forceinline__ void a_ready(const Unit&) const {}
    __device__ __forceinline__ void done(const Unit&) const {}
};


__device__ __forceinline__ unsigned cvt_pk_bf16(float lo, float hi) { unsigned r; asm volatile("v_cvt_pk_bf16_f32 %0, %1, %2" : "=v"(r) : "v"(lo), "v"(hi)); return r; }
__device__ __forceinline__ float fast_silu(float g) { return g * __builtin_amdgcn_rcpf(1.0f + __expf(-g)); }
__device__ __forceinline__ float swiglu2(float g, float u) { return (g * u) * __builtin_amdgcn_rcpf(1.0f + __builtin_amdgcn_exp2f(-g)); }

__device__ __forceinline__ unsigned pk4_fp8(float a, float b, float c, float d) {
    a = __builtin_amdgcn_fmed3f(a, -448.f, 448.f); b = __builtin_amdgcn_fmed3f(b, -448.f, 448.f); c = __builtin_amdgcn_fmed3f(c, -448.f, 448.f); d = __builtin_amdgcn_fmed3f(d, -448.f, 448.f);
    unsigned w = 0u; w = __builtin_amdgcn_cvt_pk_fp8_f32(a, b, w, false); w = __builtin_amdgcn_cvt_pk_fp8_f32(c, d, w, true); return w; }
__device__ __forceinline__ float rs_from16(const float* p) { const f32x4 a = *(const f32x4*)p, b = *(const f32x4*)(p + 4), c = *(const f32x4*)(p + 8), d = *(const f32x4*)(p + 12);
    const float t = (((a[0] + a[1]) + (a[2] + a[3])) + ((b[0] + b[1]) + (b[2] + b[3]))) + (((c[0] + c[1]) + (c[2] + c[3])) + ((d[0] + d[1]) + (d[2] + d[3]))); return rsqrtf(t * (1.0f / 1024.0f) + 1e-6f); }
template <int MODE> __device__ __forceinline__ void pre_scales(const float* sv, int row0, int fq, float (&scv)[2][4]) {
    if (MODE == 3) { f32x4 q[2][4];
#pragma unroll
        for (int ai = 0; ai < 2; ++ai)
#pragma unroll
            for (int m = 0; m < 4; ++m) q[ai][m] = *(const f32x4*)(sv + (size_t)(row0 + ai * HALF + m * 16) * 16 + 4 * fq);
#pragma unroll
        for (int ai = 0; ai < 2; ++ai)
#pragma unroll
            for (int m = 0; m < 4; ++m) { float t = (q[ai][m][0] + q[ai][m][1]) + (q[ai][m][2] + q[ai][m][3]); t += __shfl_xor(t, 16); t += __shfl_xor(t, 32); scv[ai][m] = rsqrtf(t * (1.0f / 1024.0f) + 1e-6f); } }
    else if (MODE == 1 || MODE == 2) { float t[2][4];
#pragma unroll
        for (int ai = 0; ai < 2; ++ai)
#pragma unroll
            for (int m = 0; m < 4; ++m) t[ai][m] = sv[row0 + ai * HALF + m * 16];
#pragma unroll
        for (int ai = 0; ai < 2; ++ai)
#pragma unroll
            for (int m = 0; m < 4; ++m) scv[ai][m] = MODE == 1 ? rsqrtf(t[ai][m] * (1.0f / 1024.0f) + 1e-6f) : t[ai][m]; }
    else {
#pragma unroll
        for (int ai = 0; ai < 2; ++ai)
#pragma unroll
            for (int m = 0; m < 4; ++m) scv[ai][m] = 1.0f; }
}
template <int MODE> struct EpiScaleBf16 {
    static constexpr bool PERM = true, AFTER_DRAIN = false;
    bf16_t* O; int ldc; const float* sv; int pn_mod;
    __device__ __forceinline__ void operator()(const f32x4 (&acc)[2][2][4][2], const Unit& u, int wr, int wc, int fr, int fq) const {
        const int row0 = u.pm * BM + wr * 64 + fr, pn = pn_mod ? (u.pn % pn_mod) : u.pn, col0 = pn * BM + wc * 32 + 8 * fq;
        float scv[2][4]; pre_scales<MODE>(sv, row0, fq, scv);
#pragma unroll
        for (int ai = 0; ai < 2; ++ai)
#pragma unroll
            for (int m = 0; m < 4; ++m) { const int r = row0 + ai * HALF + m * 16; const float sc = scv[ai][m];
                bf16_t* rowp = O + (size_t)r * ldc + col0;
#pragma unroll
                for (int bj = 0; bj < 2; ++bj) { const f32x4 v0 = acc[ai][bj][m][0] * sc, v1 = acc[ai][bj][m][1] * sc;
                    u32x4 w; w.x = cvt_pk_bf16(v0[0], v0[1]); w.y = cvt_pk_bf16(v0[2], v0[3]); w.z = cvt_pk_bf16(v1[0], v1[1]); w.w = cvt_pk_bf16(v1[2], v1[3]);
                    *(u32x4*)(rowp + bj * HALF) = w; } }
    }
};
struct EpiZA {
    static constexpr bool PERM = true, AFTER_DRAIN = false; static constexpr int NST = 16;
    bf16_t* O; const float* sv;
    static __device__ __forceinline__ size_t zoff(int r, int c) {
        const int b = r / SEQ, t = r - b * SEQ;
        if (c < 768) { const int cq = c < 384 ? c : c - 384, h = cq / 96, cc = cq - 96 * h; return (c < 384 ? ZH_Q : ZH_K) + ((size_t)(b * GH + h) * SEQ + t) * 96 + cc; }
        if (c < 2304) { const int cv = c < 1536 ? c - 768 : c - 1536, h = cv / 192, cc = cv - 192 * h; return (c < 1536 ? ZH_V : ZH_R) + ((size_t)(b * GH + h) * SEQ + t) * 192 + cc; }
        return ZH_QM + (size_t)r * 256 + (c - 2304); }
    __device__ __forceinline__ void operator()(const f32x4 (&acc)[2][2][4][2], const Unit& u, int wr, int wc, int fr, int fq) const {
        const int row0 = u.pm * BM + wr * 64 + fr, col0 = u.pn * BM + wc * 32 + 8 * fq;
        float scv[2][4]; pre_scales<1>(sv, row0, fq, scv);
#pragma unroll
        for (int ai = 0; ai < 2; ++ai)
#pragma unroll
            for (int m = 0; m < 4; ++m) { const int r = row0 + ai * HALF + m * 16; const float sc = scv[ai][m];
#pragma unroll
                for (int bj = 0; bj < 2; ++bj) { const f32x4 v0 = acc[ai][bj][m][0] * sc, v1 = acc[ai][bj][m][1] * sc;
                    u32x4 w; w.x = cvt_pk_bf16(v0[0], v0[1]); w.y = cvt_pk_bf16(v0[2], v0[3]); w.z = cvt_pk_bf16(v1[0], v1[1]); w.w = cvt_pk_bf16(v1[2], v1[3]);
                    *(u32x4*)(O + zoff(r, col0 + bj * HALF)) = w; } }
    }
};
template <bool WITH_SS, bool WITH_X8 = false> struct EpiResid {
    static constexpr bool PERM = true, AFTER_DRAIN = false;
    bf16_t* xb; float* ss; unsigned char* x8;
    __device__ __forceinline__ void operator()(const f32x4 (&acc)[2][2][4][2], const Unit& u, int wr, int wc, int fr, int fq) const {
        const int row0 = u.pm * BM + wr * 64 + fr, col0 = u.pn * BM + wc * 32 + 8 * fq;
        u32x4 old[2][4][2];
        constexpr int NAI = WITH_X8 ? 1 : 2;
#pragma unroll
        for (int h = 0; h < 2; h += NAI) {
        if (WITH_X8 && h) asm volatile("" ::: "memory");
#pragma unroll
        for (int ai = h; ai < h + NAI; ++ai)
#pragma unroll
            for (int m = 0; m < 4; ++m)
#pragma unroll
                for (int bj = 0; bj < 2; ++bj) old[ai][m][bj] = *(const u32x4*)(xb + (size_t)(row0 + ai * HALF + m * 16) * 1024 + col0 + bj * HALF);
#pragma unroll
        for (int ai = h; ai < h + NAI; ++ai)
#pragma unroll
            for (int m = 0; m < 4; ++m) { const int r = row0 + ai * HALF + m * 16; bf16_t* rowp = xb + (size_t)r * 1024 + col0; float part = 0.f;
#pragma unroll
                for (int bj = 0; bj < 2; ++bj) { const u32x4 o = old[ai][m][bj]; f32x4 v0 = acc[ai][bj][m][0], v1 = acc[ai][bj][m][1];
                    v0[0] += __uint_as_float(o.x << 16); v0[1] += __uint_as_float(o.x & 0xffff0000u); v0[2] += __uint_as_float(o.y << 16); v0[3] += __uint_as_float(o.y & 0xffff0000u);
                    v1[0] += __uint_as_float(o.z << 16); v1[1] += __uint_as_float(o.z & 0xffff0000u); v1[2] += __uint_as_float(o.w << 16); v1[3] += __uint_as_float(o.w & 0xffff0000u);
                    u32x4 w; w.x = cvt_pk_bf16(v0[0], v0[1]); w.y = cvt_pk_bf16(v0[2], v0[3]); w.z = cvt_pk_bf16(v1[0], v1[1]); w.w = cvt_pk_bf16(v1[2], v1[3]);
                    *(u32x4*)(rowp + bj * HALF) = w;
                    if (WITH_X8) { typedef unsigned u32x2v __attribute__((ext_vector_type(2))); u32x2v w8; w8.x = pk4_fp8(v0[0], v0[1], v0[2], v0[3]); w8.y = pk4_fp8(v1[0], v1[1], v1[2], v1[3]); *(u32x2v*)(x8 + (size_t)r * 1024 + col0 + bj * HALF) = w8; }
                    part += ((v0[0] * v0[0] + v0[1] * v0[1]) + (v0[2] * v0[2] + v0[3] * v0[3])) + ((v1[0] * v1[0] + v1[1] * v1[1]) + (v1[2] * v1[2] + v1[3] * v1[3])); }
                if (WITH_SS) { part += __shfl_xor(part, 16); part += __shfl_xor(part, 32); if (fq == 0) ss[(size_t)r * 16 + u.pn * 4 + wc] = part; } }
        }
    }
};
template <int MODE> struct EpiSwiGLU {
    static constexpr bool PERM = true, AFTER_DRAIN = false;
    bf16_t* O; int ldc; const float* sv; int pn_mod;
    __device__ __forceinline__ void operator()(const f32x4 (&acc)[2][2][4][2], const Unit& u, int wr, int wc, int fr, int fq) const {
        const int row0 = u.pm * BM + wr * 64 + fr, pn = pn_mod ? (u.pn % pn_mod) : u.pn, col0 = pn * HALF + wc * 32 + 8 * fq;
        float scv[2][4]; pre_scales<MODE>(sv, row0, fq, scv);
#pragma unroll
        for (int ai = 0; ai < 2; ++ai)
#pragma unroll
            for (int m = 0; m < 4; ++m) { const int r = row0 + ai * HALF + m * 16; const float sc = scv[ai][m];
                const f32x4 g0 = acc[ai][0][m][0] * sc, g1 = acc[ai][0][m][1] * sc, u0 = acc[ai][1][m][0] * sc, u1 = acc[ai][1][m][1] * sc; f32x4 a0, a1;
#pragma unroll
                for (int j = 0; j < 4; ++j) { a0[j] = swiglu2(g0[j], u0[j]); a1[j] = swiglu2(g1[j], u1[j]); }
                u32x4 w; w.x = cvt_pk_bf16(a0[0], a0[1]); w.y = cvt_pk_bf16(a0[2], a0[3]); w.z = cvt_pk_bf16(a1[0], a1[1]); w.w = cvt_pk_bf16(a1[2], a1[3]);
                *(u32x4*)(O + (size_t)r * ldc + col0) = w; }
    }
};
__device__ __forceinline__ unsigned pk4_fp8_nc(float a, float b, float c, float d) { unsigned w = 0u; w = __builtin_amdgcn_cvt_pk_fp8_f32(a, b, w, false); w = __builtin_amdgcn_cvt_pk_fp8_f32(c, d, w, true); return w; }
template <int MODE> struct EpiSwiGLUF8 {
    static constexpr bool PERM = true, AFTER_DRAIN = false; static constexpr int NST = 4;
    unsigned char* O; int ldc; const float* sv; int pn_mod;
    __device__ __forceinline__ void operator()(const f32x4 (&acc)[2][2][4][2], const Unit& u, int wr, int wc, int fr, int fq) const {
        const int row0 = u.pm * BM + wr * 64 + fr, pn = pn_mod ? (u.pn % pn_mod) : u.pn, col0 = pn * HALF + wc * 32 + 8 * (fq & ~1);
        float scv[2][4]; pre_scales<MODE>(sv, row0, fq, scv);
#pragma unroll
        for (int ai = 0; ai < 2; ++ai)
#pragma unroll
            for (int mp = 0; mp < 2; ++mp) { unsigned wx[2], wy[2];
#pragma unroll
                for (int q = 0; q < 2; ++q) { const int m = 2 * mp + q; const float sc = scv[ai][m];
                    f32x4 g0 = acc[ai][0][m][0], g1 = acc[ai][0][m][1], u0 = acc[ai][1][m][0], u1 = acc[ai][1][m][1]; if (MODE != 0) { g0 *= sc; g1 *= sc; u0 *= sc; u1 *= sc; }
                    f32x4 e0, e1, a0 = g0 * u0, a1 = g1 * u1;
#pragma unroll
                    for (int j = 0; j < 4; ++j) { e0[j] = __builtin_amdgcn_exp2f(-g0[j]); e1[j] = __builtin_amdgcn_exp2f(-g1[j]); }
                    e0 += 1.0f; e1 += 1.0f;
#pragma unroll
                    for (int j = 0; j < 4; ++j) { e0[j] = __builtin_amdgcn_rcpf(e0[j]); e1[j] = __builtin_amdgcn_rcpf(e1[j]); }
                    a0 *= e0; a1 *= e1;
                    wx[q] = pk4_fp8_nc(a0[0], a0[1], a0[2], a0[3]); wy[q] = pk4_fp8_nc(a1[0], a1[1], a1[2], a1[3]); }
                const auto sx = __builtin_amdgcn_permlane16_swap(wx[0], wx[1], false, false); const auto sy = __builtin_amdgcn_permlane16_swap(wy[0], wy[1], false, false);
                u32x4 w; w.x = sx[0]; w.y = sy[0]; w.z = sx[1]; w.w = sy[1];
                const int r = row0 + ai * HALF + (2 * mp + (fq & 1)) * 16;
                *(u32x4*)(O + (size_t)r * ldc + col0) = w; }
    }
};
struct EpiGateF8 {
    static constexpr bool PERM = true, AFTER_DRAIN = false; static constexpr int NST = 8;
    unsigned char* O; int ldc; const float* sv; int pn_mod;
    __device__ __forceinline__ void operator()(const f32x4 (&acc)[2][2][4][2], const Unit& u, int wr, int wc, int fr, int fq) const {
        const int row0 = u.pm * BM + wr * 64 + fr, pn = pn_mod ? (u.pn % pn_mod) : u.pn, col0 = pn * BM + wc * 32 + 8 * (fq & ~1);
        float scv[2][4]; pre_scales<2>(sv, row0, fq, scv);
#pragma unroll
        for (int ai = 0; ai < 2; ++ai)
#pragma unroll
            for (int mp = 0; mp < 2; ++mp) { unsigned wx[2][2], wy[2][2];
#pragma unroll
                for (int q = 0; q < 2; ++q) { const int m = 2 * mp + q; const float sc = scv[ai][m] * 16.0f;
#pragma unroll
                    for (int bj = 0; bj < 2; ++bj) { const f32x4 v0 = acc[ai][bj][m][0] * sc, v1 = acc[ai][bj][m][1] * sc; wx[q][bj] = pk4_fp8(v0[0], v0[1], v0[2], v0[3]); wy[q][bj] = pk4_fp8(v1[0], v1[1], v1[2], v1[3]); } }
                const int r = row0 + ai * HALF + (2 * mp + (fq & 1)) * 16;
#pragma unroll
                for (int bj = 0; bj < 2; ++bj) { const auto sx = __builtin_amdgcn_permlane16_swap(wx[0][bj], wx[1][bj], false, false); const auto sy = __builtin_amdgcn_permlane16_swap(wy[0][bj], wy[1][bj], false, false);
                    u32x4 w; w.x = sx[0]; w.y = sy[0]; w.z = sx[1]; w.w = sy[1]; *(u32x4*)(O + (size_t)r * ldc + col0 + bj * HALF) = w; } }
    }
};
struct EpiRope {
    static constexpr bool PERM = true, AFTER_DRAIN = false;
    static __device__ __forceinline__ size_t zoff(int r, int c) {
        const int b = r / SEQ, t = r - b * SEQ, cc = c & 63;
        if (c < 768) return ZI_Q + ((size_t)(b * SWH + (c >> 6)) * SEQ + t) * 64 + cc;
        if (c < 1024) return ZI_K + ((size_t)(b * SWKV + ((c - 768) >> 6)) * SEQ + t) * 64 + cc;
        if (c < 1280) return ZI_V + ((size_t)(b * SWKV + ((c - 1024) >> 6)) * SEQ + t) * 64 + cc;
        return ZI_QM + (size_t)r * 256 + (c - 1280); }
    bf16_t* O; int ldc; const float* ss; const float* rope; PG8_LAS f32x4* rl;
    __device__ __forceinline__ void operator()(const f32x4 (&acc)[2][2][4][2], const Unit& u, int wr, int wc, int fr, int fq) const {
        const int row0 = u.pm * BM + wr * 64 + fr, col0 = u.pn * BM + wc * 32 + 8 * fq; const bool anyrot = u.pn < 4, rot = anyrot && ((wc & 1) == 0);
        f32x4 g0 = {0.f, 0.f, 0.f, 0.f}, g1 = g0; int t_ = threadIdx.x; asm volatile("" : "+v"(t_));
        if (anyrot) { const f32x4* src = (const f32x4*)(rope + (size_t)u.pm * BM * 16); g0 = src[t_]; g1 = src[t_ + 512]; }
        float scv[2][4]; pre_scales<3>(ss, row0, fq, scv);
        if (anyrot) { rl[t_] = g0; rl[t_ + 512] = g1; asm volatile("s_waitcnt lgkmcnt(0)" ::: "memory"); __builtin_amdgcn_s_barrier(); }
#pragma unroll
        for (int ai = 0; ai < 2; ++ai)
#pragma unroll
            for (int m = 0; m < 4; ++m) { const int r = row0 + ai * HALF + m * 16; const float sc = scv[ai][m];
                f32x4 c0 = {1.f, 1.f, 1.f, 1.f}, c1 = c0, s0 = {0.f, 0.f, 0.f, 0.f}, s1 = s0;
                if (rot && fq < 2) { const PG8_LAS f32x4* rp = rl + (wr * 64 + ai * HALF + m * 16 + fr) * 4; c0 = rp[0]; c1 = rp[1]; s0 = rp[2]; s1 = rp[3]; if (fq == 0) { s0 = -s0; s1 = -s1; } }
#pragma unroll
                for (int bj = 0; bj < 2; ++bj) { f32x4 v0 = acc[ai][bj][m][0] * sc, v1 = acc[ai][bj][m][1] * sc;
                    if (rot) { f32x4 p0, p1;
#pragma unroll
                        for (int j = 0; j < 4; ++j) { p0[j] = __shfl_xor(v0[j], 16); p1[j] = __shfl_xor(v1[j], 16); }
                        v0 = v0 * c0 + p0 * s0; v1 = v1 * c1 + p1 * s1; }
                    u32x4 w; w.x = cvt_pk_bf16(v0[0], v0[1]); w.y = cvt_pk_bf16(v0[2], v0[3]); w.z = cvt_pk_bf16(v1[0], v1[1]); w.w = cvt_pk_bf16(v1[2], v1[3]);
                    *(u32x4*)(O + zoff(r, col0 + bj * HALF)) = w; } }
    }
};
constexpr int TAIL_SL = 7, TAIL_KB = DFE / TAIL_SL;
struct TailOrder {
    static constexpr bool HAS_KOFF = true, GATHER_A = false;
    int nt_units, G, c; const int* tilee;
    __device__ __forceinline__ void init(int nrt, int G_, int c_, const int* tilee_) { nt_units = (nrt - 256) * 4 * TAIL_SL; G = G_; c = c_; tilee = tilee_; }
    __device__ __forceinline__ bool next(int i, Unit& u) const { const int L = i * G + c; if (L >= nt_units) return false; const int t = L / TAIL_SL, sl = L % TAIL_SL, rt = t >> 2, j = t & 3;
        u.pm = 256 + rt; u.pn = tilee[u.pm] * 4 + j; u.koff = sl * TAIL_KB; return true; }
    __device__ __forceinline__ void a_ready(const Unit&) const {}
    __device__ __forceinline__ void done(const Unit&) const {}
};
struct EpiTailPart {
    static constexpr bool PERM = false, AFTER_DRAIN = false;
    float* P;
    __device__ __forceinline__ void operator()(const f32x4 (&acc)[2][2][4][2], const Unit& u, int wr, int wc, int fr, int fq) const {
        float* T = P + (size_t)(((u.pm - 256) * 4 + (u.pn & 3)) * TAIL_SL + u.koff / TAIL_KB) * 65536;
#pragma unroll
        for (int ai = 0; ai < 2; ++ai)
#pragma unroll
            for (int m = 0; m < 4; ++m) { float* rowp = T + (size_t)(ai * HALF + wr * 64 + m * 16 + fr) * 256 + wc * 32 + 4 * fq;
#pragma unroll
                for (int bj = 0; bj < 2; ++bj)
#pragma unroll
                    for (int n = 0; n < 2; ++n) *(f32x4*)(rowp + bj * HALF + n * 16) = acc[ai][bj][m][n]; }
    }
};
struct MoeOrder {
    static constexpr bool HAS_KOFF = false, GATHER_A = false;
    StaticOrder so; const int* tilee; int tpe; PG8_LAS const int* tt = nullptr;
    __device__ __forceinline__ void init(int nrt, int tpe_, int G_, int c_, const int* tilee_) { so.nM = nrt; so.nN = tpe_; so.nwg = nrt * tpe_; so.G = G_; so.c = c_; tilee = tilee_; tpe = tpe_; }
    __device__ __forceinline__ bool next(int i, Unit& u) const { if (!so.next(i, u)) return false; u.pn += (tt ? tt[i] : tilee[u.pm]) * tpe; return true; }
    __device__ __forceinline__ void a_ready(const Unit&) const {}
    __device__ __forceinline__ void done(const Unit&) const {}
};
struct MoeGatherOrder : MoeOrder { static constexpr bool GATHER_A = true; PG8_LAS const unsigned short* tok; };
template <class Epi, class Sched, bool ALIGN_EPI = false, bool SP2 = false, bool F8 = false>
__device__ __forceinline__ void gemm_phase(PG8_LAS unsigned char* lds, const Gemm g, const Sched& S, const Epi& E) {
    int tid_ = threadIdx.x; asm volatile("" : "+v"(tid_));
    const int tid = tid_, wid = __builtin_amdgcn_readfirstlane(tid >> 6), lane = tid & 63, wr = wid >> 2, wc = wid & 3, fr = lane & 15, fq = lane >> 4;
    const int K = g.K, nt = K / BK, LD = Sched::HAS_KOFF ? g.ld : g.K;
    unsigned voffA[2], voffB[2];
#pragma unroll
    for (int i = 0; i < 2; ++i) { int R, C; stage_rc(tid * 16 + i * 8192, R, C); const int Rb = Epi::PERM ? ((R & ~31) + perm32(R & 31)) : R;
        voffA[i] = (unsigned)(R * LD + C) * 2u; voffB[i] = (unsigned)(Rb * LD + C) * 2u; }
    constexpr bool GA = Sched::GATHER_A; static_assert(!GA || SP2, "row gather is wired into the two-super-phase loop only");
    unsigned voffA1[2] = {0u, 0u}; int gaR = 0; unsigned gaC = 0;
    if constexpr (GA) { int R, C; stage_rc(tid * 16, R, C); gaR = R; gaC = (unsigned)C * 2u; }
    const size_t kstep = (size_t)(BK * 2);
    const size_t hstep = (size_t)HALF * LD * 2;
    const size_t tstep = 2 * hstep;
    const unsigned ldsw = (unsigned)wid * 1024u;
    const int aoff = lds_byte(wr * 64 + fr, fq * 8), boff = lds_byte(wc * 32 + fr, fq * 8);
#define PG8_SA(b, h) (((b) * 2 + (h)) * HTB)
#define PG8_SB(b, h) ((4 + (b) * 2 + (h)) * HTB)
#define PG8_STAGE(bufoff, gbase, voff) do { _Pragma("unroll") for (int _i = 0; _i < 2; ++_i) \
        __builtin_amdgcn_global_load_lds((const unsigned*)((const char*)(gbase) + (voff)[_i]), (PG8_LAS unsigned*)(lds + (bufoff) + ldsw + _i * 8192), 16, 0, 0); } while (0)
#define PG8_STAGE_A1(bufoff, gbase) do { if constexpr (GA) PG8_STAGE(bufoff, gbase, voffA1); else PG8_STAGE(bufoff, (gbase) + hstep, voffA); } while (0)
#define PG8_GA_SET(ui_) do { if constexpr (GA) { PG8_LAS const unsigned short* tp_ = S.tok + (ui_) * 256 + gaR; const unsigned rb_ = (unsigned)LD * 2u; \
        voffA[0] = (unsigned)tp_[0] * rb_ + gaC; voffA[1] = (unsigned)tp_[64] * rb_ + gaC; voffA1[0] = (unsigned)tp_[128] * rb_ + gaC; voffA1[1] = (unsigned)tp_[192] * rb_ + gaC; } } while (0)
#define PG8_CAT(lo, hi) __builtin_bit_cast(v8i32, __builtin_shufflevector((lo), (hi), 0, 1, 2, 3, 4, 5, 6, 7, 8, 9, 10, 11, 12, 13, 14, 15))
#define PG8_LDA(dst, b, h) do { _Pragma("unroll") for (int m = 0; m < 4; ++m) { if constexpr (F8) { dst##8[m] = PG8_CAT(*(const PG8_LAS bf16x8*)(lds + PG8_SA(b, h) + aoff + m * 2048), *(const PG8_LAS bf16x8*)(lds + PG8_SA(b, h) + aoff + m * 2048 + 1024)); } \
        else { _Pragma("unroll") for (int k = 0; k < 2; ++k) dst[m][k] = *(const PG8_LAS bf16x8*)(lds + PG8_SA(b, h) + aoff + m * 2048 + k * 1024); } } } while (0)
#define PG8_LDB(dst, b, h) do { _Pragma("unroll") for (int n = 0; n < 2; ++n) { if constexpr (F8) { dst##8[n] = PG8_CAT(*(const PG8_LAS bf16x8*)(lds + PG8_SB(b, h) + boff + n * 2048), *(const PG8_LAS bf16x8*)(lds + PG8_SB(b, h) + boff + n * 2048 + 1024)); } \
        else { _Pragma("unroll") for (int k = 0; k < 2; ++k) dst[n][k] = *(const PG8_LAS bf16x8*)(lds + PG8_SB(b, h) + boff + n * 2048 + k * 1024); } } } while (0)
#define PG8_MMA(ai, bj, At, Bt) do { __builtin_amdgcn_s_setprio(1); _Pragma("unroll") for (int m = 0; m < 4; ++m) _Pragma("unroll") for (int n = 0; n < 2; ++n) { \
        if constexpr (F8) { asm volatile("v_mfma_scale_f32_16x16x128_f8f6f4 %0, %1, %2, %0, %3, %4 op_sel_hi:[0,0,0]" : "+v"(acc[ai][bj][m][n]) : "v"(Bt##8[n]), "v"(At##8[m]), "v"(sclW), "v"(sclA)); } \
        else { _Pragma("unroll") for (int k = 0; k < 2; ++k) acc[ai][bj][m][n] = __builtin_amdgcn_mfma_f32_16x16x32_bf16(Bt[n][k], At[m][k], acc[ai][bj][m][n], 0, 0, 0); } } __builtin_amdgcn_s_setprio(0); } while (0)
#define PG8_MMA_Z(ai, bj, At, Bt) do { __builtin_amdgcn_s_setprio(1); _Pragma("unroll") for (int m = 0; m < 4; ++m) _Pragma("unroll") for (int n = 0; n < 2; ++n) { \
        if constexpr (F8) { asm volatile("v_mfma_scale_f32_16x16x128_f8f6f4 %0, %1, %2, 0, %3, %4 op_sel_hi:[0,0,0]" : "=&v"(acc[ai][bj][m][n]) : "v"(Bt##8[n]), "v"(At##8[m]), "v"(sclW), "v"(sclA)); } \
        else { acc[ai][bj][m][n] = __builtin_amdgcn_mfma_f32_16x16x32_bf16(Bt[n][0], At[m][0], (f32x4){0.f, 0.f, 0.f, 0.f}, 0, 0, 0); \
               acc[ai][bj][m][n] = __builtin_amdgcn_mfma_f32_16x16x32_bf16(Bt[n][1], At[m][1], acc[ai][bj][m][n], 0, 0, 0); } } __builtin_amdgcn_s_setprio(0); } while (0)
#define PG8_WAIT_V(n) asm volatile("s_waitcnt vmcnt(" #n ")" ::: "memory")
#define PG8_WAIT_L(n) asm volatile("s_waitcnt lgkmcnt(" #n ")" ::: "memory")
#define PG8_BAR __builtin_amdgcn_s_barrier()
#define PG8_SCHED __builtin_amdgcn_sched_barrier(0)
    Unit cur, nxt; int ui = 0;
    if (!S.next(0, cur)) return;
    f32x4 acc[2][2][4][2];
    if constexpr (!SP2) {
#pragma unroll
    for (int a = 0; a < 2; ++a)
#pragma unroll
        for (int b = 0; b < 2; ++b)
#pragma unroll
            for (int m = 0; m < 4; ++m)
#pragma unroll
                for (int n = 0; n < 2; ++n) acc[a][b][m][n] = (f32x4){0.f, 0.f, 0.f, 0.f};
    }
    bf16x8 At[4][2], B0[2][2], B1[2][2]; v8i32 At8[4], B08[2], B18[2];
    const int sclW = 0x79797979, sclA = g.asc;
    const char* cA = GA ? (const char*)g.A : (const char*)g.A + (size_t)cur.pm * tstep; const char* cB = (const char*)g.Bt + (size_t)cur.pn * tstep;
    PG8_GA_SET(0);
    if constexpr (Sched::HAS_KOFF) { cA += cur.koff; cB += cur.koff; }
    S.a_ready(cur);
    if constexpr (SP2) {
        PG8_STAGE(PG8_SB(0, 0), cB, voffB); PG8_STAGE(PG8_SB(0, 1), cB + hstep, voffB); PG8_STAGE(PG8_SA(0, 0), cA, voffA); PG8_STAGE_A1(PG8_SA(0, 1), cA);
        if (wr == 1) PG8_BAR;
        PG8_WAIT_V(2); PG8_BAR;
        PG8_STAGE(PG8_SB(1, 0), cB + kstep, voffB); PG8_STAGE(PG8_SA(1, 0), cA + kstep, voffA); PG8_STAGE(PG8_SB(1, 1), cB + hstep + kstep, voffB);
        PG8_WAIT_V(6); PG8_BAR;
    } else {
        PG8_STAGE(PG8_SB(0, 0), cB, voffB); PG8_STAGE(PG8_SA(0, 0), cA, voffA); PG8_STAGE(PG8_SB(0, 1), cB + hstep, voffB); PG8_STAGE(PG8_SA(0, 1), cA + hstep, voffA);
        if (wr == 1) PG8_BAR;
        PG8_WAIT_V(4); PG8_BAR;
        PG8_STAGE(PG8_SB(1, 0), cB + kstep, voffB); PG8_STAGE(PG8_SA(1, 0), cA + kstep, voffA); PG8_STAGE(PG8_SB(1, 1), cB + hstep + kstep, voffB);
        PG8_WAIT_V(6); PG8_BAR;
    }
    for (;;) {
        const bool has_next = S.next(ui + 1, nxt);
        const char* nA = (has_next && !GA) ? (const char*)g.A + (size_t)nxt.pm * tstep : cA; const char* nB = has_next ? (const char*)g.Bt + (size_t)nxt.pn * tstep : cB;
        if constexpr (Sched::HAS_KOFF) { if (has_next) { nA += nxt.koff; nB += nxt.koff; } }
#pragma clang loop unroll(disable)
        for (int t = 0; t < nt; t += 2) {
            const bool last = (t == nt - 2);
            const char* a1 = cA + (size_t)(t + 1) * kstep;
            const char* a2 = last ? nA : cA + (size_t)(t + 2) * kstep; const char* b2 = last ? nB : cB + (size_t)(t + 2) * kstep;
            const char* a3 = a2 + kstep; const char* b3 = b2 + kstep;
            if (last && has_next) S.a_ready(nxt);
            if constexpr (SP2) {
            PG8_LDB(B0, 0, 0); PG8_LDB(B1, 0, 1); PG8_SCHED; PG8_LDA(At, 0, 0); PG8_STAGE_A1(PG8_SA(1, 1), a1);
            if constexpr (GA) { if (last && has_next) PG8_GA_SET(ui + 1); }
            PG8_WAIT_V(8); PG8_WAIT_L(0); PG8_BAR; if (t == 0) { PG8_MMA_Z(0, 0, At, B0); PG8_MMA_Z(0, 1, At, B1); } else { PG8_MMA(0, 0, At, B0); PG8_MMA(0, 1, At, B1); } PG8_BAR; PG8_SCHED;
            PG8_LDA(At, 0, 1); PG8_STAGE(PG8_SB(0, 0), b2, voffB); PG8_STAGE(PG8_SB(0, 1), b2 + hstep, voffB); PG8_STAGE(PG8_SA(0, 0), a2, voffA);
            PG8_WAIT_V(8); PG8_WAIT_L(0); PG8_BAR; if (t == 0) { PG8_MMA_Z(1, 0, At, B0); PG8_MMA_Z(1, 1, At, B1); } else { PG8_MMA(1, 0, At, B0); PG8_MMA(1, 1, At, B1); } PG8_BAR; PG8_SCHED;
            PG8_LDB(B0, 1, 0); PG8_LDB(B1, 1, 1); PG8_SCHED; PG8_LDA(At, 1, 0); PG8_STAGE_A1(PG8_SA(0, 1), a2);
            PG8_WAIT_V(8); PG8_WAIT_L(0); PG8_BAR; PG8_MMA(0, 0, At, B0); PG8_MMA(0, 1, At, B1); PG8_BAR; PG8_SCHED;
            PG8_LDA(At, 1, 1); PG8_STAGE(PG8_SB(1, 0), b3, voffB); PG8_STAGE(PG8_SB(1, 1), b3 + hstep, voffB); PG8_STAGE(PG8_SA(1, 0), a3, voffA);
            PG8_WAIT_V(8); PG8_WAIT_L(0); PG8_BAR; PG8_MMA(1, 0, At, B0); PG8_MMA(1, 1, At, B1); PG8_BAR; PG8_SCHED;
            } else {
            PG8_LDB(B0, 0, 0); PG8_SCHED; PG8_LDA(At, 0, 0); PG8_STAGE(PG8_SA(1, 1), a1 + hstep, voffA);
            PG8_WAIT_L(8); PG8_BAR; PG8_WAIT_L(0); PG8_MMA(0, 0, At, B0); PG8_BAR; PG8_SCHED;
            PG8_LDB(B1, 0, 1); PG8_STAGE(PG8_SB(0, 0), b2, voffB);
            PG8_BAR; PG8_WAIT_L(0); PG8_MMA(0, 1, At, B1); PG8_BAR;
            PG8_LDA(At, 0, 1); PG8_STAGE(PG8_SA(0, 0), a2, voffA);
            PG8_BAR; PG8_WAIT_L(0); PG8_MMA(1, 0, At, B0); PG8_BAR; PG8_SCHED;
            PG8_STAGE(PG8_SB(0, 1), b2 + hstep, voffB);
            PG8_WAIT_V(6); PG8_BAR; PG8_MMA(1, 1, At, B1); PG8_BAR;
            PG8_LDB(B0, 1, 0); PG8_SCHED; PG8_LDA(At, 1, 0); PG8_STAGE(PG8_SA(0, 1), a2 + hstep, voffA);
            PG8_WAIT_L(8); PG8_BAR; PG8_WAIT_L(0); PG8_MMA(0, 0, At, B0); PG8_BAR; PG8_SCHED;
            PG8_LDB(B1, 1, 1); PG8_STAGE(PG8_SB(1, 0), b3, voffB);
            PG8_BAR; PG8_WAIT_L(0); PG8_MMA(0, 1, At, B1); PG8_BAR;
            PG8_LDA(At, 1, 1); PG8_STAGE(PG8_SA(1, 0), a3, voffA);
            PG8_BAR; PG8_WAIT_L(0); PG8_MMA(1, 0, At, B0); PG8_BAR; PG8_SCHED;
            PG8_STAGE(PG8_SB(1, 1), b3 + hstep, voffB);
            PG8_WAIT_V(6); PG8_BAR; PG8_MMA(1, 1, At, B1); PG8_BAR;
            }
        }
        if constexpr (F8) asm volatile("s_nop 15\n\ts_nop 15" ::: "memory");
        if constexpr (ALIGN_EPI) { if (wr == 0) PG8_BAR; }
        if constexpr (!Epi::AFTER_DRAIN) { E(acc, cur, wr, wc, fr, fq); S.done(cur); }
        if (!has_next) break;
        if constexpr (!SP2) {
#pragma unroll
        for (int a = 0; a < 2; ++a)
#pragma unroll
            for (int b = 0; b < 2; ++b)
#pragma unroll
                for (int m = 0; m < 4; ++m)
#pragma unroll
                    for (int n = 0; n < 2; ++n) acc[a][b][m][n] = (f32x4){0.f, 0.f, 0.f, 0.f};
        }
        cur = nxt; cA = nA; cB = nB; ++ui;
        if constexpr (ALIGN_EPI) { if (wr == 1) PG8_BAR; }
    }
    PG8_WAIT_V(0);
    if constexpr (!ALIGN_EPI) { if (wr == 0) PG8_BAR; }
    PG8_BAR;
    if constexpr (Epi::AFTER_DRAIN) { E.fused(acc, cur, wr, wc, fr, fq, lds, wid, lane); S.done(cur); }
#undef PG8_SA
#undef PG8_SB
#undef PG8_STAGE
#undef PG8_LDA
#undef PG8_CAT
#undef PG8_STAGE_A1
#undef PG8_GA_SET
#undef PG8_LDB
#undef PG8_MMA
#undef PG8_MMA_Z
#undef PG8_WAIT_V
#undef PG8_WAIT_L
#undef PG8_BAR
#undef PG8_SCHED
}
}

#define FAST(s) (((FASTMASK) >> (s)) & 1u)
#ifndef FFN_DN_F8
#define FFN_DN_F8 1
#endif
#ifndef FFN_F8
#define FFN_F8 0
#endif
#ifndef GLA2
#define GLA2 1
#endif
#ifndef Y_F8
#define Y_F8 1
#endif
#ifndef MOE_TAILFIX
#define MOE_TAILFIX 1
#endif
#ifndef MOE_GATHER
#define MOE_GATHER 1
#endif
#ifndef INB_F8
#define INB_F8 1
#endif
#ifndef OUT_F8_L0
#define OUT_F8_L0 0
#endif
#ifndef OUT_F8_L1
#define OUT_F8_L1 1
#endif
#ifndef OUT_F8
#define OUT_F8 (OUT_F8_L0 || OUT_F8_L1)
#endif
constexpr float MIX_SC = 4.0f; constexpr int MIX_ASC = 0x7D7D7D7D;
#ifndef MOE_F8
#define MOE_F8 1
#endif

template <bool NT = true>
__device__ __forceinline__ void conv_item(const float* W, int ldw, int K, const float* gain, float scale, int srccol0, bf16* WT, int dstrow0, int k0, LAS float* scr, int lane) {
    float ld[64];
#pragma unroll
    for (int i = 0; i < 64; ++i) ld[i] = __builtin_nontemporal_load(W + (size_t)(k0 + i) * ldw + srccol0 + lane);
#pragma unroll
    for (int i = 0; i < 64; ++i) { float v = ld[i] * scale; if (gain) v *= gain[k0 + i]; scr[i * 65 + lane] = v; }
    asm volatile("s_waitcnt lgkmcnt(0)" ::: "memory");
    const int c = lane & 7;
#pragma unroll
    for (int j = 0; j < 8; ++j) { const int n = (lane >> 3) + 8 * j; const LAS float* sp = scr + (8 * c) * 65 + n;
        u32x4 o; o.x = pk2(sp[0 * 65], sp[1 * 65]); o.y = pk2(sp[2 * 65], sp[3 * 65]); o.z = pk2(sp[4 * 65], sp[5 * 65]); o.w = pk2(sp[6 * 65], sp[7 * 65]);
        if (NT) __builtin_nontemporal_store(o, (u32x4*)(WT + (size_t)(dstrow0 + n) * K + k0 + 8 * c)); else *(u32x4*)(WT + (size_t)(dstrow0 + n) * K + k0 + 8 * c) = o; }
    asm volatile("s_waitcnt lgkmcnt(0)" ::: "memory");
}
template <int KP> __device__ __forceinline__ int outk_src(int kp) {
    if (KP == 0) return kp;
    if (KP == 1 && kp < MAINW) { const int blk = kp / 96, q = kp - blk * 96; const int c = q < 64 ? 16 * ((q >> 2) & 3) + 4 * (q >> 4) + (q & 3) : 16 * (4 + (((q - 64) >> 2) & 1)) + 4 * ((q - 64) >> 3) + (q & 3); return blk * 96 + c; }
    const int q = kp & 63; return (kp & ~63) + 16 * ((q >> 2) & 3) + 4 * (q >> 4) + (q & 3);
}
template <int KP = 0>
__device__ __forceinline__ void conv_item_f8(const float* W, int ldw, int K, const float* gain, float scale, int srccol0, unsigned char* WT, int dstrow0, int k0, LAS float* scr, int lane) {
    float ld[64];
#pragma unroll
    for (int i = 0; i < 64; ++i) { const int kk = 2 * i + (lane >> 5); ld[i] = __builtin_nontemporal_load(W + (size_t)outk_src<KP>(k0 + kk) * ldw + srccol0 + (lane & 31)); }
#pragma unroll
    for (int i = 0; i < 64; ++i) { const int kk = 2 * i + (lane >> 5); float v = ld[i] * scale; if (gain) v *= gain[k0 + kk]; scr[kk * 33 + (lane & 31)] = v; }
    asm volatile("s_waitcnt lgkmcnt(0)" ::: "memory");
    const int c = lane & 15;
#pragma unroll
    for (int j = 0; j < 8; ++j) { const int n = (lane >> 4) + 4 * j; const LAS float* sp = scr + (8 * c) * 33 + n;
        u32x2 o; o.x = pg8::pk4_fp8(sp[0 * 33], sp[1 * 33], sp[2 * 33], sp[3 * 33]); o.y = pg8::pk4_fp8(sp[4 * 33], sp[5 * 33], sp[6 * 33], sp[7 * 33]);
        __builtin_nontemporal_store(o, (u32x2*)(WT + (size_t)(dstrow0 + n) * K + k0 + 8 * c)); }
    asm volatile("s_waitcnt lgkmcnt(0)" ::: "memory");
}
#ifndef CONV_SPLIT
#define CONV_SPLIT 0
#endif
constexpr int NCONV7 = 21;
__device__ __forceinline__ void conv_weights(const Args& a, LAS unsigned char* lds, int gw0, int NGW, bool skip_moe) {
    const int lane = threadIdx.x & 63, wave = threadIdx.x >> 6, gw = gw0 + wave;
    LAS float* scr = (LAS float*)(lds + wave * 16896);
    static_assert(FFN_F8 == 0, "the fp8 gate/up conversion path below still enumerates 64 x 64 items");
    constexpr int I_INA = 16 * (NA / 64), I_INB = 16 * (WINB / 64), I_MKV = 2 * 16 * 8, I_OUT = 2 * 16 * 16, I_FGU = 16 * (2 * DFF / 64), I_FDN = (FFN_F8 || FFN_DN_F8) ? (DFF / 128) * 32 : (DFF / 64) * 16;
    constexpr int I_EGU = MOE_F8 ? NE * 8 * (2 * DFE / 32) : NE * 16 * (2 * DFE / 64), I_EDN = MOE_F8 ? NE * (DFE / 128) * 32 : NE * (DFE / 64) * 16;
    constexpr int NIT = I_INA + I_INB + I_MKV + I_OUT + I_FGU + I_FDN + I_EGU + I_EDN;
    constexpr int I_PRE = I_INA + I_INB + I_MKV + I_OUT + I_FGU + I_FDN;
    const int nit = skip_moe ? I_PRE : NIT;
    for (int it = gw; it < nit; it += NGW) {
        int r = it;
        if (r < I_INA) { const int nb = r % (NA / 64), kb = r / (NA / 64), n0 = nb * 64; const int src = n0 < 1536 ? n0 : n0 + 16; const float sc = n0 < 384 ? 0.10206207261596575f : (n0 >= ZA_QM ? QS : 1.0f);
            conv_item<false>(a.w_in_a, WINA, DM, a.mix_norm, sc, src, (bf16*)(a.ws + WT_INA), n0, kb * 64, scr, lane); continue; } r -= I_INA;
        if (INB_F8 && r < I_INB) { const int nb = r % (WINB / 32), kb = r / (WINB / 32), n0 = nb * 32; const float sc = (n0 < ZB_K || n0 >= ZB_QM) ? QS : 1.0f;
            conv_item_f8(a.w_in_b, WINB, DM, a.mix_norm + DM, 64.0f * sc, n0, (unsigned char*)(a.ws + WT_INB), n0, kb * 128, scr, lane); continue; }
        if (r < I_INB) { const int nb = r % (WINB / 64), kb = r / (WINB / 64), n0 = nb * 64; const float sc = (n0 < ZB_K || n0 >= ZB_QM) ? QS : 1.0f;
            conv_item(a.w_in_b, WINB, DM, a.mix_norm + DM, sc, n0, (bf16*)(a.ws + WT_INB), n0, kb * 64, scr, lane); continue; } r -= I_INB;
        if (r < I_MKV) { const int l = r / 128, q = r % 128, nb = q % 8, kb = q / 8;
            conv_item<false>(a.w_mem_kv + (size_t)l * DM * 512, 512, DM, nullptr, 1.0f, nb * 64, (bf16*)(a.ws + WT_MKV) + (size_t)l * 512 * DM, nb * 64, kb * 64, scr, lane); continue; } r -= I_MKV;
        if (r < I_OUT && ((r < 256) ? OUT_F8_L0 : OUT_F8_L1)) { const int l = r / 256, q = r % 256, nb = q % 32, kb = q / 32;
            if (l == 0) conv_item_f8<1>(a.w_out, DM, DM, nullptr, 64.0f, nb * 32, (unsigned char*)(a.ws + WT_OUT), nb * 32, kb * 128, scr, lane);
            else conv_item_f8<2>(a.w_out + (size_t)DM * DM, DM, DM, nullptr, 64.0f, nb * 32, (unsigned char*)(a.ws + WT_OUT) + (size_t)2 * DM * DM, nb * 32, kb * 128, scr, lane);
            continue; }
        if (r < I_OUT) { const int l = r / 256, q = r % 256, nb = q % 16, kb = q / 16;
            conv_item(a.w_out + (size_t)l * DM * DM, DM, DM, nullptr, 1.0f, nb * 64, (bf16*)(a.ws + WT_OUT) + (size_t)l * DM * DM, nb * 64, kb * 64, scr, lane); continue; } r -= I_OUT;
        if (r < I_FGU) { const int nb = r % (2 * DFF / 64), kb = r / (2 * DFF / 64), n0 = nb * 64; const int src = ((n0 & 255) >> 7) * DFF + (n0 >> 8) * 128 + (n0 & 127);
            const float gs = (n0 & 255) < 128 ? LOG2E : 1.0f / LOG2E;
            if (FFN_F8) conv_item_f8(a.ffn_w_gate_up, 2 * DFF, DM, a.ffn_norm, 64.0f * gs, src, (unsigned char*)(a.ws + WT_FGU), n0, kb * 64, scr, lane);
            else conv_item(a.ffn_w_gate_up, 2 * DFF, DM, a.ffn_norm, gs, src, (bf16*)(a.ws + WT_FGU), n0, kb * 64, scr, lane);
            continue; } r -= I_FGU;
        if (r < I_FDN) {
            if (FFN_F8 || FFN_DN_F8) { const int nb = r % 32, kb = r / 32; conv_item_f8(a.ffn_w_down, DM, DFF, nullptr, 64.0f, nb * 32, (unsigned char*)(a.ws + WT_FDN), nb * 32, kb * 128, scr, lane); }
            else { const int nb = r % 16, kb = r / 16; conv_item(a.ffn_w_down, DM, DFF, nullptr, 1.0f, nb * 64, (bf16*)(a.ws + WT_FDN), nb * 64, kb * 64, scr, lane); }
            continue; } r -= I_FDN;
        if (r < I_EGU) {
            if (MOE_F8) { constexpr int per = 8 * (2 * DFE / 32); const int e = r / per, q = r % per, nb = q % (2 * DFE / 32), kb = q / (2 * DFE / 32), n0 = nb * 32; const int src = ((n0 & 255) >> 7) * DFE + (n0 >> 8) * 128 + (n0 & 127);
                const float gs = (n0 & 255) < 128 ? LOG2E : 1.0f / LOG2E;
                conv_item_f8(a.exp_w_gate_up + (size_t)e * DM * 2 * DFE, 2 * DFE, DM, a.ffn_norm + DM, 64.0f * gs, src, (unsigned char*)(a.ws + WT_EGU) + (size_t)e * 2 * DFE * DM, n0, kb * 128, scr, lane); }
            else { constexpr int per = 16 * (2 * DFE / 64); const int e = r / per, q = r % per, nb = q % (2 * DFE / 64), kb = q / (2 * DFE / 64), n0 = nb * 64; const int src = ((n0 & 255) >> 7) * DFE + (n0 >> 8) * 128 + (n0 & 127);
                const float gs = (n0 & 255) < 128 ? LOG2E : 1.0f / LOG2E;
                conv_item(a.exp_w_gate_up + (size_t)e * DM * 2 * DFE, 2 * DFE, DM, a.ffn_norm + DM, gs, src, (bf16*)(a.ws + WT_EGU) + (size_t)e * 2 * DFE * DM, n0, kb * 64, scr, lane); }
            continue; } r -= I_EGU;
        if (MOE_F8) { constexpr int per = (DFE / 128) * 32; const int e = r / per, q = r % per, nb = q % 32, kb = q / 32;
            conv_item_f8(a.exp_w_down + (size_t)e * DFE * DM, DM, DFE, nullptr, 64.0f, nb * 32, (unsigned char*)(a.ws + WT_EDN) + (size_t)e * DM * DFE, nb * 32, kb * 128, scr, lane); }
        else { constexpr int per = (DFE / 64) * 16; const int e = r / per, q = r % per, nb = q % 16, kb = q / 16;
            conv_item(a.exp_w_down + (size_t)e * DFE * DM, DM, DFE, nullptr, 1.0f, nb * 64, (bf16*)(a.ws + WT_EDN) + (size_t)e * DM * DFE, nb * 64, kb * 64, scr, lane); }
    }
}
constexpr int CM_EGU = NE * 8 * (2 * DFE / 32), CM_EDN = NE * (DFE / 128) * 32;
struct CDesc { const float* W; unsigned char* WT; const float* gain; float scale; int ldw, K; };
__device__ __forceinline__ void cm_decode(const Args& a, int r, CDesc& d) {
    if (r < CM_EGU) { constexpr int per = 8 * (2 * DFE / 32); const int e = r / per, q = r % per, nb = q % (2 * DFE / 32), kb = q / (2 * DFE / 32), n0 = nb * 32; const int src = ((n0 & 255) >> 7) * DFE + (n0 >> 8) * 128 + (n0 & 127);
        d.W = a.exp_w_gate_up + (size_t)e * DM * 2 * DFE + (size_t)(kb * 128) * (2 * DFE) + src; d.WT = (unsigned char*)(a.ws + WT_EGU) + (size_t)e * 2 * DFE * DM + (size_t)n0 * DM + kb * 128;
        d.gain = a.ffn_norm + DM + kb * 128; d.scale = 64.0f * ((n0 & 255) < 128 ? LOG2E : 1.0f / LOG2E); d.ldw = 2 * DFE; d.K = DM; }
    else { r -= CM_EGU; constexpr int per = (DFE / 128) * 32; const int e = r / per, q = r % per, nb = q % 32, kb = q / 32;
        d.W = a.exp_w_down + (size_t)e * DFE * DM + (size_t)(kb * 128) * DM + nb * 32; d.WT = (unsigned char*)(a.ws + WT_EDN) + (size_t)e * DM * DFE + (size_t)(nb * 32) * DFE + kb * 128;
        d.gain = nullptr; d.scale = 64.0f; d.ldw = DM; d.K = DFE; }
}
__device__ __forceinline__ void cm_issue(const CDesc& d, f32x4 (&ld)[16], int lane) {
    const float* p = d.W + (size_t)(lane >> 3) * d.ldw + 4 * (lane & 7);
#pragma unroll
    for (int i = 0; i < 16; ++i) ld[i] = __builtin_nontemporal_load((const f32x4*)(p + (size_t)(8 * i) * d.ldw));
}
__device__ __forceinline__ void cm_finish(const CDesc& d, const f32x4 (&ld)[16], LAS float* scr, int lane) {
    const int rr = lane >> 3, m4 = 4 * (lane & 7);
#pragma unroll
    for (int i = 0; i < 16; ++i) { const int kk = 8 * i + rr; float sc = d.scale; if (d.gain) sc *= d.gain[kk]; const f32x4 v = ld[i] * sc; LAS float* w = scr + kk * 33 + m4; w[0] = v[0]; w[1] = v[1]; w[2] = v[2]; w[3] = v[3]; }
    asm volatile("s_waitcnt lgkmcnt(0)" ::: "memory");
    const int c = lane & 15;
#pragma unroll
    for (int j = 0; j < 8; ++j) { const int n = (lane >> 4) + 4 * j; const LAS float* sp = scr + (8 * c) * 33 + n;
        u32x2 o; o.x = pg8::pk4_fp8(sp[0 * 33], sp[1 * 33], sp[2 * 33], sp[3 * 33]); o.y = pg8::pk4_fp8(sp[4 * 33], sp[5 * 33], sp[6 * 33], sp[7 * 33]);
        __builtin_nontemporal_store(o, (u32x2*)(d.WT + (size_t)n * d.K + 8 * c)); }
    asm volatile("s_waitcnt lgkmcnt(0)" ::: "memory");
}
__device__ __forceinline__ void conv_moe(const Args& a, LAS unsigned char* lds, int gw0, int NGW, int lo, int hi) {
    const int lane = threadIdx.x & 63, wave = threadIdx.x >> 6; LAS float* scr = (LAS float*)(lds + wave * 16896);
    f32x4 ldA[16], ldB[16]; CDesc dA, dB; int it = lo + gw0 + wave;
    if (it < hi) { cm_decode(a, it, dA); cm_issue(dA, ldA, lane); }
#pragma unroll 1
    for (; it < hi; it += 2 * NGW) {
        const bool hb = it + NGW < hi; if (hb) { cm_decode(a, it + NGW, dB); cm_issue(dB, ldB, lane); }
        cm_finish(dA, ldA, scr, lane);
        const bool ha = it + 2 * NGW < hi; if (ha) { cm_decode(a, it + 2 * NGW, dA); cm_issue(dA, ldA, lane); }
        if (hb) cm_finish(dB, ldB, scr, lane);
    }
}
typedef short s16x4 __attribute__((ext_vector_type(4)));
typedef __bf16 bf16x2_t __attribute__((ext_vector_type(2)));
#define MFMA16(a, b, c) __builtin_amdgcn_mfma_f32_16x16x32_bf16((a), (b), (c), 0, 0, 0)
__device__ __forceinline__ s16x4 ds_tr(LAS const unsigned char* p) { return __builtin_bit_cast(s16x4, __builtin_amdgcn_ds_read_tr16_b64_v4i16((LAS s16x4*)p)); }
__device__ __forceinline__ bf16x8 cat8(s16x4 lo, s16x4 hi) { return __builtin_shufflevector(lo, hi, 0, 1, 2, 3, 4, 5, 6, 7); }
__device__ __forceinline__ unsigned cvtpk(float lo, float hi) { f32x2 v = {lo, hi}; bf16x2_t b = __builtin_convertvector(v, bf16x2_t); return __builtin_bit_cast(unsigned, b); }
__device__ __forceinline__ bf16x8 pack8(f32x4 a, f32x4 b) { u32x4 w; w.x = cvtpk(a[0], a[1]); w.y = cvtpk(a[2], a[3]); w.z = cvtpk(b[0], b[1]); w.w = cvtpk(b[2], b[3]); return __builtin_bit_cast(bf16x8, w); }
__device__ __forceinline__ bf16x8 row_frag(LAS const unsigned char* T, int stride, int row0, int col0, int fr, int fq) { return *(LAS const bf16x8*)(T + (row0 + fr) * stride + (col0 + 8 * fq) * 2); }
__device__ __forceinline__ bf16x8 tr_frag(LAS const unsigned char* T, int stride, int k0, int col0, int fr, int fq) {
    LAS const unsigned char* p = T + (k0 + 8 * fq + (fr >> 2)) * stride + (col0 + 4 * (fr & 3)) * 2; return cat8(ds_tr(p), ds_tr(p + 4 * stride)); }
__device__ __forceinline__ bf16x8 tr2(LAS const unsigned char* p, int stride) { return cat8(ds_tr(p), ds_tr(p + 4 * stride)); }
__device__ __forceinline__ bf16x8 tr_frag_perm(LAS const unsigned char* T, int stride, int k0, int col0, int fr, int fq) {
    LAS const unsigned char* p = T + (k0 + 4 * fq + (fr >> 2)) * stride + (col0 + 4 * (fr & 3)) * 2; return cat8(ds_tr(p), ds_tr(p + 16 * stride)); }

template <bool SWA_MODE, bool OF8>
__device__ __forceinline__ void attn_wave16(LAS const unsigned char* Ks, LAS const unsigned char* Vs, const bf16x8 (&qf)[2], bf16* O  , int ldo, int kb0, int dbase, int lim, float sink, int lane, int mflag = 2) {
    constexpr int NKB = SWA_MODE ? 10 : 16;
    const int fr = lane & 15, fq = lane >> 4;
    f32x4 sacc[NKB];
    const int kx = (fr >> 1) & 7;
    LAS const unsigned char* kbase = Ks + kb0 * 2048 + fr * 128;
#pragma unroll
    for (int i = 0; i < NKB; ++i) { sacc[i] = (f32x4){0.f, 0.f, 0.f, 0.f};
#pragma unroll
        for (int ks = 0; ks < 2; ++ks) { const bf16x8 a = *(LAS const bf16x8*)(kbase + i * 2048 + (((fq + 4 * ks) ^ kx) * 16)); sacc[i] = MFMA16(a, qf[ks], sacc[i]); }
        if ((i & 3) == 3) __builtin_amdgcn_sched_barrier(0); }
    if (SWA_MODE) {
        auto maskblk = [&](int i) {
#pragma unroll
            for (int r = 0; r < 4; ++r) { const unsigned d = (unsigned)(dbase - (16 * i + r)); if (d > (unsigned)lim) sacc[i][r] = -INFINITY; } };
        if (mflag & 2) {
#pragma unroll
            for (int i = 0; i < NKB; ++i) maskblk(i); }
        else { maskblk(0); maskblk(NKB - 1); if (mflag & 1) maskblk(1); else maskblk(NKB - 2); } }
    f32x4 m4 = sacc[0];
#pragma unroll
    for (int i = 1; i < NKB; ++i)
#pragma unroll
        for (int r = 0; r < 4; ++r) m4[r] = fmaxf(m4[r], sacc[i][r]);
    float mx = fmaxf(fmaxf(m4[0], m4[1]), fmaxf(m4[2], m4[3]));
    mx = fmaxf(mx, __shfl_xor(mx, 16)); mx = fmaxf(mx, __shfl_xor(mx, 32));
    if (SWA_MODE) mx = fmaxf(mx, sink);
    f32x4 s4 = {0.f, 0.f, 0.f, 0.f};
#pragma unroll
    for (int i = 0; i < NKB; ++i) { f32x4 t = sacc[i] - mx;
#pragma unroll
        for (int r = 0; r < 4; ++r) t[r] = __builtin_amdgcn_exp2f(t[r]);
        sacc[i] = t; s4 += t; }
    float sum = (s4[0] + s4[1]) + (s4[2] + s4[3]);
    sum += __shfl_xor(sum, 16); sum += __shfl_xor(sum, 32);
    if (SWA_MODE) sum += __builtin_amdgcn_exp2f(sink - mx);
    const float inv = 1.0f / sum;
    f32x4 oacc[4];
#pragma unroll
    for (int db = 0; db < 4; ++db) oacc[db] = (f32x4){0.f, 0.f, 0.f, 0.f};
    const int vx = (2 * fq + (fr >> 3)) & 3;
    LAS const unsigned char* vbase = Vs + kb0 * 2048 + (4 * fq + (fr >> 2)) * 128 + (4 * (fr & 3)) * 2;
#pragma unroll
    for (int g = 0; g < NKB / 2; ++g) { const bf16x8 pb = pack8(sacc[2 * g], sacc[2 * g + 1]);
#pragma unroll
        for (int db = 0; db < 4; ++db) { LAS const unsigned char* p = vbase + g * 4096 + ((db ^ vx) * 32); const bf16x8 va = cat8(ds_tr(p), ds_tr(p + 2048)); oacc[db] = MFMA16(va, pb, oacc[db]); }
        if (g & 1) __builtin_amdgcn_sched_barrier(0); }
    if (OF8) { const float isc = inv * MIX_SC; unsigned w[4];
#pragma unroll
        for (int db = 0; db < 4; ++db) { const f32x4 o = oacc[db] * isc; w[db] = pg8::pk4_fp8(o[0], o[1], o[2], o[3]); }
        *(u32x4*)((unsigned char*)O + (size_t)fr * ldo + 16 * fq) = (u32x4){w[0], w[1], w[2], w[3]}; return; }
#pragma unroll
    for (int db = 0; db < 4; ++db) { const f32x4 o = oacc[db] * inv; u32x2 w; w.x = cvtpk(o[0], o[1]); w.y = cvtpk(o[2], o[3]); *(u32x2*)(O + (size_t)fr * ldo + 16 * db + 4 * fq) = w; }
}
#ifndef MEM_SHARE
#define MEM_SHARE 2
#endif
#ifndef SWA_SHARE
#define SWA_SHARE 2
#endif
template <bool SWA_MODE, bool OF8, int NH>
__device__ __forceinline__ void attn_swa3(LAS const unsigned char* Ks, LAS const unsigned char* Vs, const bf16x8 (*qf)[2], bf16* O  , int ldo, size_t ostride, int kb0, int dbase, int lim, const float* sink, int lane, int mflag) {
    constexpr int NKB = SWA_MODE ? 10 : 16;
    const int fr = lane & 15, fq = lane >> 4;
    f32x4 sacc[NH][NKB];
    const int kx = (fr >> 1) & 7;
    LAS const unsigned char* kbase = Ks + kb0 * 2048 + fr * 128;
#pragma unroll
    for (int i = 0; i < NKB; ++i) {
#pragma unroll
        for (int h = 0; h < NH; ++h) sacc[h][i] = (f32x4){0.f, 0.f, 0.f, 0.f};
#pragma unroll
        for (int ks = 0; ks < 2; ++ks) { const bf16x8 a = *(LAS const bf16x8*)(kbase + i * 2048 + (((fq + 4 * ks) ^ kx) * 16));
#pragma unroll
            for (int h = 0; h < NH; ++h) sacc[h][i] = MFMA16(a, qf[h][ks], sacc[h][i]); }
        if (i & 1) __builtin_amdgcn_sched_barrier(0); }
    if (SWA_MODE) { auto maskblk = [&](int i) {
#pragma unroll
          for (int r = 0; r < 4; ++r) { const unsigned d = (unsigned)(dbase - (16 * i + r)); if (d > (unsigned)lim) { for (int h = 0; h < NH; ++h) sacc[h][i][r] = -INFINITY; } } };
      if (mflag & 2) {
#pragma unroll
          for (int i = 0; i < NKB; ++i) maskblk(i); }
      else { maskblk(0); maskblk(NKB - 1); if (mflag & 1) maskblk(1); else maskblk(NKB - 2); } }
    float inv[NH]; bf16x8 pbv[NH][NKB / 2];
#pragma unroll
    for (int h = 0; h < NH; ++h) { f32x4 m4 = sacc[h][0];
#pragma unroll
        for (int i = 1; i < NKB; ++i)
#pragma unroll
            for (int r = 0; r < 4; ++r) m4[r] = fmaxf(m4[r], sacc[h][i][r]);
        float mx = fmaxf(fmaxf(m4[0], m4[1]), fmaxf(m4[2], m4[3]));
        mx = fmaxf(mx, __shfl_xor(mx, 16)); mx = fmaxf(mx, __shfl_xor(mx, 32)); if (SWA_MODE) mx = fmaxf(mx, sink[h]);
        f32x4 s4 = {0.f, 0.f, 0.f, 0.f};
#pragma unroll
        for (int i = 0; i < NKB; ++i) { f32x4 t = sacc[h][i] - mx;
#pragma unroll
            for (int r = 0; r < 4; ++r) t[r] = __builtin_amdgcn_exp2f(t[r]);
            sacc[h][i] = t; s4 += t; }
        float sum = (s4[0] + s4[1]) + (s4[2] + s4[3]);
        sum += __shfl_xor(sum, 16); sum += __shfl_xor(sum, 32); if (SWA_MODE) sum += __builtin_amdgcn_exp2f(sink[h] - mx);
        inv[h] = 1.0f / sum;
#pragma unroll
        for (int g = 0; g < NKB / 2; ++g) pbv[h][g] = pack8(sacc[h][2 * g], sacc[h][2 * g + 1]);
        __builtin_amdgcn_sched_barrier(0); }
    f32x4 oacc[NH][4];
#pragma unroll
    for (int h = 0; h < NH; ++h)
#pragma unroll
        for (int db = 0; db < 4; ++db) oacc[h][db] = (f32x4){0.f, 0.f, 0.f, 0.f};
    const int vx = (2 * fq + (fr >> 3)) & 3;
    LAS const unsigned char* vbase = Vs + kb0 * 2048 + (4 * fq + (fr >> 2)) * 128 + (4 * (fr & 3)) * 2;
#pragma unroll
    for (int g = 0; g < NKB / 2; ++g) {
#pragma unroll
        for (int db = 0; db < 4; ++db) { LAS const unsigned char* p = vbase + g * 4096 + ((db ^ vx) * 32); const bf16x8 va = cat8(ds_tr(p), ds_tr(p + 2048));
#pragma unroll
            for (int h = 0; h < NH; ++h) oacc[h][db] = MFMA16(va, pbv[h][g], oacc[h][db]); }
        __builtin_amdgcn_sched_barrier(0); }
#pragma unroll
    for (int h = 0; h < NH; ++h) {
        if (OF8) { const float isc = inv[h] * MIX_SC; unsigned w[4];
#pragma unroll
            for (int db = 0; db < 4; ++db) { const f32x4 o = oacc[h][db] * isc; w[db] = pg8::pk4_fp8(o[0], o[1], o[2], o[3]); }
            *(u32x4*)((unsigned char*)O + h * ostride + (size_t)fr * ldo + 16 * fq) = (u32x4){w[0], w[1], w[2], w[3]}; }
        else {
#pragma unroll
            for (int db = 0; db < 4; ++db) { const f32x4 o = oacc[h][db] * inv[h]; u32x2 w; w.x = cvtpk(o[0], o[1]); w.y = cvtpk(o[2], o[3]); *(u32x2*)(O + h * ostride + (size_t)fr * ldo + 16 * db + 4 * fq) = w; } } }
}
template <bool SWA_MODE, bool OF8, int NH>
__device__ __forceinline__ void attn_chunked(LAS const unsigned char* Ks, LAS const unsigned char* Vs, const bf16x8 (*qf)[2], bf16* O, int ldo, size_t ostride, int kb0, int dbase, int lim, const float* sink, int lane, int mflag) {
    asm volatile("" : "+v"(lane));
    const int fr = lane & 15, fq = lane >> 4, kx = (fr >> 1) & 7, vx = (2 * fq + (fr >> 3)) & 3;
    LAS const unsigned char* kbase = Ks + kb0 * 2048 + fr * 128;
    LAS const unsigned char* vbase = Vs + kb0 * 2048 + (4 * fq + (fr >> 2)) * 128 + (4 * (fr & 3)) * 2;
    f32x4 oacc[NH][4]; float mrun[NH], lrun[NH];
#pragma unroll
    for (int h = 0; h < NH; ++h) { mrun[h] = SWA_MODE ? sink[h] : -INFINITY; lrun[h] = 0.f;
#pragma unroll
        for (int db = 0; db < 4; ++db) oacc[h][db] = (f32x4){0.f, 0.f, 0.f, 0.f}; }
    auto chunk = [&](auto i0c, auto nbc) { constexpr int I0 = decltype(i0c)::value, NB_ = decltype(nbc)::value;
        f32x4 sc[NH][NB_];
#pragma unroll
        for (int i = 0; i < NB_; ++i) {
#pragma unroll
            for (int h = 0; h < NH; ++h) sc[h][i] = (f32x4){0.f, 0.f, 0.f, 0.f};
#pragma unroll
            for (int ks = 0; ks < 2; ++ks) { const bf16x8 a = *(LAS const bf16x8*)(kbase + (I0 + i) * 2048 + (((fq + 4 * ks) ^ kx) * 16));
#pragma unroll
                for (int h = 0; h < NH; ++h) sc[h][i] = MFMA16(a, qf[h][ks], sc[h][i]); }
            if (i & 1) __builtin_amdgcn_sched_barrier(0); }
        if (SWA_MODE) { auto maskblk = [&](int i) {
#pragma unroll
              for (int r = 0; r < 4; ++r) { const unsigned d = (unsigned)(dbase - (16 * i + r)); if (d > (unsigned)lim) {
#pragma unroll
                  for (int h = 0; h < NH; ++h) sc[h][i - I0][r] = -INFINITY; } } };
#pragma unroll
          for (int i = 0; i < NB_; ++i) { const int bi = I0 + i;
              if ((mflag & 2) || bi == 0 || bi == 9 || (bi == 1 && (mflag & 1)) || (bi == 8 && !(mflag & 1))) maskblk(bi); } }
        bf16x8 pb[NH][NB_ / 2];
#pragma unroll
        for (int h = 0; h < NH; ++h) { f32x4 m4 = sc[h][0];
#pragma unroll
            for (int i = 1; i < NB_; ++i)
#pragma unroll
                for (int r = 0; r < 4; ++r) m4[r] = fmaxf(m4[r], sc[h][i][r]);
            float mx = fmaxf(fmaxf(m4[0], m4[1]), fmaxf(m4[2], m4[3]));
            mx = fmaxf(mx, __shfl_xor(mx, 16)); mx = fmaxf(mx, __shfl_xor(mx, 32));
            const float mnew = fmaxf(mrun[h], mx);
            if (I0 != 0) { const float al = __builtin_amdgcn_exp2f(mrun[h] - mnew); lrun[h] *= al;
#pragma unroll
                for (int db = 0; db < 4; ++db) oacc[h][db] *= al; }
            mrun[h] = mnew;
            f32x4 s4 = {0.f, 0.f, 0.f, 0.f};
#pragma unroll
            for (int i = 0; i < NB_; ++i) { f32x4 t = sc[h][i] - mnew;
#pragma unroll
                for (int r = 0; r < 4; ++r) t[r] = __builtin_amdgcn_exp2f(t[r]);
                sc[h][i] = t; s4 += t; }
            lrun[h] += (s4[0] + s4[1]) + (s4[2] + s4[3]);
#pragma unroll
            for (int g = 0; g < NB_ / 2; ++g) pb[h][g] = pack8(sc[h][2 * g], sc[h][2 * g + 1]);
            __builtin_amdgcn_sched_barrier(0); }
#pragma unroll
        for (int g = 0; g < NB_ / 2; ++g) {
#pragma unroll
            for (int db = 0; db < 4; ++db) { LAS const unsigned char* p = vbase + (I0 / 2 + g) * 4096 + ((db ^ vx) * 32); const bf16x8 va = cat8(ds_tr(p), ds_tr(p + 2048));
#pragma unroll
                for (int h = 0; h < NH; ++h) oacc[h][db] = MFMA16(va, pb[h][g], oacc[h][db]); }
            __builtin_amdgcn_sched_barrier(0); } };
    chunk(std::integral_constant<int, 0>{}, std::integral_constant<int, 4>{});
    chunk(std::integral_constant<int, 4>{}, std::integral_constant<int, 4>{});
    if constexpr (SWA_MODE) chunk(std::integral_constant<int, 8>{}, std::integral_constant<int, 2>{});
    else { chunk(std::integral_constant<int, 8>{}, std::integral_constant<int, 4>{}); chunk(std::integral_constant<int, 12>{}, std::integral_constant<int, 4>{}); }
#pragma unroll
    for (int h = 0; h < NH; ++h) { float sum = lrun[h]; sum += __shfl_xor(sum, 16); sum += __shfl_xor(sum, 32); if (SWA_MODE) sum += __builtin_amdgcn_exp2f(sink[h] - mrun[h]); const float inv = 1.0f / sum;
        if (OF8) { const float isc = inv * MIX_SC; unsigned w[4];
#pragma unroll
            for (int db = 0; db < 4; ++db) { const f32x4 o = oacc[h][db] * isc; w[db] = pg8::pk4_fp8(o[0], o[1], o[2], o[3]); }
            *(u32x4*)((unsigned char*)O + h * ostride + (size_t)fr * ldo + 16 * fq) = (u32x4){w[0], w[1], w[2], w[3]}; }
        else {
#pragma unroll
            for (int db = 0; db < 4; ++db) { const f32x4 o = oacc[h][db] * inv; u32x2 w; w.x = cvtpk(o[0], o[1]); w.y = cvtpk(o[2], o[3]); *(u32x2*)(O + h * ostride + (size_t)fr * ldo + 16 * db + 4 * fq) = w; } } }
}
struct KVPref { u32x4 k[4], v[4]; };
__device__ __forceinline__ void attn_issue(KVPref& P, const bf16* Ksrc, const bf16* Vsrc, int ld, int row_lo) {
    int t_ = threadIdx.x; asm volatile("" : "+v"(t_));
#pragma unroll
    for (int i = 0; i < 4; ++i) { const int c = t_ + NTHREADS * i, row = c >> 3, p8 = c & 7; P.k[i] = (u32x4){0u, 0u, 0u, 0u}; P.v[i] = P.k[i];
        { const int rr = row >= row_lo ? row : row_lo; P.k[i] = *(const u32x4*)(Ksrc + (ptrdiff_t)rr * ld + p8 * 8); P.v[i] = *(const u32x4*)(Vsrc + (ptrdiff_t)rr * ld + p8 * 8); } }
}
__device__ __forceinline__ void attn_store(const KVPref& P, LAS unsigned char* Ks, LAS unsigned char* Vs) {
    int t_ = threadIdx.x; asm volatile("" : "+v"(t_));
#pragma unroll
    for (int i = 0; i < 4; ++i) { const int c = t_ + NTHREADS * i, row = c >> 3, p8 = c & 7;
        *(LAS u32x4*)(Ks + row * 128 + ((p8 ^ ((row >> 1) & 7)) * 16)) = P.k[i];
        *(LAS u32x4*)(Vs + row * 128 + (((p8 >> 1) ^ ((row >> 1) & 3)) * 32) + (p8 & 1) * 16) = P.v[i]; }
}
__device__ __forceinline__ void fast_attn(const Args& a, LAS unsigned char* lds, int layer, bool do_swa, bool do_mem) {
    const int lane = threadIdx.x & 63, wave = threadIdx.x >> 6, fr = lane & 15, fq = lane >> 4;
    const bf16* Z = (const bf16*)(a.ws + WS_Z); bf16* MIX = (bf16*)(a.ws + WS_MIX); const bf16* KV = (const bf16*)(a.ws + WS_MEMKV) + (size_t)layer * NB * NMEM * 512;
    LAS unsigned char* Ks = lds; LAS unsigned char* Vs = lds + 32768;
    const int ldz = 256; const size_t qoff = layer ? ZI_QM : ZH_QM;
    const int nswa = do_swa ? NB * SWKV * (SEQ / 128) : 0, nmem = do_mem ? NB * MEMH * 16 : 0, NU = nswa + nmem;
    KVPref P; bf16x8 qf[4][2];
    auto issue = [&](int u) __attribute__((always_inline)) {
        if (u < nswa) { const int n = u % 64, kvh = (u / 64) % SWKV, b = u / (64 * SWKV); const ptrdiff_t m0 = (ptrdiff_t)b * SEQ + 128 * n;
            const ptrdiff_t kr = ((ptrdiff_t)(b * SWKV + kvh) * SEQ + 128 * n - 128) * HD; (void)m0;
            attn_issue(P, Z + ZI_K + kr, Z + ZI_V + kr, HD, n == 0 ? 128 : 0); }
        else { const int v = u - nswa, h = (v / 16) % MEMH, b = v / (16 * MEMH); attn_issue(P, KV + (size_t)b * NMEM * 512 + h * HD, KV + (size_t)b * NMEM * 512 + 256 + h * HD, 512, 0); } };
    auto load_q = [&](int u) __attribute__((always_inline)) {
        const bool sw = u < nswa; const int us = sw ? u : 0, v = sw ? 0 : u - nswa;
        const int n = us % 64, kvh = (us / 64) % SWKV, bs = us / (64 * SWKV); const int qg = v % 16, hm = (v / 16) % MEMH, bm = v / (16 * MEMH);
#pragma unroll
        for (int i = 0; i < 4; ++i) { const int i3 = i < 3 ? i : 2;
            const size_t offs = ZI_Q + ((size_t)(bs * SWH + kvh * 3 + i3) * SEQ + 128 * n + 16 * wave + fr) * HD;
            const size_t offm = qoff + ((size_t)bm * SEQ + 128 * (4 * qg + i) + 16 * wave + fr) * ldz + hm * HD;
            const bf16* qp = Z + (sw ? offs : offm) + 8 * fq;
#pragma unroll
            for (int ks = 0; ks < 2; ++ks) qf[i][ks] = *(const bf16x8*)(qp + 32 * ks); } };
    LAS float* SK = (LAS float*)(lds + TOK_OFF + 2048);
    if (do_swa) { __syncthreads(); if (threadIdx.x < SWH) SK[threadIdx.x] = a.swa_sinks[threadIdx.x] * LOG2E; __syncthreads(); }
    int u = (gridDim.x % 8 == 0) ? (int)((blockIdx.x % 8) * (gridDim.x / 8) + blockIdx.x / 8) : (int)blockIdx.x; if (u < NU) issue(u);
    for (; u < NU; u += gridDim.x) {
        float sink3[3] = {0.f, 0.f, 0.f};
        if (u < nswa) { const int kvh = (u / 64) % SWKV;
#pragma unroll
            for (int g3 = 0; g3 < 3; ++g3) sink3[g3] = SK[kvh * 3 + g3]; }
        __syncthreads();
        attn_store(P, Ks, Vs);
        load_q(u);
        __builtin_amdgcn_sched_barrier(0);
        issue(u + (int)gridDim.x < NU ? u + (int)gridDim.x : u);
        __syncthreads();
        if (u < nswa) { const int n = u % 64, kvh = (u / 64) % SWKV, b = u / (64 * SWKV); const size_t mr = (size_t)b * SEQ + 128 * n + 16 * wave;
            const int kb0 = wave & ~1, dbase = 128 + 16 * wave + fr - 16 * kb0 - 4 * fq, tq = 128 * n + 16 * wave + fr, lim = tq < 127 ? tq : 127;
            const int mflag = __builtin_amdgcn_readfirstlane((wave & 1) | (n == 0 ? 2 : 0));
            if (SWA_SHARE == 3) attn_swa3<true, OUT_F8_L1 != 0, 3>(Ks, Vs, qf, OUT_F8_L1 ? (bf16*)((unsigned char*)MIX + mr * DM + kvh * 3 * HD) : MIX + mr * DM + kvh * 3 * HD, DM, HD, kb0, dbase, lim, sink3, lane, mflag);
            else if (SWA_SHARE == 2) {
                { const int hq = kvh * 3 + 2; attn_wave16<true, OUT_F8_L1 != 0>(Ks, Vs, qf[2], OUT_F8_L1 ? (bf16*)((unsigned char*)MIX + mr * DM + hq * HD) : MIX + mr * DM + hq * HD, DM, kb0, dbase, lim, sink3[2], lane, mflag); }
                attn_swa3<true, OUT_F8_L1 != 0, 2>(Ks, Vs, qf, OUT_F8_L1 ? (bf16*)((unsigned char*)MIX + mr * DM + kvh * 3 * HD) : MIX + mr * DM + kvh * 3 * HD, DM, HD, kb0, dbase, lim, sink3, lane, mflag); }
            else {
#pragma unroll
            for (int g3 = 0; g3 < 3; ++g3) { const int hq = kvh * 3 + g3; attn_wave16<true, OUT_F8_L1 != 0>(Ks, Vs, qf[g3], OUT_F8_L1 ? (bf16*)((unsigned char*)MIX + mr * DM + hq * HD) : MIX + mr * DM + hq * HD, DM, kb0, dbase, lim, sink3[g3], lane, mflag); } }
        } else if (MEM_SHARE) { const int v = u - nswa, qg = v % 16, h = (v / 16) % MEMH, b = v / (16 * MEMH);
#pragma unroll
            for (int i2 = 0; i2 < 4 / MEM_SHARE; ++i2) { const size_t mr = (size_t)b * SEQ + 128 * (4 * qg + MEM_SHARE * i2) + 16 * wave;
                if (layer ? OUT_F8_L1 : OUT_F8_L0) attn_chunked<false, true, MEM_SHARE>(Ks, Vs, qf + MEM_SHARE * i2, (bf16*)((unsigned char*)MIX + mr * DM + MAINW + h * HD), DM, (size_t)128 * DM, 0, 0, 0, nullptr, lane, 0);
                else attn_chunked<false, false, MEM_SHARE>(Ks, Vs, qf + MEM_SHARE * i2, MIX + mr * DM + MAINW + h * HD, DM, (size_t)128 * DM, 0, 0, 0, nullptr, lane, 0); }
        } else { const int v = u - nswa, qg = v % 16, h = (v / 16) % MEMH, b = v / (16 * MEMH);
#pragma unroll
            for (int i = 0; i < 4; ++i) { const size_t mr = (size_t)b * SEQ + 128 * (4 * qg + i) + 16 * wave; { if (layer ? OUT_F8_L1 : OUT_F8_L0) attn_wave16<false, true>(Ks, Vs, qf[i], (bf16*)((unsigned char*)MIX + mr * DM + MAINW + h * HD), DM, 0, 0, 0, 0.f, lane); else attn_wave16<false, false>(Ks, Vs, qf[i], MIX + mr * DM + MAINW + h * HD, DM, 0, 0, 0, 0.f, lane); } }
        }
    }
}

constexpr int GL_B = 0, GL_QD = 24576, GL_KD = 37888, GL_VT = 51200, GL_ST = 76800, GL_GLR = 115200, GL_GW = 119296, GL_GT = 125440, GL_SSQ = 126976;
constexpr int QSTR = 208, VSTR = 400;
struct G1Pref { f32x4 glr; f32x4 gw; u32x4 q[2], k[2], v[3]; };
__device__ __forceinline__ void g1_issue(G1Pref& P, const Args& a, int u) {
    const int tid = threadIdx.x; const int n = u % NCH, h = (u / NCH) % GH, b = u / (NCH * GH); const size_t m0 = (size_t)b * SEQ + (size_t)n * GCH; const size_t zhb = ((size_t)(b * GH + h) * SEQ + (size_t)n * GCH);
    const bf16* Z = (const bf16*)(a.ws + WS_Z); const float* GLR = (const float*)(a.ws + WS_GLR);
    P.glr = *(const f32x4*)(GLR + m0 * 16 + (tid < 256 ? tid : 255) * 4);
    if (!GLA2) { const int tg = tid < 384 ? tid : 383, j = tg / 24, c4 = (tg % 24) * 4; P.gw = *(const f32x4*)(a.gla_gate_w + j * (GH * GDK) + h * GDK + c4); } else (void)h;
#pragma unroll
    for (int j = 0; j < 2; ++j) { const int i0 = tid + NTHREADS * j, i = i0 < 64 * 12 ? i0 : 64 * 12 - 1; const int t = i / 12, c8 = (i % 12) * 8; P.q[j] = *(const u32x4*)(Z + ZH_Q + (zhb + t) * GDK + c8); P.k[j] = *(const u32x4*)(Z + ZH_K + (zhb + t) * GDK + c8); }
#pragma unroll
    for (int j = 0; j < 3; ++j) { const int i = tid + NTHREADS * j, t = i / 24, ch = i % 24; P.v[j] = *(const u32x4*)(Z + ZH_V + (zhb + t) * GDV + ch * 8); }
}
__device__ __forceinline__ void gla_chunk_kv(const Args& a, LAS unsigned char* lds) {
    const int tid = threadIdx.x, lane = tid & 63, wave = tid >> 6, fr = lane & 15, fq = lane >> 4;
    bf16* Z = (bf16*)(a.ws + WS_Z); bf16* KV = (bf16*)(a.ws + GK_KV); float* DECB = (float*)(a.ws + GK_DEC);
    LAS float* B32 = (LAS float*)(lds + GL_B); LAS unsigned char* KE = lds + GL_KD; LAS unsigned char* VT = lds + GL_VT;
    LAS float* GLT = (LAS float*)(lds + GL_GLR); LAS float* GW = (LAS float*)(lds + GL_GW); LAS float* GT = (LAS float*)(lds + GL_GT); LAS float* EL = (LAS float*)(lds + GL_SSQ);
    constexpr int NU = NB * GH * NCH;
    G1Pref P; int u = blockIdx.x; if (u < NU) g1_issue(P, a, u);
    for (; u < NU; u += gridDim.x) { const int n = u % NCH, h = (u / NCH) % GH, b = u / (NCH * GH); const size_t m0 = (size_t)b * SEQ + (size_t)n * GCH;
        __syncthreads();
        if (tid < 256) *(LAS f32x4*)(GLT + tid * 4) = P.glr;
        if (tid < 384) *(LAS f32x4*)(GW + tid * 4) = P.gw;
        __syncthreads();
        const int c = tid % GDK, rg = tid / GDK;
        if (tid < 4 * GDK) { float gw[16];
#pragma unroll
            for (int j = 0; j < 16; ++j) gw[j] = GW[j * GDK + c];
            const float bias = a.gla_gate_b[h * GDK + c]; float run = 0.f;
#pragma unroll 4
            for (int tt = 0; tt < 16; ++tt) { const int t = rg * 16 + tt; float lg = bias;
#pragma unroll
                for (int q = 0; q < 4; ++q) { const f32x4 g = *(LAS const f32x4*)(GLT + t * 16 + 4 * q); lg += g[0] * gw[4 * q] + g[1] * gw[4 * q + 1] + g[2] * gw[4 * q + 2] + g[3] * gw[4 * q + 3]; }
                const float ls = (fminf(lg, 0.f) - __logf(1.0f + __expf(-fabsf(lg)))) * (1.0f / 16.0f); run += ls; B32[t * GDK + c] = run; }
            GT[rg * GDK + c] = run; }
        __syncthreads();
        if (tid < 4 * GDK) { float pre = 0.f; for (int r = 0; r < rg; ++r) pre += GT[r * GDK + c];
            if (rg > 0) {
#pragma unroll 4
                for (int tt = 0; tt < 16; ++tt) B32[(rg * 16 + tt) * GDK + c] += pre; }
            if (rg == 3) { const float el = __expf(B32[63 * GDK + c]); EL[c] = el; DECB[(size_t)u * GDK + c] = el; } }
        __syncthreads();
#pragma unroll
        for (int j = 0; j < 2; ++j) { const int i = tid + NTHREADS * j; if (i < 64 * 12) { const int t = i / 12, c8 = (i % 12) * 8; float fqv[8], fkv[8], fke[8];
#pragma unroll
            for (int e = 0; e < 4; ++e) { fqv[2 * e] = __uint_as_float(P.q[j][e] << 16); fqv[2 * e + 1] = __uint_as_float(P.q[j][e] & 0xffff0000u); fkv[2 * e] = __uint_as_float(P.k[j][e] << 16); fkv[2 * e + 1] = __uint_as_float(P.k[j][e] & 0xffff0000u); }
#pragma unroll
            for (int e = 0; e < 8; ++e) { const float eb = __expf(B32[t * GDK + c8 + e]), ei = __builtin_amdgcn_rcpf(eb); fqv[e] *= eb; fkv[e] *= ei; fke[e] = fkv[e] * EL[c8 + e]; }
            u32x4 o; o.x = cvtpk(fqv[0], fqv[1]); o.y = cvtpk(fqv[2], fqv[3]); o.z = cvtpk(fqv[4], fqv[5]); o.w = cvtpk(fqv[6], fqv[7]); *(u32x4*)(Z + (m0 + t) * NA + ZA_Q + h * GDK + c8) = o;
            o.x = cvtpk(fkv[0], fkv[1]); o.y = cvtpk(fkv[2], fkv[3]); o.z = cvtpk(fkv[4], fkv[5]); o.w = cvtpk(fkv[6], fkv[7]); *(u32x4*)(Z + (m0 + t) * NA + ZA_K + h * GDK + c8) = o;
            o.x = cvtpk(fke[0], fke[1]); o.y = cvtpk(fke[2], fke[3]); o.z = cvtpk(fke[4], fke[5]); o.w = cvtpk(fke[6], fke[7]); *(LAS u32x4*)(KE + t * QSTR + c8 * 2) = o; } }
#pragma unroll
        for (int j = 0; j < 3; ++j) { const int i = tid + NTHREADS * j, t = i / 24, ch = i % 24; *(LAS u32x4*)(VT + t * VSTR + ch * 16) = P.v[j]; }
        if (u + (int)gridDim.x < NU) g1_issue(P, a, u + gridDim.x);
        __syncthreads();
#pragma unroll 1
        for (int i = 0; i < 9; ++i) { const int bi = wave * 9 + i, cb = bi / 12, dvb = bi % 12; f32x4 acc = {0.f, 0.f, 0.f, 0.f};
#pragma unroll
            for (int ks = 0; ks < 2; ++ks) acc = MFMA16(tr_frag(VT, VSTR, 32 * ks, 16 * dvb, fr, fq), tr_frag(KE, QSTR, 32 * ks, 16 * cb, fr, fq), acc);
            u32x2 w; w.x = cvtpk(acc[0], acc[1]); w.y = cvtpk(acc[2], acc[3]);
            *(u32x2*)(KV + (size_t)u * (GDK * GDV) + (size_t)(16 * cb + fr) * GDV + 16 * dvb + 4 * fq) = w; }
    }
}
__device__ __forceinline__ void gla_scan(const Args& a, int skip) {
    const bf16* KV = (const bf16*)(a.ws + GK_KV); const float* DECB = (const float*)(a.ws + GK_DEC); bf16* ST = (bf16*)(a.ws + GK_ST);
    constexpr int NQ = NB * GH * GDK * (GDV / 4); const int nblk = (int)gridDim.x - skip, bi = (int)blockIdx.x - skip, QPB = (NQ + nblk - 1) / nblk;
    if (bi < 0) return;
    const int qend = (bi + 1) * QPB < NQ ? (bi + 1) * QPB : NQ;
    for (int q = bi * QPB + (int)threadIdx.x; q < qend; q += NTHREADS) {
        const int dv4 = q % (GDV / 4), c = (q / (GDV / 4)) % GDK, bh = q / ((GDV / 4) * GDK);
        f32x4 S = {0.f, 0.f, 0.f, 0.f};
        for (int n0 = 0; n0 < NCH; n0 += 16) { u32x2 kv[16]; float d[16];
#pragma unroll
            for (int i = 0; i < 16; ++i) { const size_t u = (size_t)bh * NCH + n0 + i; kv[i] = *(const u32x2*)(KV + u * (GDK * GDV) + (size_t)c * GDV + 4 * dv4); d[i] = DECB[u * GDK + c]; }
#pragma unroll
            for (int i = 0; i < 16; ++i) { const size_t u = (size_t)bh * NCH + n0 + i; u32x2 w; w.x = cvtpk(S[0], S[1]); w.y = cvtpk(S[2], S[3]); *(u32x2*)(ST + u * (GDK * GDV) + (size_t)c * GDV + 4 * dv4) = w;
                const f32x4 k4 = {__uint_as_float(kv[i].x << 16), __uint_as_float(kv[i].x & 0xffff0000u), __uint_as_float(kv[i].y << 16), __uint_as_float(kv[i].y & 0xffff0000u)}; S = S * d[i] + k4; } }
    }
}
struct G3Pref { u32x4 q[2], k[2], v[3], s[5]; };
__device__ __forceinline__ void g3_issue(G3Pref& P, const Args& a, int u) {
    const int tid = threadIdx.x; const int n = u % NCH, h = (u / NCH) % GH, b = u / (NCH * GH); const size_t m0 = (size_t)b * SEQ + (size_t)n * GCH;
    const bf16* Z = (const bf16*)(a.ws + WS_Z); const bf16* ST = (const bf16*)(a.ws + GK_ST);
#pragma unroll
    for (int j = 0; j < 2; ++j) { const int i = tid + NTHREADS * j; if (i < 64 * 12) { const int t = i / 12, c8 = (i % 12) * 8; P.q[j] = *(const u32x4*)(Z + (m0 + t) * NA + ZA_Q + h * GDK + c8); P.k[j] = *(const u32x4*)(Z + (m0 + t) * NA + ZA_K + h * GDK + c8); } }
#pragma unroll
    for (int j = 0; j < 3; ++j) { const int i = tid + NTHREADS * j, t = i / 24, ch = i % 24; P.v[j] = *(const u32x4*)(Z + (m0 + t) * NA + ZA_V + h * GDV + ch * 8); }
#pragma unroll
    for (int j = 0; j < 5; ++j) { const int i = tid + NTHREADS * j; if (i < GDK * 24) { const int c = i / 24, ch = i % 24; P.s[j] = *(const u32x4*)(ST + (size_t)u * (GDK * GDV) + (size_t)c * GDV + ch * 8); } }
}
__device__ __forceinline__ void gla_output(const Args& a, LAS unsigned char* lds) {
    const int tid = threadIdx.x, lane = tid & 63, wave = tid >> 6, fr = lane & 15, fq = lane >> 4, tb = wave & 3, dh = wave >> 2;
    const bf16* Z = (const bf16*)(a.ws + WS_Z); bf16* MIX = (bf16*)(a.ws + WS_MIX);
    LAS unsigned char* QD = lds + GL_QD; LAS unsigned char* KD = lds + GL_KD; LAS unsigned char* VT = lds + GL_VT; LAS unsigned char* SS = lds + GL_ST; LAS float* SSQ = (LAS float*)(lds + GL_SSQ);
    constexpr int NU = NB * GH * NCH;
    G3Pref P; int u = blockIdx.x; if (u < NU) g3_issue(P, a, u);
    for (; u < NU; u += gridDim.x) { const int n = u % NCH, h = (u / NCH) % GH, b = u / (NCH * GH); const size_t m0 = (size_t)b * SEQ + (size_t)n * GCH;
        __syncthreads();
#pragma unroll
        for (int j = 0; j < 2; ++j) { const int i = tid + NTHREADS * j; if (i < 64 * 12) { const int t = i / 12, c8 = (i % 12) * 8; *(LAS u32x4*)(QD + t * QSTR + c8 * 2) = P.q[j]; *(LAS u32x4*)(KD + t * QSTR + c8 * 2) = P.k[j]; } }
#pragma unroll
        for (int j = 0; j < 3; ++j) { const int i = tid + NTHREADS * j, t = i / 24, ch = i % 24; *(LAS u32x4*)(VT + t * VSTR + ch * 16) = P.v[j]; }
#pragma unroll
        for (int j = 0; j < 5; ++j) { const int i = tid + NTHREADS * j; if (i < GDK * 24) { const int c = i / 24, ch = i % 24; *(LAS u32x4*)(SS + c * VSTR + ch * 16) = P.s[j]; } }
        if (u + (int)gridDim.x < NU) g3_issue(P, a, u + gridDim.x);
        const size_t mr = m0 + 16 * tb + fr; u32x2 rr[6];
#pragma unroll
        for (int i = 0; i < 6; ++i) rr[i] = *(const u32x2*)(Z + mr * NA + ZA_R + h * GDV + 16 * (6 * dh + i) + 4 * fq);
        __syncthreads();
        f32x4 sacc[4];
#pragma unroll
        for (int sb = 0; sb < 4; ++sb) { sacc[sb] = (f32x4){0.f, 0.f, 0.f, 0.f};
            if (sb <= tb) {
#pragma unroll
                for (int ks = 0; ks < 3; ++ks) sacc[sb] = MFMA16(row_frag(KD, QSTR, 16 * sb, 32 * ks, fr, fq), row_frag(QD, QSTR, 16 * tb, 32 * ks, fr, fq), sacc[sb]);
                if (sb == tb) {
#pragma unroll
                    for (int r = 0; r < 4; ++r) if (4 * fq + r > fr) sacc[sb][r] = 0.f; } } }
        const bf16x8 pb0 = pack8(sacc[0], sacc[1]), pb1 = pack8(sacc[2], sacc[3]);
        bf16x8 qb[3];
#pragma unroll
        for (int ks = 0; ks < 3; ++ks) qb[ks] = row_frag(QD, QSTR, 16 * tb, 32 * ks, fr, fq);
        f32x4 oacc[6]; float ssq = 0.f;
#pragma unroll
        for (int i = 0; i < 6; ++i) { const int db = 6 * dh + i; f32x4 acc = {0.f, 0.f, 0.f, 0.f};
            acc = MFMA16(tr_frag_perm(VT, VSTR, 0, 16 * db, fr, fq), pb0, acc);
            if (tb >= 2) acc = MFMA16(tr_frag_perm(VT, VSTR, 32, 16 * db, fr, fq), pb1, acc);
#pragma unroll
            for (int ks = 0; ks < 3; ++ks) acc = MFMA16(tr_frag(SS, VSTR, 32 * ks, 16 * db, fr, fq), qb[ks], acc);
            oacc[i] = acc; ssq += (acc[0] * acc[0] + acc[1] * acc[1]) + (acc[2] * acc[2] + acc[3] * acc[3]); }
        ssq += __shfl_xor(ssq, 16); ssq += __shfl_xor(ssq, 32);
        if (fq == 0) SSQ[dh * 64 + 16 * tb + fr] = ssq;
        __syncthreads();
        const float rs = rsqrtf((SSQ[16 * tb + fr] + SSQ[64 + 16 * tb + fr]) * (1.0f / GDV) + EPS);
#pragma unroll
        for (int i = 0; i < 6; ++i) { const int dv = 16 * (6 * dh + i) + 4 * fq; const f32x4 gn = *(const f32x4*)(a.gla_out_norm + dv);
            const float r0 = __uint_as_float(rr[i].x << 16), r1 = __uint_as_float(rr[i].x & 0xffff0000u), r2 = __uint_as_float(rr[i].y << 16), r3 = __uint_as_float(rr[i].y & 0xffff0000u);
            const f32x4 o = oacc[i] * rs * gn; u32x2 w; w.x = cvtpk(o[0] * silu_f(r0), o[1] * silu_f(r1)); w.y = cvtpk(o[2] * silu_f(r2), o[3] * silu_f(r3));
            *(u32x2*)(MIX + mr * DM + h * GDV + dv) = w; }
    }
}


constexpr int GGC = 8, GNG = NCH / GGC;
constexpr size_t G2_AGG = WS_GK, G2_GST = WS_GK + 32 * MiB, G2_GD = WS_GK + 64 * MiB;
constexpr int GL_EL = GL_SSQ + 512;
__device__ __forceinline__ int gla2_chunk(int unit, int ci) { return (unit / GNG) * NCH + (unit % GNG) * GGC + ci; }
__device__ __forceinline__ void gla2_pass_a(const Args& a, LAS unsigned char* lds) {
    const int tid = threadIdx.x, lane = tid & 63, wave = tid >> 6, fr = lane & 15, fq = lane >> 4;
    bf16* Z = (bf16*)(a.ws + WS_Z); float* AGG = (float*)(a.ws + G2_AGG); float* GD = (float*)(a.ws + G2_GD); float* DECB = (float*)(a.ws + GK_DEC);
    LAS float* B32 = (LAS float*)(lds + GL_B); LAS unsigned char* KE = lds + GL_KD; LAS unsigned char* VT = lds + GL_VT;
    LAS float* GLT = (LAS float*)(lds + GL_GLR); LAS float* GW = (LAS float*)(lds + GL_GW); LAS float* GT = (LAS float*)(lds + GL_GT); LAS float* EL = (LAS float*)(lds + GL_EL); LAS float* BI = (LAS float*)(lds + TOK_OFF);
    constexpr int NUNIT = NB * GH * GNG;
    for (int unit = blockIdx.x; unit < NUNIT; unit += gridDim.x) {
        f32x4 agg[9];
#pragma unroll
        for (int i = 0; i < 9; ++i) agg[i] = (f32x4){0.f, 0.f, 0.f, 0.f};
        float gd = 1.0f;
        G1Pref PP[2]; g1_issue(PP[0], a, gla2_chunk(unit, 0));
        { const int h0 = (gla2_chunk(unit, 0) / NCH) % GH; __syncthreads(); if (tid < 384) { const int j = tid / 24, c4 = (tid % 24) * 4; *(LAS f32x4*)(GW + tid * 4) = *(const f32x4*)(a.gla_gate_w + j * (GH * GDK) + h0 * GDK + c4); }
          if (tid < GDK) BI[tid] = a.gla_gate_b[h0 * GDK + tid]; }
#pragma unroll
        for (int ci = 0; ci < GGC; ++ci) { const int u = gla2_chunk(unit, ci); const int n = u % NCH, h = (u / NCH) % GH, b = u / (NCH * GH); const size_t m0 = (size_t)b * SEQ + (size_t)n * GCH; const size_t zhb = ((size_t)(b * GH + h) * SEQ + (size_t)n * GCH); (void)m0; (void)h;
            if (ci + 1 < GGC) g1_issue(PP[(ci + 1) & 1], a, gla2_chunk(unit, ci + 1));
            G1Pref& P = PP[ci & 1];
            __syncthreads();
            if (tid < 256) *(LAS f32x4*)(GLT + tid * 4) = P.glr;
#pragma unroll
            for (int j = 0; j < 3; ++j) { const int i = tid + NTHREADS * j, t = i / 24, ch = i % 24; *(LAS u32x4*)(VT + t * VSTR + ch * 16) = P.v[j]; }
            __syncthreads();
            const int c = tid % GDK, rg = tid / GDK;
            { const int l15 = lane & 15, l4 = lane >> 4;
#pragma unroll
              for (int q = 0; q < 3; ++q) { const int tile = wave * 3 + q, tm = tile / 6, cn = tile % 6; f32x4 acc = {0.f, 0.f, 0.f, 0.f};
#pragma unroll
                  for (int k0 = 0; k0 < 4; ++k0) acc = __builtin_amdgcn_mfma_f32_16x16x4f32(GLT[(16 * tm + l15) * 16 + 4 * k0 + l4], GW[(4 * k0 + l4) * GDK + 16 * cn + l15], acc, 0, 0, 0);
                  const float bc = BI[16 * cn + l15];
#pragma unroll
                  for (int r = 0; r < 4; ++r) { const float lg = acc[r] + bc; B32[(16 * tm + 4 * l4 + r) * GDK + 16 * cn + l15] = (fminf(lg, 0.f) - __logf(1.0f + __expf(-fabsf(lg)))) * (1.0f / 16.0f); } } }
            __syncthreads();
            if (tid < 4 * GDK) { float run = 0.f;
#pragma unroll 4
                for (int tt = 0; tt < 16; ++tt) { const int t = rg * 16 + tt; run += B32[t * GDK + c]; B32[t * GDK + c] = run; }
                GT[rg * GDK + c] = run; }
            __syncthreads();
            if (tid < 4 * GDK) { float pre = 0.f; for (int r = 0; r < rg; ++r) pre += GT[r * GDK + c];
                if (rg > 0) {
#pragma unroll 4
                    for (int tt = 0; tt < 16; ++tt) B32[(rg * 16 + tt) * GDK + c] += pre; }
                if (rg == 3) { const float el = __expf(B32[63 * GDK + c]); EL[c] = el; DECB[(size_t)u * GDK + c] = el; } }
            __syncthreads();
            if (tid < GDK) gd *= EL[tid];
#pragma unroll
            for (int j = 0; j < 2; ++j) { const int i = tid + NTHREADS * j; if (i < 64 * 12) { const int t = i / 12, c8 = (i % 12) * 8; float fqv[8], fkv[8], fke[8];
#pragma unroll
                for (int e = 0; e < 4; ++e) { fqv[2 * e] = __uint_as_float(P.q[j][e] << 16); fqv[2 * e + 1] = __uint_as_float(P.q[j][e] & 0xffff0000u); fkv[2 * e] = __uint_as_float(P.k[j][e] << 16); fkv[2 * e + 1] = __uint_as_float(P.k[j][e] & 0xffff0000u); }
#pragma unroll
                for (int e = 0; e < 8; ++e) { const float eb = __expf(B32[t * GDK + c8 + e]), ei = __builtin_amdgcn_rcpf(eb); fqv[e] *= eb; fkv[e] *= ei; fke[e] = fkv[e] * EL[c8 + e]; }
                u32x4 o; o.x = cvtpk(fqv[0], fqv[1]); o.y = cvtpk(fqv[2], fqv[3]); o.z = cvtpk(fqv[4], fqv[5]); o.w = cvtpk(fqv[6], fqv[7]); *(u32x4*)(Z + ZH_Q + (zhb + t) * GDK + c8) = o;
                o.x = cvtpk(fkv[0], fkv[1]); o.y = cvtpk(fkv[2], fkv[3]); o.z = cvtpk(fkv[4], fkv[5]); o.w = cvtpk(fkv[6], fkv[7]); *(u32x4*)(Z + ZH_K + (zhb + t) * GDK + c8) = o;
                o.x = cvtpk(fke[0], fke[1]); o.y = cvtpk(fke[2], fke[3]); o.z = cvtpk(fke[4], fke[5]); o.w = cvtpk(fke[6], fke[7]); *(LAS u32x4*)(KE + t * QSTR + c8 * 2) = o; } }
            __syncthreads();
            { LAS const unsigned char* vp = VT + (8 * fq + (fr >> 2)) * VSTR + (48 * (wave >> 1) + 4 * (fr & 3)) * 2; LAS const unsigned char* kp = KE + (8 * fq + (fr >> 2)) * QSTR + (48 * (wave & 1) + 4 * (fr & 3)) * 2;
#pragma unroll
              for (int j = 0; j < 3; ++j) { const float el = EL[48 * (wave & 1) + 16 * j + fr];
#pragma unroll
                for (int k = 0; k < 3; ++k) { f32x4 acc = agg[3 * j + k] * el;
#pragma unroll
                    for (int ks = 0; ks < 2; ++ks) acc = MFMA16(tr2(vp + 32 * ks * VSTR + 32 * k, VSTR), tr2(kp + 32 * ks * QSTR + 32 * j, QSTR), acc);
                    agg[3 * j + k] = acc; }
                __builtin_amdgcn_sched_barrier(0); } }
        }
#pragma unroll
        for (int j = 0; j < 3; ++j)
#pragma unroll
            for (int k = 0; k < 3; ++k) *(f32x4*)(AGG + (size_t)unit * (GDK * GDV) + (size_t)(48 * (wave & 1) + 16 * j + fr) * GDV + 48 * (wave >> 1) + 16 * k + 4 * fq) = agg[3 * j + k];
        if (tid < GDK) GD[(size_t)unit * GDK + tid] = gd;
    }
}
__device__ __forceinline__ void gla2_scan(const Args& a, int skip) {
    const float* AGG = (const float*)(a.ws + G2_AGG); const float* GD = (const float*)(a.ws + G2_GD); float* GST = (float*)(a.ws + G2_GST);
    constexpr int NQ = NB * GH * GDK * (GDV / 4); const int nblk = (int)gridDim.x - skip, bi = (int)blockIdx.x - skip, QPB = (NQ + nblk - 1) / nblk;
    if (bi < 0) return;
    const int qend = (bi + 1) * QPB < NQ ? (bi + 1) * QPB : NQ;
    for (int q = bi * QPB + (int)threadIdx.x; q < qend; q += NTHREADS) { const int dv4 = q % (GDV / 4), c = (q / (GDV / 4)) % GDK, bh = q / ((GDV / 4) * GDK);
        f32x4 kv[GNG]; float d[GNG];
#pragma unroll
        for (int g = 0; g < GNG; ++g) { const size_t un = (size_t)bh * GNG + g; kv[g] = *(const f32x4*)(AGG + un * (GDK * GDV) + (size_t)c * GDV + 4 * dv4); d[g] = GD[un * GDK + c]; }
        f32x4 S = {0.f, 0.f, 0.f, 0.f};
#pragma unroll
        for (int g = 0; g < GNG; ++g) { const size_t un = (size_t)bh * GNG + g; *(f32x4*)(GST + un * (GDK * GDV) + (size_t)c * GDV + 4 * dv4) = S; S = S * d[g] + kv[g]; } }
}
struct G3bPref { u32x4 q[2], k[2], v[3]; u32x2 r[6]; float el; };
__device__ __forceinline__ void g3b_issue(G3bPref& P, const Args& a, int u, int tb, int dh, int fr, int fq) {
    const int tid = threadIdx.x; const int n = u % NCH, h = (u / NCH) % GH, b = u / (NCH * GH); const size_t m0 = (size_t)b * SEQ + (size_t)n * GCH; const bf16* Z = (const bf16*)(a.ws + WS_Z); const size_t zhb = ((size_t)(b * GH + h) * SEQ + (size_t)n * GCH); (void)m0;
#pragma unroll
    for (int j = 0; j < 2; ++j) { const int i0 = tid + NTHREADS * j, i = i0 < 64 * 12 ? i0 : 64 * 12 - 1; const int t = i / 12, c8 = (i % 12) * 8;
        P.q[j] = __builtin_nontemporal_load((const u32x4*)(Z + ZH_Q + (zhb + t) * GDK + c8)); P.k[j] = __builtin_nontemporal_load((const u32x4*)(Z + ZH_K + (zhb + t) * GDK + c8)); }
#pragma unroll
    for (int j = 0; j < 3; ++j) { const int i = tid + NTHREADS * j, t = i / 24, ch = i % 24; P.v[j] = __builtin_nontemporal_load((const u32x4*)(Z + ZH_V + (zhb + t) * GDV + ch * 8)); }
#pragma unroll
    for (int i = 0; i < 6; ++i) P.r[i] = *(const u32x2*)(Z + ZH_R + (zhb + 16 * tb + fr) * GDV + 16 * (6 * dh + i) + 4 * fq);
    P.el = ((const float*)(a.ws + GK_DEC))[(size_t)u * GDK + (tid < GDK ? tid : GDK - 1)];
}
__device__ __forceinline__ void gla2_pass_b(const Args& a, LAS unsigned char* lds) {
    const int tid = threadIdx.x, lane = tid & 63, wave = tid >> 6, fr = lane & 15, fq = lane >> 4, tb = wave & 3, dh = wave >> 2;
    const bf16* Z = (const bf16*)(a.ws + WS_Z); bf16* MIX = (bf16*)(a.ws + WS_MIX); const float* GST = (const float*)(a.ws + G2_GST);
    LAS unsigned char* QD = lds + GL_QD; LAS unsigned char* KD = lds + GL_KD; LAS unsigned char* VT = lds + GL_VT; LAS unsigned char* SS = lds + GL_ST; LAS float* SSQ = (LAS float*)(lds + GL_SSQ); LAS float* EL = (LAS float*)(lds + GL_EL);
    constexpr int NUNIT = NB * GH * GNG;
    LAS float* GN = (LAS float*)(lds + TOK_OFF);
    __syncthreads(); if (tid < GDV / 4) *(LAS f32x4*)(GN + 4 * tid) = *(const f32x4*)(a.gla_out_norm + 4 * tid); __syncthreads();
    for (int unit = blockIdx.x; unit < NUNIT; unit += gridDim.x) {
        f32x4 st[9];
#pragma unroll
        for (int i = 0; i < 9; ++i) { const int j = i / 3, k = i % 3; st[i] = *(const f32x4*)(GST + (size_t)unit * (GDK * GDV) + (size_t)(48 * (wave & 1) + 16 * j + fr) * GDV + 48 * (wave >> 1) + 16 * k + 4 * fq); }
        G3bPref PP[2]; g3b_issue(PP[0], a, gla2_chunk(unit, 0), tb, dh, fr, fq);
#pragma unroll
        for (int ci = 0; ci < GGC; ++ci) { const int u = gla2_chunk(unit, ci); const int n = u % NCH, h = (u / NCH) % GH, b = u / (NCH * GH); const size_t m0 = (size_t)b * SEQ + (size_t)n * GCH;
            if (ci + 1 < GGC) g3b_issue(PP[(ci + 1) & 1], a, gla2_chunk(unit, ci + 1), tb, dh, fr, fq);
            G3bPref& P = PP[ci & 1];
            __syncthreads();
#pragma unroll
            for (int j = 0; j < 2; ++j) { const int i = tid + NTHREADS * j; const bool in = i < 64 * 12; const int t = i / 12, c8 = (i % 12) * 8;
                LAS unsigned char* dq = in ? QD + t * QSTR + c8 * 2 : lds + TOK_OFF + 4096 + (tid & 255) * 16; LAS unsigned char* dk = in ? KD + t * QSTR + c8 * 2 : lds + TOK_OFF + 8192 + (tid & 255) * 16;
                *(LAS u32x4*)dq = P.q[j]; *(LAS u32x4*)dk = P.k[j]; }
#pragma unroll
            for (int j = 0; j < 3; ++j) { const int i = tid + NTHREADS * j, t = i / 24, ch = i % 24; *(LAS u32x4*)(VT + t * VSTR + ch * 16) = P.v[j]; }
            EL[tid < GDK ? tid : GDK + (tid & 31)] = P.el;
#pragma unroll
            for (int i = 0; i < 9; ++i) { const int j = i / 3, k = i % 3; u32x2 w; w.x = cvtpk(st[i][0], st[i][1]); w.y = cvtpk(st[i][2], st[i][3]); *(LAS u32x2*)(SS + (48 * (wave & 1) + fr) * VSTR + (48 * (wave >> 1) + 4 * fq) * 2 + j * 16 * VSTR + k * 32) = w; }
            const size_t mr = m0 + 16 * tb + fr;
            __syncthreads();
            f32x4 sacc[4];
#pragma unroll
            for (int sb = 0; sb < 4; ++sb) { sacc[sb] = (f32x4){0.f, 0.f, 0.f, 0.f};
                if (sb <= tb) {
#pragma unroll
                    for (int ks = 0; ks < 3; ++ks) sacc[sb] = MFMA16(row_frag(KD, QSTR, 16 * sb, 32 * ks, fr, fq), row_frag(QD, QSTR, 16 * tb, 32 * ks, fr, fq), sacc[sb]);
                    if (sb == tb) {
#pragma unroll
                        for (int r = 0; r < 4; ++r) if (4 * fq + r > fr) sacc[sb][r] = 0.f; } } }
            const bf16x8 pb0 = pack8(sacc[0], sacc[1]), pb1 = pack8(sacc[2], sacc[3]);
            bf16x8 qb[3];
#pragma unroll
            for (int ks = 0; ks < 3; ++ks) qb[ks] = row_frag(QD, QSTR, 16 * tb, 32 * ks, fr, fq);
            f32x4 oacc[6]; float ssq = 0.f;
            LAS const unsigned char* vpp = VT + (4 * fq + (fr >> 2)) * VSTR + (96 * dh + 4 * (fr & 3)) * 2; LAS const unsigned char* spp = SS + (8 * fq + (fr >> 2)) * VSTR + (96 * dh + 4 * (fr & 3)) * 2;
#pragma unroll
            for (int i = 0; i < 6; ++i) { f32x4 acc = {0.f, 0.f, 0.f, 0.f};
                acc = MFMA16(cat8(ds_tr(vpp + 32 * i), ds_tr(vpp + 32 * i + 16 * VSTR)), pb0, acc);
                if (tb >= 2) acc = MFMA16(cat8(ds_tr(vpp + 32 * VSTR + 32 * i), ds_tr(vpp + 48 * VSTR + 32 * i)), pb1, acc);
#pragma unroll
                for (int ks = 0; ks < 3; ++ks) acc = MFMA16(tr2(spp + 32 * ks * VSTR + 32 * i, VSTR), qb[ks], acc);
                oacc[i] = acc; ssq += (acc[0] * acc[0] + acc[1] * acc[1]) + (acc[2] * acc[2] + acc[3] * acc[3]); if (i & 1) __builtin_amdgcn_sched_barrier(0); }
            ssq += __shfl_xor(ssq, 16); ssq += __shfl_xor(ssq, 32);
            if (fq == 0) SSQ[dh * 64 + 16 * tb + fr] = ssq;
            { LAS const unsigned char* vp = VT + (8 * fq + (fr >> 2)) * VSTR + (48 * (wave >> 1) + 4 * (fr & 3)) * 2; LAS const unsigned char* kp = KD + (8 * fq + (fr >> 2)) * QSTR + (48 * (wave & 1) + 4 * (fr & 3)) * 2;
#pragma unroll
              for (int j = 0; j < 3; ++j) { const float el = EL[48 * (wave & 1) + 16 * j + fr];
#pragma unroll
                for (int k = 0; k < 3; ++k) { f32x4 acc = st[3 * j + k];
#pragma unroll
                    for (int ks = 0; ks < 2; ++ks) acc = MFMA16(tr2(vp + 32 * ks * VSTR + 32 * k, VSTR), tr2(kp + 32 * ks * QSTR + 32 * j, QSTR), acc);
                    st[3 * j + k] = acc * el; }
                __builtin_amdgcn_sched_barrier(0); } }
            __syncthreads();
            const float rs = rsqrtf((SSQ[16 * tb + fr] + SSQ[64 + 16 * tb + fr]) * (1.0f / GDV) + EPS);
            unsigned w8[6];
#pragma unroll
            for (int i = 0; i < 6; ++i) { const int dv = 16 * (6 * dh + i) + 4 * fq; const f32x4 gn = *(LAS const f32x4*)(GN + dv);
                const float r0 = __uint_as_float(P.r[i].x << 16), r1 = __uint_as_float(P.r[i].x & 0xffff0000u), r2 = __uint_as_float(P.r[i].y << 16), r3 = __uint_as_float(P.r[i].y & 0xffff0000u);
                if (OUT_F8_L0) { const f32x4 o = oacc[i] * (rs * MIX_SC) * gn; w8[i] = pg8::pk4_fp8(o[0] * silu_fast(r0), o[1] * silu_fast(r1), o[2] * silu_fast(r2), o[3] * silu_fast(r3)); }
                else { const f32x4 sg = {silu_fast(r0), silu_fast(r1), silu_fast(r2), silu_fast(r3)}; const f32x4 o = oacc[i] * rs * gn * sg; u32x2 w; w.x = cvtpk(o[0], o[1]); w.y = cvtpk(o[2], o[3]);
                    *(u32x2*)(MIX + mr * DM + h * GDV + dv) = w; } }
            if (OUT_F8_L0) { unsigned char* mp = (unsigned char*)MIX + mr * DM + h * GDV + 96 * dh;
                *(u32x4*)(mp + 16 * fq) = (u32x4){w8[0], w8[1], w8[2], w8[3]}; *(u32x2*)(mp + 64 + 8 * fq) = (u32x2){w8[4], w8[5]}; }
        }
    }
}

__device__ __forceinline__ void memkv_tiles(const Args& a, LAS unsigned char* lds) {
    const int tid = threadIdx.x, lane = tid & 63, wave = tid >> 6, fr = lane & 15, fq = lane >> 4; constexpr int STR = 528;
    LAS unsigned char* At = lds; LAS unsigned char* Bt = lds + 64 * STR;
    for (int u = blockIdx.x; u < 256; u += gridDim.x) { const int l = u >> 7, rt = (u & 127) >> 3, ct = u & 7;
        const bf16* A = (const bf16*)(a.ws + WS_MEMN) + (size_t)l * NB * NMEM * DM + (size_t)(64 * rt) * DM; const bf16* B = (const bf16*)(a.ws + WT_MKV) + (size_t)l * 512 * DM + (size_t)(64 * ct) * DM;
        u32x4 pa[4], pb[4];
#pragma unroll
        for (int i = 0; i < 4; ++i) { const int c = tid + NTHREADS * i, row = c >> 5, pc = c & 31; pa[i] = *(const u32x4*)(A + (size_t)row * DM + pc * 8); pb[i] = *(const u32x4*)(B + (size_t)row * DM + pc * 8); }
        f32x4 acc0 = {0.f, 0.f, 0.f, 0.f}, acc1 = acc0;
#pragma unroll
        for (int kc = 0; kc < 4; ++kc) { const int kn = kc < 3 ? kc + 1 : kc;
            __syncthreads();
#pragma unroll
            for (int i = 0; i < 4; ++i) { const int c = tid + NTHREADS * i, row = c >> 5, pc = c & 31; *(LAS u32x4*)(At + row * STR + pc * 16) = pa[i]; *(LAS u32x4*)(Bt + row * STR + pc * 16) = pb[i]; }
            {
#pragma unroll
                for (int i = 0; i < 4; ++i) { const int c = tid + NTHREADS * i, row = c >> 5, pc = c & 31; pa[i] = *(const u32x4*)(A + (size_t)row * DM + 256 * kn + pc * 8); pb[i] = *(const u32x4*)(B + (size_t)row * DM + 256 * kn + pc * 8); } }
            __syncthreads();
#pragma unroll
            for (int ks = 0; ks < 8; ++ks) { const bf16x8 af = row_frag(At, STR, 16 * (wave >> 1), 32 * ks, fr, fq);
                acc0 = MFMA16(row_frag(Bt, STR, 32 * (wave & 1), 32 * ks, fr, fq), af, acc0); acc1 = MFMA16(row_frag(Bt, STR, 32 * (wave & 1) + 16, 32 * ks, fr, fq), af, acc1); }
        }
        bf16* O = (bf16*)(a.ws + WS_MEMKV) + (size_t)l * NB * NMEM * 512 + (size_t)(64 * rt + 16 * (wave >> 1) + fr) * 512 + 64 * ct + 32 * (wave & 1) + 4 * fq;
        u32x2 w; w.x = cvtpk(acc0[0], acc0[1]); w.y = cvtpk(acc0[2], acc0[3]); *(u32x2*)O = w;
        w.x = cvtpk(acc1[0], acc1[1]); w.y = cvtpk(acc1[2], acc1[3]); *(u32x2*)(O + 16) = w; }
}

template <bool DUAL, class AF, class BF, class B2F, class EF>
__device__ __forceinline__ void simple_gemm(LAS float* sm, int Mrows, int N, int K, AF a_at, BF b_at, B2F b2_at, EF epi) {
    const int tid = threadIdx.x, ty = tid >> 4, tx = tid & 15;
    LAS float* As = sm; LAS float* Bs = sm + 16 * 132; LAS float* B2 = Bs + 16 * 68;
    const int tm = (Mrows + 127) / 128, tn = (N + 63) / 64;
    for (int t = blockIdx.x; t < tm * tn; t += gridDim.x) {
        const int m0 = (t / tn) * 128, n0 = (t % tn) * 64;
        float acc[4][4], acc2[4][4];
#pragma unroll
        for (int i = 0; i < 4; ++i)
#pragma unroll
            for (int j = 0; j < 4; ++j) { acc[i][j] = 0.f; acc2[i][j] = 0.f; }
        for (int k0 = 0; k0 < K; k0 += 16) {
#pragma unroll
            for (int i = 0; i < 4; ++i) { const int idx = tid + 512 * i, kk = idx & 15, mm = idx >> 4; As[kk * 132 + mm] = (m0 + mm < Mrows) ? a_at(m0 + mm, k0 + kk) : 0.f; }
#pragma unroll
            for (int i = 0; i < 2; ++i) { const int idx = tid + 512 * i, nn = idx & 63, kk = idx >> 6; const bool ok = n0 + nn < N;
                Bs[kk * 68 + nn] = ok ? b_at(k0 + kk, n0 + nn, m0) : 0.f; if (DUAL) B2[kk * 68 + nn] = ok ? b2_at(k0 + kk, n0 + nn, m0) : 0.f; }
            __syncthreads();
#pragma unroll
            for (int kk = 0; kk < 16; ++kk) {
                const f32x4 a = *(const LAS f32x4*)(As + kk * 132 + 4 * ty), b = *(const LAS f32x4*)(Bs + kk * 68 + 4 * tx);
                f32x4 b2 = b; if (DUAL) b2 = *(const LAS f32x4*)(B2 + kk * 68 + 4 * tx);
#pragma unroll
                for (int i = 0; i < 4; ++i)
#pragma unroll
                    for (int j = 0; j < 4; ++j) { acc[i][j] += a[i] * b[j]; if (DUAL) acc2[i][j] += a[i] * b2[j]; }
            }
            __syncthreads();
        }
#pragma unroll
        for (int i = 0; i < 4; ++i)
#pragma unroll
            for (int j = 0; j < 4; ++j) { const int m = m0 + 4 * ty + i, n = n0 + 4 * tx + j; if (m < Mrows && n < N) epi(m, n, acc[i][j], acc2[i][j]); }
    }
}

__constant__ float c_inv_freq[8] = {1.0f, 0.1939227432012558f, 0.03760603070259094f, 0.007292664609849453f, 0.0014142135623842478f, 0.00027424818836152554f, 5.318296098266728e-05f, 1.0313386155758053e-05f};

template <bool WITH_GLR>
__device__ __forceinline__ void prep_rows(const Args& a, LAS unsigned char* lds) {
    const int lane = threadIdx.x & 63, wave = threadIdx.x >> 6, gw = blockIdx.x * NWAVES + wave, NGW = gridDim.x * NWAVES;
    bf16* XB = (bf16*)(a.ws + WS_XB); float* SS0 = (float*)(a.ws + WS_SS0); float* GLR = (float*)(a.ws + WS_GLR);
    LAS float* wl = (LAS float*)lds;
    f32x4 nxt[4];
    if (gw < M) { const f32x4* xr = (const f32x4*)(a.x + (size_t)gw * DM) + lane;
#pragma unroll
        for (int j = 0; j < 4; ++j) nxt[j] = __builtin_nontemporal_load(xr + 64 * j); }
    if (WITH_GLR) { __syncthreads();
#pragma unroll
        for (int hb = 0; hb < 2; ++hb) { float tw[16], tg[16];
#pragma unroll
            for (int i = 0; i < 16; ++i) { const int idx = threadIdx.x + NTHREADS * (16 * hb + i), k = idx >> 4, j = idx & 15; tw[i] = a.w_in_a[(size_t)k * WINA + 1536 + j]; tg[i] = a.mix_norm[k]; }
#pragma unroll
            for (int i = 0; i < 16; ++i) { const int idx = threadIdx.x + NTHREADS * (16 * hb + i), k = idx >> 4, j = idx & 15; wl[j * DM + k] = tw[i] * tg[i]; } }
        __syncthreads(); }
    for (int m = gw; m < M; m += NGW) {
        f32x4 v[4]; float s = 0.f;
#pragma unroll
        for (int j = 0; j < 4; ++j) { v[j] = nxt[j]; s += (v[j].x * v[j].x + v[j].y * v[j].y) + (v[j].z * v[j].z + v[j].w * v[j].w); }
        if (m + NGW < M) { const f32x4* xr = (const f32x4*)(a.x + (size_t)(m + NGW) * DM) + lane;
#pragma unroll
            for (int j = 0; j < 4; ++j) nxt[j] = __builtin_nontemporal_load(xr + 64 * j); }
        s = wave_sum(s);
        u32x2* o = (u32x2*)(XB + (size_t)m * DM) + lane;
#pragma unroll
        for (int j = 0; j < 4; ++j) { u32x2 w; w.x = pk2(v[j].x, v[j].y); w.y = pk2(v[j].z, v[j].w); o[64 * j] = w; }
        if (lane == 0) SS0[m] = s;
        if (WITH_GLR) { const float rs = rsqrtf(s * (1.0f / DM) + EPS); float p[16];
#pragma unroll
            for (int o = 0; o < 16; ++o) { float acc = 0.f;
#pragma unroll
                for (int j = 0; j < 4; ++j) { const f32x4 w = *(const LAS f32x4*)(wl + o * DM + 4 * lane + 256 * j); acc += (v[j].x * w.x + v[j].y * w.y) + (v[j].z * w.z + v[j].w * w.w); }
                p[o] = acc; if (o & 1) asm volatile("" ::: "memory"); }
            float q8[8], q4[4], q2[2], q1;
            { const bool hi = (lane & 32) != 0;
#pragma unroll
              for (int i = 0; i < 8; ++i) { const float keep = hi ? p[i + 8] : p[i], give = hi ? p[i] : p[i + 8]; q8[i] = keep + __shfl_xor(give, 32); } }
            { const bool hi = (lane & 16) != 0;
#pragma unroll
              for (int i = 0; i < 4; ++i) { const float keep = hi ? q8[i + 4] : q8[i], give = hi ? q8[i] : q8[i + 4]; q4[i] = keep + __shfl_xor(give, 16); } }
            { const bool hi = (lane & 8) != 0;
#pragma unroll
              for (int i = 0; i < 2; ++i) { const float keep = hi ? q4[i + 2] : q4[i], give = hi ? q4[i] : q4[i + 2]; q2[i] = keep + __shfl_xor(give, 8); } }
            { const bool hi = (lane & 4) != 0; const float keep = hi ? q2[1] : q2[0], give = hi ? q2[0] : q2[1]; q1 = keep + __shfl_xor(give, 4); }
            q1 += __shfl_xor(q1, 2); q1 += __shfl_xor(q1, 1);
            if ((lane & 3) == 0) { const int o = 8 * ((lane >> 5) & 1) + 4 * ((lane >> 4) & 1) + 2 * ((lane >> 3) & 1) + ((lane >> 2) & 1); GLR[m * 16 + o] = q1 * rs; } }
    }
    if (WITH_GLR) __syncthreads();
    bf16* MEMN = (bf16*)(a.ws + WS_MEMN);
    for (int r = gw; r < NB * NMEM; r += NGW) {
        const f32x4* xr = (const f32x4*)(a.mem + (size_t)r * DM) + lane; f32x4 v[4]; float s = 0.f;
#pragma unroll
        for (int j = 0; j < 4; ++j) { v[j] = xr[64 * j]; s += (v[j].x * v[j].x + v[j].y * v[j].y) + (v[j].z * v[j].z + v[j].w * v[j].w); }
        f32x4 gm[2][4];
#pragma unroll
        for (int l = 0; l < 2; ++l)
#pragma unroll
            for (int j = 0; j < 4; ++j) gm[l][j] = *((const f32x4*)(a.mem_norm + l * DM) + lane + 64 * j);
        const float rs = rsqrtf(wave_sum(s) * (1.0f / DM) + EPS);
#pragma unroll
        for (int l = 0; l < 2; ++l) { u32x2* o = (u32x2*)(MEMN + ((size_t)l * NB * NMEM + r) * DM) + lane;
#pragma unroll
            for (int j = 0; j < 4; ++j) { const f32x4 g = gm[l][j]; u32x2 w; w.x = pk2(v[j].x * rs * g.x, v[j].y * rs * g.y); w.y = pk2(v[j].z * rs * g.z, v[j].w * rs * g.w); o[64 * j] = w; } }
    }
    float* ROPE = (float*)(a.ws + WS_ROPE);
    for (int idx = blockIdx.x * NTHREADS + threadIdx.x; idx < M * 8; idx += gridDim.x * NTHREADS) {
        const int m = idx >> 3, i = idx & 7; const float ang = (float)a.positions[m] * c_inv_freq[i];
        const double t = (double)ang * 0.15915494309189533577; const float fr = (float)(t - floor(t));
        ROPE[m * 16 + i] = __builtin_amdgcn_cosf(fr); ROPE[m * 16 + 8 + i] = __builtin_amdgcn_sinf(fr);
    }
}

__device__ __forceinline__ void s_inproj_a(const Args& a, LAS float* sm) {
    const bf16* XB = (const bf16*)(a.ws + WS_XB); const float* SS0 = (const float*)(a.ws + WS_SS0); bf16* Z = (bf16*)(a.ws + WS_Z); float* GLR = (float*)(a.ws + WS_GLR);
    const float* W = a.w_in_a; const float* g = a.mix_norm;
    simple_gemm<false>(sm, M, WINA, DM,
        [&](int m, int k) { return bf2f(XB[(size_t)m * DM + k]) * g[k]; },
        [&](int k, int n, int) { return W[(size_t)k * WINA + n]; }, [&](int, int, int) { return 0.f; },
        [&](int m, int n, float acc, float) { const float v = acc * rsqrtf(SS0[m] * (1.0f / DM) + EPS);
            if (n < 384) Z[(size_t)m * NA + ZA_Q + n] = (bf16)f2bf(v * 0.10206207261596575f);
            else if (n < 768) Z[(size_t)m * NA + ZA_K + (n - 384)] = (bf16)f2bf(v);
            else if (n < 1536) Z[(size_t)m * NA + ZA_V + (n - 768)] = (bf16)f2bf(v);
            else if (n < 1552) GLR[m * 16 + (n - 1536)] = v;
            else if (n < 2320) Z[(size_t)m * NA + ZA_R + (n - 1552)] = (bf16)f2bf(v);
            else Z[(size_t)m * NA + ZA_QM + (n - 2320)] = (bf16)f2bf(v * QS); });
}
__device__ __forceinline__ void s_memkv(const Args& a, LAS float* sm) {
    const bf16* MEMN = (const bf16*)(a.ws + WS_MEMN); bf16* MEMKV = (bf16*)(a.ws + WS_MEMKV);
    for (int l = 0; l < 2; ++l) { const float* W = a.w_mem_kv + (size_t)l * DM * 512; const bf16* A = MEMN + (size_t)l * NB * NMEM * DM; bf16* O = MEMKV + (size_t)l * NB * NMEM * 512;
        simple_gemm<false>(sm, NB * NMEM, 512, DM, [&](int m, int k) { return bf2f(A[(size_t)m * DM + k]); }, [&](int k, int n, int) { return W[(size_t)k * 512 + n]; }, [&](int, int, int) { return 0.f; },
            [&](int m, int n, float acc, float) { O[(size_t)m * 512 + n] = (bf16)f2bf(acc); }); }
}
__device__ __forceinline__ void s_gla_alpha(const Args& a) {
    const float* GLR = (const float*)(a.ws + WS_GLR); float* ALPHA = (float*)(a.ws + GK_ALPHA);
    for (int idx = blockIdx.x * NTHREADS + threadIdx.x; idx < M * 384; idx += gridDim.x * NTHREADS) {
        const int m = idx / 384, c = idx % 384; float lg = a.gla_gate_b[c];
#pragma unroll
        for (int j = 0; j < 16; ++j) lg += GLR[m * 16 + j] * a.gla_gate_w[j * 384 + c];
        const float ls = fminf(lg, 0.f) - log1pf(__expf(-fabsf(lg)));
        ALPHA[idx] = __expf(ls * (1.0f / 16.0f));
    }
}
__device__ __forceinline__ void s_gla_rec(const Args& a) {
    const bf16* Z = (const bf16*)(a.ws + WS_Z); const float* ALPHA = (const float*)(a.ws + GK_ALPHA); float* ORAW = (float*)(a.ws + GK_ORAW);
    for (int item = blockIdx.x; item < NB * GH * 12; item += gridDim.x) {
        const int bh = item / 12, dvg = item % 12, b = bh / GH, h = bh % GH;
        if (threadIdx.x < 64) { const int dv = dvg * 16 + (threadIdx.x & 15), cp = threadIdx.x >> 4, c0 = cp * 24;
            float S[24];
#pragma unroll
            for (int c = 0; c < 24; ++c) S[c] = 0.f;
            for (int t = 0; t < SEQ; ++t) { const size_t m = (size_t)b * SEQ + t; const bf16* zr = Z + m * NA; const float* ar = ALPHA + m * 384 + h * GDK + c0;
                const float vv = bf2f(zr[ZA_V + h * GDV + dv]); float o = 0.f;
#pragma unroll
                for (int c = 0; c < 24; ++c) { S[c] = ar[c] * S[c] + bf2f(zr[ZA_K + h * GDK + c0 + c]) * vv; o += bf2f(zr[ZA_Q + h * GDK + c0 + c]) * S[c]; }
                o += __shfl_xor(o, 16); o += __shfl_xor(o, 32);
                if (cp == 0) ORAW[m * MAINW + h * GDV + dv] = o; }
        }
    }
}
__device__ __forceinline__ void s_gla_out(const Args& a) {
    const int lane = threadIdx.x & 63, gw = blockIdx.x * NWAVES + (threadIdx.x >> 6), NGW = gridDim.x * NWAVES;
    const bf16* Z = (const bf16*)(a.ws + WS_Z); const float* ORAW = (const float*)(a.ws + GK_ORAW); bf16* MIX = (bf16*)(a.ws + WS_MIX);
    for (int it = gw; it < M * GH; it += NGW) { const int m = it / GH, h = it % GH; float o[3]; float s = 0.f;
#pragma unroll
        for (int j = 0; j < 3; ++j) { o[j] = ORAW[(size_t)m * MAINW + h * GDV + lane + 64 * j]; s += o[j] * o[j]; }
        const float rs = rsqrtf(wave_sum(s) * (1.0f / GDV) + EPS);
#pragma unroll
        for (int j = 0; j < 3; ++j) { const int dv = lane + 64 * j; const float r = bf2f(Z[(size_t)m * NA + ZA_R + h * GDV + dv]);
            MIX[(size_t)m * DM + h * GDV + dv] = (bf16)f2bf(o[j] * rs * a.gla_out_norm[dv] * silu_f(r)); } }
}
__device__ __forceinline__ void s_memattn(const Args& a, int layer, int ldz, int qoff) {
    const int lane = threadIdx.x & 63, gw = blockIdx.x * NWAVES + (threadIdx.x >> 6), NGW = gridDim.x * NWAVES;
    const bf16* Z = (const bf16*)(a.ws + WS_Z); const bf16* KV = (const bf16*)(a.ws + WS_MEMKV) + (size_t)layer * NB * NMEM * 512; bf16* MIX = (bf16*)(a.ws + WS_MIX);
    for (int it = gw; it < M * MEMH; it += NGW) { const int m = it / MEMH, h = it % MEMH, b = m / SEQ; const bf16* q = Z + (size_t)m * ldz + qoff + h * HD;
        float s[4];
#pragma unroll
        for (int i = 0; i < 4; ++i) { const bf16* kr = KV + ((size_t)b * NMEM + lane + 64 * i) * 512 + h * HD; float d = 0.f;
            for (int e = 0; e < HD; ++e) d += bf2f(q[e]) * bf2f(kr[e]);
            s[i] = d; }
        const float mx = wave_max(fmaxf(fmaxf(s[0], s[1]), fmaxf(s[2], s[3]))); float p[4], ps = 0.f;
#pragma unroll
        for (int i = 0; i < 4; ++i) { p[i] = exp2f(s[i] - mx); ps += p[i]; }
        const float den = wave_sum(ps); float acc = 0.f;
#pragma unroll
        for (int i = 0; i < 4; ++i) for (int jl = 0; jl < 64; ++jl) acc += __shfl(p[i], jl) * bf2f(KV[((size_t)b * NMEM + jl + 64 * i) * 512 + 256 + h * HD + lane]);
        MIX[(size_t)m * DM + MAINW + h * HD + lane] = (bf16)f2bf(acc / den); }
}
__device__ __forceinline__ void s_swa(const Args& a) {
    const int lane = threadIdx.x & 63, gw = blockIdx.x * NWAVES + (threadIdx.x >> 6), NGW = gridDim.x * NWAVES;
    const bf16* Z = (const bf16*)(a.ws + WS_Z); bf16* MIX = (bf16*)(a.ws + WS_MIX);
    for (int it = gw; it < M * SWH; it += NGW) { const int m = it / SWH, hq = it % SWH, t = m % SEQ, kvh = hq / 3; const bf16* q = Z + (size_t)m * WINB + ZB_Q + hq * HD;
        float s[2]; bool ok[2];
#pragma unroll
        for (int i = 0; i < 2; ++i) { const int off = lane + 64 * i; ok[i] = (t - off) >= 0; const bf16* kr = Z + (size_t)(ok[i] ? m - off : m) * WINB + ZB_K + kvh * HD; float d = 0.f;
            for (int e = 0; e < HD; ++e) d += bf2f(q[e]) * bf2f(kr[e]);
            s[i] = ok[i] ? d : -INFINITY; }
        const float sink = a.swa_sinks[hq] * LOG2E; const float mx = fmaxf(wave_max(fmaxf(s[0], s[1])), sink); float p[2];
#pragma unroll
        for (int i = 0; i < 2; ++i) p[i] = ok[i] ? exp2f(s[i] - mx) : 0.f;
        const float den = wave_sum(p[0] + p[1]) + exp2f(sink - mx); float acc = 0.f;
#pragma unroll
        for (int i = 0; i < 2; ++i) for (int jl = 0; jl < 64; ++jl) { const int off = jl + 64 * i; const float pj = __shfl(p[i], jl); const size_t mr = (t - off) >= 0 ? (size_t)(m - off) : (size_t)m;
            acc += pj * bf2f(Z[mr * WINB + ZB_V + kvh * HD + lane]); }
        MIX[(size_t)m * DM + hq * HD + lane] = (bf16)f2bf(acc / den); }
}
__device__ __forceinline__ void s_outproj(const Args& a, LAS float* sm, int layer) {
    const bf16* MIX = (const bf16*)(a.ws + WS_MIX); const float* W = a.w_out + (size_t)layer * DM * DM; bf16* XB = (bf16*)(a.ws + WS_XB);
    simple_gemm<false>(sm, M, DM, DM, [&](int m, int k) { return bf2f(MIX[(size_t)m * DM + k]); }, [&](int k, int n, int) { return W[(size_t)k * DM + n]; }, [&](int, int, int) { return 0.f; },
        [&](int m, int n, float acc, float) { XB[(size_t)m * DM + n] = (bf16)f2bf(bf2f(XB[(size_t)m * DM + n]) + acc); });
}
__device__ __forceinline__ void s_xb_ss(const Args& a, float* SS) {
    const int lane = threadIdx.x & 63, gw = blockIdx.x * NWAVES + (threadIdx.x >> 6), NGW = gridDim.x * NWAVES; const bf16* XB = (const bf16*)(a.ws + WS_XB);
    for (int m = gw; m < M; m += NGW) { const u32x2* xr = (const u32x2*)(XB + (size_t)m * DM) + lane; float s = 0.f;
#pragma unroll
        for (int j = 0; j < 4; ++j) { const u32x2 w = xr[64 * j]; const float x0 = __uint_as_float(w.x << 16), x1 = __uint_as_float(w.x & 0xffff0000u), x2 = __uint_as_float(w.y << 16), x3 = __uint_as_float(w.y & 0xffff0000u); s += (x0 * x0 + x1 * x1) + (x2 * x2 + x3 * x3); }
        s = wave_sum(s);
        if (lane < 16) SS[(size_t)m * 16 + lane] = lane == 0 ? s : 0.f; }
}
__device__ __forceinline__ void s_ffn_gu(const Args& a, LAS float* sm) {
    const bf16* XB = (const bf16*)(a.ws + WS_XB); const float* SS = (const float*)(a.ws + WS_SSP1); bf16* ACT = (bf16*)(a.ws + GK_ACTF); const float* W = a.ffn_w_gate_up; const float* g = a.ffn_norm;
    simple_gemm<true>(sm, M, DFF, DM, [&](int m, int k) { return bf2f(XB[(size_t)m * DM + k]) * g[k]; },
        [&](int k, int n, int) { return W[(size_t)k * 2 * DFF + n]; }, [&](int k, int n, int) { return W[(size_t)k * 2 * DFF + DFF + n]; },
        [&](int m, int n, float gg, float uu) { const float rs = pg8::rs_from16(SS + (size_t)m * 16); ACT[(size_t)m * DFF + n] = (bf16)f2bf(silu_f(gg * rs) * (uu * rs)); });
}
__device__ __forceinline__ void s_ffn_dn(const Args& a, LAS float* sm) {
    const bf16* ACT = (const bf16*)(a.ws + GK_ACTF); const float* W = a.ffn_w_down; bf16* XB = (bf16*)(a.ws + WS_XB);
    simple_gemm<false>(sm, M, DM, DFF, [&](int m, int k) { return bf2f(ACT[(size_t)m * DFF + k]); }, [&](int k, int n, int) { return W[(size_t)k * DM + n]; }, [&](int, int, int) { return 0.f; },
        [&](int m, int n, float acc, float) { XB[(size_t)m * DM + n] = (bf16)f2bf(bf2f(XB[(size_t)m * DM + n]) + acc); });
}
__device__ __forceinline__ void s_inproj_b(const Args& a, LAS float* sm) {
    const bf16* XB = (const bf16*)(a.ws + WS_XB); const float* SS = (const float*)(a.ws + WS_SSP2); float* ZF = (float*)(a.ws + GK_ZF); const float* W = a.w_in_b; const float* g = a.mix_norm + DM;
    simple_gemm<false>(sm, M, WINB, DM, [&](int m, int k) { return bf2f(XB[(size_t)m * DM + k]) * g[k]; }, [&](int k, int n, int) { return W[(size_t)k * WINB + n]; }, [&](int, int, int) { return 0.f; },
        [&](int m, int n, float acc, float) { float v = acc * pg8::rs_from16(SS + (size_t)m * 16); if (n < ZB_K || n >= ZB_QM) v *= QS; ZF[(size_t)m * WINB + n] = v; });
}
__device__ __forceinline__ void s_rope(const Args& a) {
    const float* ZF = (const float*)(a.ws + GK_ZF); const float* ROPE = (const float*)(a.ws + WS_ROPE); bf16* Z = (bf16*)(a.ws + WS_Z);
    for (size_t idx = (size_t)blockIdx.x * NTHREADS + threadIdx.x; idx < (size_t)M * WINB; idx += (size_t)gridDim.x * NTHREADS) {
        const int m = (int)(idx / WINB), n = (int)(idx % WINB); float v = ZF[idx];
        if (n < ZB_V) { const int d = n & 63; if (d < 16) { const int i = d & 7; const float c = ROPE[m * 16 + i], s = ROPE[m * 16 + 8 + i];
            v = (d < 8) ? v * c - ZF[idx + 8] * s : v * c + ZF[idx - 8] * s; } }
        Z[idx] = (bf16)f2bf(v); }
}
__device__ __forceinline__ void route_token(const Args& a, int m, const f32x4 (&v)[4], float (&lg)[8], float ss, int lane, LAS unsigned* scnt) {
    int* TOPI = (int*)(a.ws + RT_TOPI); float* TOPG = (float*)(a.ws + RT_TOPG); float* RS3 = (float*)(a.ws + RT_RS3); unsigned char* X8 = (unsigned char*)(a.ws + WS_X8);
    ss = wave_sum(ss); const float rs = rsqrtf(ss * (1.0f / DM) + EPS);
    if (MOE_F8 && FAST(18)) { unsigned* dst = (unsigned*)(X8 + (size_t)m * DM) + lane;
#pragma unroll
        for (int j = 0; j < 4; ++j) dst[64 * j] = pg8::pk4_fp8(v[j].x * rs, v[j].y * rs, v[j].z * rs, v[j].w * rs); }
    float q4[4], q2[2], q1;
    { const bool hi = (lane & 32) != 0;
#pragma unroll
      for (int t = 0; t < 4; ++t) { const float keep = hi ? lg[t + 4] : lg[t], give = hi ? lg[t] : lg[t + 4]; q4[t] = keep + __shfl_xor(give, 32); } }
    { const bool hi = (lane & 16) != 0;
#pragma unroll
      for (int t = 0; t < 2; ++t) { const float keep = hi ? q4[t + 2] : q4[t], give = hi ? q4[t] : q4[t + 2]; q2[t] = keep + __shfl_xor(give, 16); } }
    { const bool hi = (lane & 8) != 0; const float keep = hi ? q2[1] : q2[0], give = hi ? q2[0] : q2[1]; q1 = keep + __shfl_xor(give, 8); }
    q1 += __shfl_xor(q1, 4); q1 += __shfl_xor(q1, 2); q1 += __shfl_xor(q1, 1);
    float l8[8];
#pragma unroll
    for (int e = 0; e < 8; ++e) l8[e] = __shfl(q1, 8 * e) * rs;
    int i0 = 0; float v0 = l8[0];
#pragma unroll
    for (int e = 1; e < 8; ++e) if (l8[e] > v0) { v0 = l8[e]; i0 = e; }
    int i1 = -1; float v1 = -INFINITY;
#pragma unroll
    for (int e = 0; e < 8; ++e) if (e != i0 && l8[e] > v1) { v1 = l8[e]; i1 = e; }
    const float g0 = 1.0f / (1.0f + __expf(v1 - v0));
    if (lane == 0) { TOPI[2 * m] = i0; TOPI[2 * m + 1] = i1; TOPG[2 * m] = g0; TOPG[2 * m + 1] = 1.0f - g0; RS3[m] = rs;
        __hip_atomic_fetch_add(&scnt[i0], 1u, __ATOMIC_RELAXED, __HIP_MEMORY_SCOPE_WORKGROUP); __hip_atomic_fetch_add(&scnt[i1], 1u, __ATOMIC_RELAXED, __HIP_MEMORY_SCOPE_WORKGROUP); }
}
__device__ __forceinline__ void route_top2(const Args& a, LAS unsigned char* lds, LAS unsigned* scnt) {
    const int lane = threadIdx.x & 63, wave = threadIdx.x >> 6;
    int* BCNT = (int*)(a.ws + RT_BCNT); const bf16* XB = (const bf16*)(a.ws + WS_XB);
    LAS float* rwl = (LAS float*)lds;
    __syncthreads();
    for (int idx = threadIdx.x; idx < 8 * DM; idx += NTHREADS) { const int k = idx >> 3, e = idx & 7; rwl[e * DM + k] = a.router_w[idx] * a.ffn_norm[DM + k]; }
    __syncthreads();
    for (int vb = blockIdx.x; vb < 256; vb += gridDim.x) {
        if (threadIdx.x < 8) scnt[threadIdx.x] = 0u;
        __syncthreads();
        const int mw = vb * 128 + wave * 16;
        u32x2 nv[4][4];
#pragma unroll
        for (int t = 0; t < 4; ++t) { const u32x2* xr = (const u32x2*)(XB + (size_t)(mw + t) * DM) + lane;
#pragma unroll
            for (int j = 0; j < 4; ++j) nv[t][j] = __builtin_nontemporal_load(xr + 64 * j); }
#pragma unroll 1
        for (int g4 = 0; g4 < 4; ++g4) { f32x4 v[4][4]; float ss[4], lg[4][8];
#pragma unroll
            for (int t = 0; t < 4; ++t) { ss[t] = 0.f;
#pragma unroll
                for (int j = 0; j < 4; ++j) { v[t][j].x = __uint_as_float(nv[t][j].x << 16); v[t][j].y = __uint_as_float(nv[t][j].x & 0xffff0000u); v[t][j].z = __uint_as_float(nv[t][j].y << 16); v[t][j].w = __uint_as_float(nv[t][j].y & 0xffff0000u);
                    ss[t] += (v[t][j].x * v[t][j].x + v[t][j].y * v[t][j].y) + (v[t][j].z * v[t][j].z + v[t][j].w * v[t][j].w); } }
            if (g4 < 3) {
#pragma unroll
                for (int t = 0; t < 4; ++t) { const u32x2* xr = (const u32x2*)(XB + (size_t)(mw + 4 * (g4 + 1) + t) * DM) + lane;
#pragma unroll
                    for (int j = 0; j < 4; ++j) nv[t][j] = __builtin_nontemporal_load(xr + 64 * j); } }
#pragma unroll
            for (int e = 0; e < 8; ++e) { float acc[4] = {0.f, 0.f, 0.f, 0.f};
#pragma unroll
                for (int j = 0; j < 4; ++j) { const f32x4 w = *(const LAS f32x4*)(rwl + e * DM + 4 * lane + 256 * j);
#pragma unroll
                    for (int t = 0; t < 4; ++t) acc[t] += (v[t][j].x * w.x + v[t][j].y * w.y) + (v[t][j].z * w.z + v[t][j].w * w.w); }
#pragma unroll
                for (int t = 0; t < 4; ++t) lg[t][e] = acc[t];
                if (e & 1) asm volatile("" ::: "memory"); }
#pragma unroll
            for (int t = 0; t < 4; ++t) route_token(a, mw + 4 * g4 + t, v[t], lg[t], ss[t], lane, scnt);
        }
        __syncthreads();
        if (threadIdx.x < 8) BCNT[vb * 8 + threadIdx.x] = (int)scnt[threadIdx.x];
        __syncthreads();
    }
}
#ifndef ROUTER_MFMA
#define ROUTER_MFMA 1
#endif
__device__ __forceinline__ void route_top2_mfma(const Args& a, LAS unsigned char* lds, LAS unsigned* scnt) {
    const int tid = threadIdx.x, lane = tid & 63, wave = tid >> 6, fr = lane & 15, fq = lane >> 4;
    int* BCNT = (int*)(a.ws + RT_BCNT); const bf16* XB = (const bf16*)(a.ws + WS_XB);
    int* TOPI = (int*)(a.ws + RT_TOPI); float* TOPG = (float*)(a.ws + RT_TOPG); float* RS3 = (float*)(a.ws + RT_RS3); unsigned char* X8 = (unsigned char*)(a.ws + WS_X8);
    LAS unsigned short* whi = (LAS unsigned short*)lds; LAS unsigned short* wlo = whi + 8192;
    __syncthreads();
    float rw[16], rg[16];
#pragma unroll
    for (int i = 0; i < 16; ++i) { const int idx = tid + NTHREADS * i; rw[i] = a.router_w[idx]; rg[i] = a.ffn_norm[DM + (idx >> 3)]; }
#pragma unroll
    for (int i = 0; i < 16; ++i) { const int idx = tid + NTHREADS * i; const int k = idx >> 3, e = idx & 7; const float w = rw[i] * rg[i];
        const unsigned h = f2bf(w), l = f2bf(w - __uint_as_float(h << 16)); const int ks = 2 * (k >> 6) + ((k >> 3) & 1), q = (k >> 4) & 3, j = k & 7, o = ((ks * 4 + q) * 8 + e) * 8 + j;
        whi[o] = (unsigned short)h; wlo[o] = (unsigned short)l; }
    __syncthreads();
    for (int vb = blockIdx.x; vb < 256; vb += gridDim.x) {
        if (tid < 8) scnt[tid] = 0u;
        __syncthreads();
        const int m = vb * 128 + wave * 16 + fr;
        const u32x4* xr = (const u32x4*)(XB + (size_t)m * DM) + 2 * fq;
        u32x4 x[16][2];
#pragma unroll
        for (int p = 0; p < 16; ++p) { x[p][0] = xr[8 * p]; x[p][1] = xr[8 * p + 1]; }
        f32x4 acc = {0.f, 0.f, 0.f, 0.f}; float ss = 0.f;
        LAS const unsigned char* wp = lds + (fq * 8 + (fr & 7)) * 16;
#pragma unroll
        for (int p = 0; p < 16; ++p)
#pragma unroll
            for (int h = 0; h < 2; ++h) { const u32x4 xv = x[p][h]; const bf16x8 xb = __builtin_bit_cast(bf16x8, xv); const int ks = 2 * p + h;
                const bf16x8 wh = *(LAS const bf16x8*)(wp + ks * 512), wl = *(LAS const bf16x8*)(wp + ks * 512 + 16384);
                acc = MFMA16(wh, xb, acc); acc = MFMA16(wl, xb, acc);
                const float e0 = __uint_as_float(xv.x << 16), e1 = __uint_as_float(xv.x & 0xffff0000u), e2 = __uint_as_float(xv.y << 16), e3 = __uint_as_float(xv.y & 0xffff0000u);
                const float e4 = __uint_as_float(xv.z << 16), e5 = __uint_as_float(xv.z & 0xffff0000u), e6 = __uint_as_float(xv.w << 16), e7 = __uint_as_float(xv.w & 0xffff0000u);
                ss += ((e0 * e0 + e1 * e1) + (e2 * e2 + e3 * e3)) + ((e4 * e4 + e5 * e5) + (e6 * e6 + e7 * e7)); if (h) __builtin_amdgcn_sched_barrier(0); }
        ss += __shfl_xor(ss, 16); ss += __shfl_xor(ss, 32);
        const float rs = rsqrtf(ss * (1.0f / DM) + EPS);
        if (MOE_F8 && FAST(18)) { u32x4* dst = (u32x4*)(X8 + (size_t)m * DM + 16 * fq);
#pragma unroll
            for (int p = 0; p < 16; ++p) { u32x4 w;
#pragma unroll
                for (int h = 0; h < 2; ++h) { u32x4 xv = x[p][h]; asm volatile("" : "+v"(xv));
                    const unsigned lo = pg8::pk4_fp8(__uint_as_float(xv.x << 16) * rs, __uint_as_float(xv.x & 0xffff0000u) * rs, __uint_as_float(xv.y << 16) * rs, __uint_as_float(xv.y & 0xffff0000u) * rs);
                    const unsigned hi = pg8::pk4_fp8(__uint_as_float(xv.z << 16) * rs, __uint_as_float(xv.z & 0xffff0000u) * rs, __uint_as_float(xv.w << 16) * rs, __uint_as_float(xv.w & 0xffff0000u) * rs);
                    if (h == 0) { w.x = lo; w.y = hi; } else { w.z = lo; w.w = hi; } }
                dst[4 * p] = w; if (p & 1) __builtin_amdgcn_sched_barrier(0); } }
        float l8[8];
#pragma unroll
        for (int r = 0; r < 4; ++r) { const float mine = acc[r] * rs, other = __shfl_xor(mine, 16); l8[r] = (fq & 1) ? other : mine; l8[r + 4] = (fq & 1) ? mine : other; }
        int i0 = 0; float v0 = l8[0];
#pragma unroll
        for (int e = 1; e < 8; ++e) if (l8[e] > v0) { v0 = l8[e]; i0 = e; }
        int i1 = -1; float v1 = -INFINITY;
#pragma unroll
        for (int e = 0; e < 8; ++e) if (e != i0 && l8[e] > v1) { v1 = l8[e]; i1 = e; }
        const float g0 = 1.0f / (1.0f + __expf(v1 - v0));
        if (fq == 0) { TOPI[2 * m] = i0; TOPI[2 * m + 1] = i1; TOPG[2 * m] = g0; TOPG[2 * m + 1] = 1.0f - g0; RS3[m] = rs;
            __hip_atomic_fetch_add(&scnt[i0], 1u, __ATOMIC_RELAXED, __HIP_MEMORY_SCOPE_WORKGROUP); __hip_atomic_fetch_add(&scnt[i1], 1u, __ATOMIC_RELAXED, __HIP_MEMORY_SCOPE_WORKGROUP); }
        __syncthreads();
        if (tid < 8) BCNT[vb * 8 + tid] = (int)scnt[tid];
        __syncthreads();
    }
}
__device__ __forceinline__ void route_build(const Args& a, LAS unsigned* sc) {
    const int tid = threadIdx.x, lane = tid & 63, wave = tid >> 6;
    const int* TOPI = (const int*)(a.ws + RT_TOPI); const float* TOPG = (const float*)(a.ws + RT_TOPG); const float* RS3 = (const float*)(a.ws + RT_RS3); const int* BCNT = (const int*)(a.ws + RT_BCNT);
    int* POS = (int*)(a.ws + RT_POS); int* ROWTOK = (int*)(a.ws + RT_ROWTOK); float* ROWGATE = (float*)(a.ws + RT_ROWGATE); float* ROWRS = (float*)(a.ws + RT_ROWRS); int* TILEE = (int*)(a.ws + RT_TILEE);
    const bf16* XB = (const bf16*)(a.ws + WS_XB); bf16* XG = (bf16*)(a.ws + WS_XG);
    for (int vb = blockIdx.x; vb < 256; vb += gridDim.x) {
        __syncthreads();
        { int bc[4];
#pragma unroll
          for (int i = 0; i < 4; ++i) bc[i] = BCNT[tid + NTHREADS * i];
#pragma unroll
          for (int i = 0; i < 4; ++i) sc[320 + tid + NTHREADS * i] = (unsigned)bc[i]; }
        if (tid < 32) sc[288 + tid] = 0u;
        __syncthreads();
        if (tid < 64) {
            const int e = tid >> 3, j = tid & 7; unsigned tot = 0, pre = 0;
            for (int b = j; b < 256; b += 8) { const unsigned c = sc[320 + b * 8 + e]; tot += c; pre += (b < vb) ? c : 0u; }
            tot += __shfl_xor(tot, 1); tot += __shfl_xor(tot, 2); tot += __shfl_xor(tot, 4); pre += __shfl_xor(pre, 1); pre += __shfl_xor(pre, 2); pre += __shfl_xor(pre, 4);
            if (j == 0) { sc[e] = tot; sc[16 + e] = pre; } }
        __syncthreads();
        if (tid == 0) { unsigned base = 0; for (int e = 0; e < 8; ++e) { sc[8 + e] = base; base += (sc[e] + 255u) & ~255u; } sc[24] = base; }
        int my_e = -1; unsigned my_rank = 0;
        if (tid < 256) { my_e = TOPI[2 * (vb * 128) + tid];
#pragma unroll
            for (int e = 0; e < 8; ++e) { const unsigned long long mk = __ballot(my_e == e); if (my_e == e) my_rank = (unsigned)__popcll(mk & ((1ull << lane) - 1ull)); if (lane == 0) sc[288 + wave * 8 + e] = (unsigned)__popcll(mk); } }
        __syncthreads();
        if (tid < 256) { unsigned off = sc[8 + my_e] + sc[16 + my_e]; for (int w = 0; w < wave; ++w) off += sc[288 + w * 8 + my_e]; sc[32 + tid] = off + my_rank; }
        __syncthreads();
        if (tid < 256) { const int i = tid >> 1, s = tid & 1, m = vb * 128 + i; const int row = (int)sc[32 + tid]; POS[2 * m + s] = row; ROWTOK[row] = m; ROWGATE[row] = TOPG[2 * m + s]; ROWRS[row] = RS3[m]; }
        if (MOE_F8 && FAST(18) && MOE_GATHER) {}
        else if (MOE_F8 && FAST(18)) { const unsigned char* X8 = (const unsigned char*)(a.ws + WS_X8);
#pragma unroll 1
            for (int p0 = wave * 32; p0 < wave * 32 + 32; p0 += 8) { u32x4 t[8];
#pragma unroll
                for (int q = 0; q < 8; ++q) { const int p = p0 + q, m = vb * 128 + (p >> 1); t[q] = __builtin_nontemporal_load((const u32x4*)(X8 + (size_t)m * DM) + lane); }
#pragma unroll
                for (int q = 0; q < 8; ++q) { const int row = (int)sc[32 + p0 + q]; *((u32x4*)((unsigned char*)XG + (size_t)row * DM) + lane) = t[q]; } } }
        else { for (int p = wave; p < 256; p += NWAVES) { const int i = p >> 1, m = vb * 128 + i; const int row = (int)sc[32 + p];
            const u32x4* src = (const u32x4*)(XB + (size_t)m * DM); u32x4* dst = (u32x4*)(XG + (size_t)row * DM); dst[lane] = src[lane]; dst[lane + 64] = src[lane + 64]; } }
        if (vb == 0) {
            if (tid < 8) { const unsigned b0 = sc[8 + tid], cnt = sc[tid], pe = (cnt + 255u) & ~255u; for (unsigned t = 0; t < pe / 256u; ++t) TILEE[b0 / 256u + t] = tid; }
            if (tid == 0) TILEE[MAXRT] = (int)(sc[24] / 256u);
            for (int e = 0; e < 8; ++e) { const unsigned b0 = sc[8 + e], cnt = sc[e], pe = (cnt + 255u) & ~255u; for (unsigned r = b0 + cnt + tid; r < b0 + pe; r += NTHREADS) { ROWTOK[r] = -1; ROWGATE[r] = 0.f; ROWRS[r] = 0.f; } }
        }
    }
}
__device__ __forceinline__ void s_moe_gu(const Args& a, LAS float* sm) {
    const bf16* XG = (const bf16*)(a.ws + WS_XG); const int* ROWTOK = (const int*)(a.ws + RT_ROWTOK); const float* ROWRS = (const float*)(a.ws + RT_ROWRS); const int* TILEE = (const int*)(a.ws + RT_TILEE);
    bf16* ACT = (bf16*)(a.ws + WS_ACTM); const float* W = a.exp_w_gate_up; const float* g = a.ffn_norm + DM; const int nrows = TILEE[MAXRT] * 256;
    simple_gemm<true>(sm, nrows, DFE, DM, [&](int m, int k) { return ROWTOK[m] >= 0 ? bf2f(XG[(size_t)m * DM + k]) * g[k] : 0.f; },
        [&](int k, int n, int m0) { return W[((size_t)TILEE[m0 >> 8] * DM + k) * 2 * DFE + n]; }, [&](int k, int n, int m0) { return W[((size_t)TILEE[m0 >> 8] * DM + k) * 2 * DFE + DFE + n]; },
        [&](int m, int n, float gg, float uu) { const float rs = ROWRS[m]; ACT[(size_t)m * DFE + n] = (bf16)f2bf(silu_f(gg * rs) * (uu * rs)); });
}
__device__ __forceinline__ void s_moe_dn(const Args& a, LAS float* sm) {
    const bf16* ACT = (const bf16*)(a.ws + WS_ACTM); const float* ROWGATE = (const float*)(a.ws + RT_ROWGATE); const int* TILEE = (const int*)(a.ws + RT_TILEE);
    bf16* Y = (bf16*)(a.ws + WS_XG); const float* W = a.exp_w_down; const int nrows = TILEE[MAXRT] * 256;
    simple_gemm<false>(sm, nrows, DM, DFE, [&](int m, int k) { return bf2f(ACT[(size_t)m * DFE + k]); }, [&](int k, int n, int m0) { return W[((size_t)TILEE[m0 >> 8] * DFE + k) * DM + n]; }, [&](int, int, int) { return 0.f; },
        [&](int m, int n, float acc, float) { Y[(size_t)m * DM + n] = (bf16)f2bf(acc * ROWGATE[m]); });
}
__device__ __forceinline__ void final_tail_y(const Args& a, int row, int lane, f32x4 (&y)[4]) {
    const float* P = (const float*)(a.ws + WS_Z); const float gate = ((const float*)(a.ws + RT_ROWGATE))[row]; const int rt = (row >> 8) - 256, rl = row & 255;
#pragma unroll
    for (int j = 0; j < 4; ++j) { f32x4 acc = {0.f, 0.f, 0.f, 0.f};
#pragma unroll
        for (int sl = 0; sl < pg8::TAIL_SL; ++sl) acc += *(const f32x4*)(P + (size_t)((rt * 4 + j) * pg8::TAIL_SL + sl) * 65536 + (size_t)rl * 256 + 4 * lane);
        y[j] = acc * gate; }
}
__device__ __forceinline__ void final_rows(const Args& a) {
    int t_ = threadIdx.x; asm volatile("" : "+v"(t_));
    const int lane = t_ & 63, gw = blockIdx.x * NWAVES + (t_ >> 6), NGW = gridDim.x * NWAVES; const int* POS = (const int*)(a.ws + RT_POS); const bf16* XB = (const bf16*)(a.ws + WS_XB);
    constexpr bool tailfix = (MOE_F8 != 0) && (FAST(19) != 0) && (MOE_TAILFIX != 0), yf8 = (Y_F8 != 0) && (MOE_F8 != 0) && (FAST(19) != 0);
    constexpr int YB = yf8 ? 1 : 2;
    const unsigned char* Y = (const unsigned char*)(a.ws + WS_XG);
    int m = gw, pr0 = 0, pr1 = 0, qv0 = 0, qv1 = 0; u32x2 nx[4], n0[4], n1[4];
    f32x4 gfin[4];
#pragma unroll
    for (int j = 0; j < 4; ++j) gfin[j] = *((const f32x4*)a.final_norm + lane + 64 * j);
    auto ldy = [&](int row, u32x2 (&d)[4]) {
#pragma unroll
        for (int j = 0; j < 4; ++j) { if (yf8) { d[j].x = __builtin_nontemporal_load((const unsigned*)(Y + (size_t)row * DM) + lane + 64 * j); d[j].y = 0u; } else d[j] = __builtin_nontemporal_load((const u32x2*)(Y + (size_t)row * DM * 2) + lane + 64 * j); } };
    auto dec = [&](const u32x2 w) -> f32x4 {
        if (yf8) { const f32x2 lo = __builtin_amdgcn_cvt_pk_f32_fp8(w.x, false), hi = __builtin_amdgcn_cvt_pk_f32_fp8(w.x, true); return (f32x4){lo.x, lo.y, hi.x, hi.y} * 0.0625f; }
        return (f32x4){__uint_as_float(w.x << 16), __uint_as_float(w.x & 0xffff0000u), __uint_as_float(w.y << 16), __uint_as_float(w.y & 0xffff0000u)}; };
    (void)YB;
    if (m < M) { pr0 = __builtin_amdgcn_readfirstlane(POS[2 * m]); pr1 = __builtin_amdgcn_readfirstlane(POS[2 * m + 1]); }
    if (m + NGW < M) { qv0 = POS[2 * (m + NGW)]; qv1 = POS[2 * (m + NGW) + 1]; }
    if (m < M) { const u32x2* x3 = (const u32x2*)(XB + (size_t)m * DM) + lane;
#pragma unroll
        for (int j = 0; j < 4; ++j) nx[j] = __builtin_nontemporal_load(x3 + 64 * j);
        ldy(pr0, n0); ldy(pr1, n1); }
    for (; m < M; m += NGW) { const int r0 = pr0, r1 = pr1; u32x2 xv[4], a0[4], a1[4];
#pragma unroll
        for (int j = 0; j < 4; ++j) { xv[j] = nx[j]; a0[j] = n0[j]; a1[j] = n1[j]; }
        pr0 = __builtin_amdgcn_readfirstlane(qv0); pr1 = __builtin_amdgcn_readfirstlane(qv1);
        if (m + NGW < M) { const int mn = m + NGW; const u32x2* x3 = (const u32x2*)(XB + (size_t)mn * DM) + lane;
#pragma unroll
            for (int j = 0; j < 4; ++j) nx[j] = __builtin_nontemporal_load(x3 + 64 * j);
            ldy(pr0, n0); ldy(pr1, n1); }
        if (m + 2 * NGW < M) { qv0 = POS[2 * (m + 2 * NGW)]; qv1 = POS[2 * (m + 2 * NGW) + 1]; }
        f32x4* xr = (f32x4*)(a.out + (size_t)m * DM) + lane;
        f32x4 y0[4], y1[4];
#pragma unroll
        for (int j = 0; j < 4; ++j) { y0[j] = dec(a0[j]); y1[j] = dec(a1[j]); }
        if (tailfix && r0 >= 65536) final_tail_y(a, r0, lane, y0);
        if (tailfix && r1 >= 65536) final_tail_y(a, r1, lane, y1);
        f32x4 v[4]; float s = 0.f;
#pragma unroll
        for (int j = 0; j < 4; ++j) { v[j].x = __uint_as_float(xv[j].x << 16) + (y0[j].x + y1[j].x); v[j].y = __uint_as_float(xv[j].x & 0xffff0000u) + (y0[j].y + y1[j].y);
            v[j].z = __uint_as_float(xv[j].y << 16) + (y0[j].z + y1[j].z); v[j].w = __uint_as_float(xv[j].y & 0xffff0000u) + (y0[j].w + y1[j].w);
            s += (v[j].x * v[j].x + v[j].y * v[j].y) + (v[j].z * v[j].z + v[j].w * v[j].w); }
        const float rs = rsqrtf(wave_sum(s) * (1.0f / DM) + EPS);
#pragma unroll
        for (int j = 0; j < 4; ++j) { const f32x4 g = gfin[j]; __builtin_nontemporal_store((f32x4){v[j].x * rs * g.x, v[j].y * rs * g.y, v[j].z * rs * g.z, v[j].w * rs * g.w}, xr + 64 * j); } }
}

constexpr int NSTEPS = 21;
__global__ void __launch_bounds__(NTHREADS, 2) fwd(Args args) {
    extern __shared__ __attribute__((aligned(16))) unsigned char lds_raw[];
    LAS unsigned char* lds = (LAS unsigned char*)lds_raw;
    LAS float* smf = (LAS float*)lds;
    volatile LAS unsigned* MISC = (volatile LAS unsigned*)(lds + MISC_OFF);
    for (int u = threadIdx.x; u < 512 / 4; u += NTHREADS) ((LAS unsigned*)(lds + MISC_OFF))[u] = 0u;
    __syncthreads();
    unsigned* barw = (unsigned*)(args.ws + WS_CTL) + CW_BAR;
    XcdBarrier bar; bar.bar = barw; bar.x = 0; bar.st = nullptr;
    const int lo = args.lo, hi = args.hi;
    if (hi - lo > 1) bar = xcd_barrier_post(barw, MISC + 8);
#define YOUNG_PRIO(p) do { if (__builtin_amdgcn_readfirstlane(threadIdx.x) >= 256) __builtin_amdgcn_s_setprio(p); } while (0)
#define RUN(s) (lo <= (s) && (s) < hi)
#define SEAM(s) do { if ((s) + 1 < hi) xcd_barrier(bar); } while (0)
    LAS unsigned* sc = (LAS unsigned*)(lds + 65536);

    const int G = gridDim.x, bid = blockIdx.x;
    bf16* const XB = (bf16*)(args.ws + (args.li ? WS_XG : WS_XB));     bf16* const Zb = (bf16*)(args.ws + WS_Z); bf16* const MIX = (bf16*)(args.ws + WS_MIX);
    float* const SS0 = (float*)(args.ws + WS_SS0); float* const SS1 = (float*)(args.ws + (args.li ? WS_XG + 64 * MiB : WS_SSP1)); float* const SS2 = (float*)(args.ws + (args.li ? WS_XG + 64 * MiB : WS_SSP2)); float* const SS3 = nullptr;

    if (RUN(0)) { if (FAST(1)) prep_rows<true>(args, lds); else prep_rows<false>(args, lds); if (FAST(0)) { const bool split7 = CONV_SPLIT && FAST(7) && G > 2 * NCONV7; conv_weights(args, lds, bid * NWAVES, G * NWAVES, MOE_F8 != 0);
        if (MOE_F8) conv_moe(args, lds, bid * NWAVES, G * NWAVES, split7 ? CM_EGU : 0, CM_EGU + CM_EDN); }
        SEAM(0); }
    if (RUN(1)) {
        if (FAST(1)) {
            { pg8::Gemm g{XB, (const bf16*)(args.ws + WT_INA), M, NA, DM, DM}; pg8::StaticOrder S; S.init(M, NA, G, bid); pg8::EpiZA E{Zb, SS0};
              pg8::gemm_phase<pg8::EpiZA, pg8::StaticOrder, true, true>(lds, g, S, E); }
        } else { s_inproj_a(args, smf); s_memkv(args, smf); }
        SEAM(1); }
    if (RUN(2)) { YOUNG_PRIO(1); if (FAST(2)) { if (GLA2) gla2_pass_a(args, lds); else gla_chunk_kv(args, lds); } else s_gla_alpha(args); YOUNG_PRIO(0); SEAM(2); }
    if (RUN(3)) {
        YOUNG_PRIO(1); if (FAST(1)) memkv_tiles(args, lds); YOUNG_PRIO(0);
        if (FAST(2)) { if (GLA2) gla2_scan(args, 0); else gla_scan(args, 0); } else s_gla_rec(args);
        SEAM(3); }
    if (RUN(4)) { YOUNG_PRIO(1); if (FAST(2)) { if (GLA2) gla2_pass_b(args, lds); else gla_output(args, lds); } else s_gla_out(args); if (FAST(4)) fast_attn(args, lds, 0, false, true); else s_memattn(args, 0, NA, ZA_QM); YOUNG_PRIO(0); SEAM(4); }
    if (RUN(5)) {
        if (FAST(5)) { pg8::StaticOrder S; S.init(M, DM, G, bid); pg8::EpiResid<true, FFN_F8 != 0> E{XB, SS1, (unsigned char*)(args.ws + WS_Z)};
            if (OUT_F8_L0) { pg8::Gemm g{MIX, (const bf16*)(args.ws + WT_OUT), M, DM, DM / 2, DM / 2, MIX_ASC}; pg8::gemm_phase<pg8::EpiResid<true, FFN_F8 != 0>, pg8::StaticOrder, true, true, true>(lds, g, S, E); }
            else { pg8::Gemm g{MIX, (const bf16*)(args.ws + WT_OUT), M, DM, DM, DM}; pg8::gemm_phase<pg8::EpiResid<true, FFN_F8 != 0>, pg8::StaticOrder, true, true>(lds, g, S, E); } }
        else s_outproj(args, smf, 0);
        SEAM(5); }
    if (!FAST(5) && RUN(6)) { s_xb_ss(args, SS1); SEAM(6); }
    if (RUN(7)) {
        const bool split7 = CONV_SPLIT && MOE_F8 && FAST(0) && G > 2 * NCONV7; const int g7 = split7 ? G - NCONV7 : G;
        if (FAST(7) && split7 && bid >= g7) conv_moe(args, lds, (bid - g7) * NWAVES, NCONV7 * NWAVES, 0, CM_EGU);
        else if (FAST(7)) { pg8::StaticOrder S; S.init(M, 2 * DFF, g7, bid);
            if (FFN_F8) { pg8::Gemm g{(const bf16*)(args.ws + WS_Z), (const bf16*)(args.ws + WT_FGU), M, 2 * DFF, DM / 2, DM / 2}; pg8::EpiSwiGLUF8<3> E{(unsigned char*)(args.ws + GK_ACTF), DFF, SS1, 0};
                pg8::gemm_phase<pg8::EpiSwiGLUF8<3>, pg8::StaticOrder, true, true, true>(lds, g, S, E); }
            else if (FFN_DN_F8) { pg8::Gemm g{XB, (const bf16*)(args.ws + WT_FGU), M, 2 * DFF, DM, DM}; pg8::EpiSwiGLUF8<3> E{(unsigned char*)(args.ws + GK_ACTF), DFF, SS1, 0};
                pg8::gemm_phase<pg8::EpiSwiGLUF8<3>, pg8::StaticOrder, true, true>(lds, g, S, E); }
            else { pg8::Gemm g{XB, (const bf16*)(args.ws + WT_FGU), M, 2 * DFF, DM, DM}; pg8::EpiSwiGLU<3> E{(bf16*)(args.ws + GK_ACTF), DFF, SS1, 0};
                pg8::gemm_phase<pg8::EpiSwiGLU<3>, pg8::StaticOrder, true, true>(lds, g, S, E); } }
        else s_ffn_gu(args, smf);
        SEAM(7); }
    if (RUN(8)) {
        if (FAST(8)) { pg8::StaticOrder S; S.init(M, DM, G, bid); pg8::EpiResid<true, INB_F8 != 0> E{XB, SS2, INB_F8 ? (unsigned char*)(args.ws + WS_X8) : nullptr};
            if (FFN_F8 || FFN_DN_F8) { pg8::Gemm g{(const bf16*)(args.ws + GK_ACTF), (const bf16*)(args.ws + WT_FDN), M, DM, DFF / 2, DFF / 2}; pg8::gemm_phase<pg8::EpiResid<true, INB_F8 != 0>, pg8::StaticOrder, true, true, true>(lds, g, S, E); }
            else { pg8::Gemm g{(const bf16*)(args.ws + GK_ACTF), (const bf16*)(args.ws + WT_FDN), M, DM, DFF, DFF}; pg8::gemm_phase<pg8::EpiResid<true, INB_F8 != 0>, pg8::StaticOrder, true, true>(lds, g, S, E); } }
        else s_ffn_dn(args, smf);
        SEAM(8); }
    if (!FAST(8) && RUN(9)) { s_xb_ss(args, SS2); SEAM(9); }
    if (RUN(10)) {
        if (FAST(10)) { pg8::StaticOrder S; S.init(M, WINB, G, bid); pg8::EpiRope E{Zb, WINB, SS2, (const float*)(args.ws + WS_ROPE), (LAS f32x4*)(lds + TOK_OFF)};
            if (INB_F8) { pg8::Gemm g{(const bf16*)(args.ws + WS_X8), (const bf16*)(args.ws + WT_INB), M, WINB, DM / 2, DM / 2}; pg8::gemm_phase<pg8::EpiRope, pg8::StaticOrder, true, true, true>(lds, g, S, E); }
            else { pg8::Gemm g{XB, (const bf16*)(args.ws + WT_INB), M, WINB, DM, DM}; pg8::gemm_phase<pg8::EpiRope, pg8::StaticOrder, true, true>(lds, g, S, E); } }
        else s_inproj_b(args, smf);
        SEAM(10); }
    if (!FAST(10) && RUN(11)) { s_rope(args); SEAM(11); }
    if (RUN(12)) { YOUNG_PRIO(1); if (FAST(12) || FAST(4)) fast_attn(args, lds, 1, FAST(12) != 0, FAST(4) != 0); if (!FAST(12)) s_swa(args); if (!FAST(4)) s_memattn(args, 1, WINB, ZB_QM); YOUNG_PRIO(0); SEAM(12); }
    if (RUN(13)) {
        if (FAST(13)) { pg8::StaticOrder S; S.init(M, DM, G, bid); pg8::EpiResid<false> E{XB, SS3, nullptr};
            if (OUT_F8_L1) { pg8::Gemm g{MIX, (const bf16*)(args.ws + WT_OUT) + (size_t)DM * DM, M, DM, DM / 2, DM / 2, MIX_ASC}; pg8::gemm_phase<pg8::EpiResid<false>, pg8::StaticOrder, true, true, true>(lds, g, S, E); }
            else { pg8::Gemm g{MIX, (const bf16*)(args.ws + WT_OUT) + (size_t)DM * DM, M, DM, DM, DM}; pg8::gemm_phase<pg8::EpiResid<false>, pg8::StaticOrder, true, true>(lds, g, S, E); } }
        else s_outproj(args, smf, 1);
        SEAM(13); }
    if (!FAST(13) && RUN(14)) { s_xb_ss(args, SS1); SEAM(14); }
    if (RUN(15)) { if (ROUTER_MFMA) route_top2_mfma(args, lds, sc); else route_top2(args, lds, sc); SEAM(15); }
    if (RUN(16)) { route_build(args, sc); SEAM(16); }
    if (RUN(18)) {
        if (FAST(18)) { const int* TILEE = (const int*)(args.ws + RT_TILEE); const int nrt = TILEE[MAXRT]; pg8::MoeOrder S; S.init(nrt, 2 * DFE / 256, G, bid, TILEE);
            if (MOE_F8 && MOE_GATHER) {
                static_assert((MAXRT * (2 * DFE / 256) + 255) / 256 <= 31, "row table: at most 31 units per workgroup");
                pg8::MoeGatherOrder SG; SG.init(nrt, 2 * DFE / 256, G, bid, TILEE); SG.tok = (LAS const unsigned short*)(lds + TOK_OFF);
                { LAS unsigned short* tk = (LAS unsigned short*)(lds + TOK_OFF); LAS int* pmv = (LAS int*)(lds + TOK_OFF + 16384 - 128); const int* ROWTOK = (const int*)(args.ws + RT_ROWTOK);
                  LAS int* ttw = (LAS int*)(lds + TOK_OFF + 15872); SG.tt = ttw;
                  if (threadIdx.x < 32) { pg8::Unit u; const bool ok = SG.so.next((int)threadIdx.x, u); pmv[threadIdx.x] = ok ? u.pm : -1; ttw[threadIdx.x] = ok ? TILEE[u.pm] : 0; }
                  __syncthreads();
                  int tv[16];
#pragma unroll
                  for (int j = 0; j < 16; ++j) { const int idx = (int)threadIdx.x + NTHREADS * j, ui = idx >> 8; const int pm = ui < 31 ? pmv[ui] : -1; tv[j] = pm >= 0 ? ROWTOK[pm * 256 + (idx & 255)] : -2; }
#pragma unroll
                  for (int j = 0; j < 16; ++j) { const int idx = (int)threadIdx.x + NTHREADS * j; if (tv[j] != -2) tk[idx] = (unsigned short)(tv[j] < 0 ? 0 : tv[j]); }
                  __syncthreads(); }
                pg8::Gemm g{(const bf16*)(args.ws + WS_X8), (const bf16*)(args.ws + WT_EGU), nrt * 256, NE * 2 * DFE, DM / 2, DM / 2};
                pg8::EpiSwiGLUF8<0> E{(unsigned char*)(args.ws + WS_ACTM), DFE, nullptr, 2 * DFE / 256};
                pg8::gemm_phase<pg8::EpiSwiGLUF8<0>, pg8::MoeGatherOrder, true, true, true>(lds, g, SG, E); }
            else if (MOE_F8) { pg8::Gemm g{(const bf16*)(args.ws + WS_XG), (const bf16*)(args.ws + WT_EGU), nrt * 256, NE * 2 * DFE, DM / 2, DM / 2};
                pg8::EpiSwiGLUF8<0> E{(unsigned char*)(args.ws + WS_ACTM), DFE, nullptr, 2 * DFE / 256};
                pg8::gemm_phase<pg8::EpiSwiGLUF8<0>, pg8::MoeOrder, true, true, true>(lds, g, S, E); }
            else { pg8::Gemm g{(const bf16*)(args.ws + WS_XG), (const bf16*)(args.ws + WT_EGU), nrt * 256, NE * 2 * DFE, DM, DM};
                pg8::EpiSwiGLU<2> E{(bf16*)(args.ws + WS_ACTM), DFE, (const float*)(args.ws + RT_ROWRS), 2 * DFE / 256};
                pg8::gemm_phase<pg8::EpiSwiGLU<2>, pg8::MoeOrder, true, true>(lds, g, S, E); } }
        else s_moe_gu(args, smf);
        SEAM(18); }
    if (RUN(19)) {
        if (FAST(19)) { const int* TILEE = (const int*)(args.ws + RT_TILEE); const int nrt = TILEE[MAXRT];
            if (MOE_F8) { pg8::MoeOrder S; S.init((MOE_TAILFIX && nrt > 256) ? 256 : nrt, DM / 256, G, bid, TILEE);
                { LAS int* ttw = (LAS int*)(lds + TOK_OFF + 15872); __syncthreads(); if (threadIdx.x < 32) { pg8::Unit u; ttw[threadIdx.x] = S.so.next((int)threadIdx.x, u) ? TILEE[u.pm] : 0; } __syncthreads(); S.tt = ttw; }
                pg8::Gemm g{(const bf16*)(args.ws + WS_ACTM), (const bf16*)(args.ws + WT_EDN), nrt * 256, NE * DM, DFE / 2, DFE / 2};
                if (Y_F8) { pg8::EpiGateF8 E{(unsigned char*)(args.ws + WS_XG), DM, (const float*)(args.ws + RT_ROWGATE), DM / 256}; pg8::gemm_phase<pg8::EpiGateF8, pg8::MoeOrder, true, true, true>(lds, g, S, E); }
                else { pg8::EpiScaleBf16<2> E{(bf16*)(args.ws + WS_XG), DM, (const float*)(args.ws + RT_ROWGATE), DM / 256}; pg8::gemm_phase<pg8::EpiScaleBf16<2>, pg8::MoeOrder, true, true, true>(lds, g, S, E); }
                if (MOE_TAILFIX && nrt > 256) { pg8::TailOrder T; T.init(nrt, G, bid, TILEE); pg8::EpiTailPart EP{(float*)(args.ws + WS_Z)};
                    pg8::Gemm gt{(const bf16*)(args.ws + WS_ACTM), (const bf16*)(args.ws + WT_EDN), nrt * 256, NE * DM, pg8::TAIL_KB / 2, DFE / 2}; pg8::gemm_phase<pg8::EpiTailPart, pg8::TailOrder, true, true, true>(lds, gt, T, EP); } }
            else { pg8::EpiScaleBf16<2> E{(bf16*)(args.ws + WS_XG), DM, (const float*)(args.ws + RT_ROWGATE), DM / 256}; pg8::MoeOrder S; S.init(nrt, DM / 256, G, bid, TILEE); pg8::Gemm g{(const bf16*)(args.ws + WS_ACTM), (const bf16*)(args.ws + WT_EDN), nrt * 256, NE * DM, DFE, DFE}; pg8::gemm_phase<pg8::EpiScaleBf16<2>, pg8::MoeOrder, true, true>(lds, g, S, E); } }
        else s_moe_dn(args, smf);
        SEAM(19); }
    if (RUN(20)) { final_rows(args); }
#undef RUN
#undef SEAM
}

extern "C" void kernel_launch(void* const* d_in, const int* in_sizes, int n_in, void* d_out, int out_size, void* d_ws, size_t ws_size, hipStream_t stream) {
    static int grid = 0;
    if (grid == 0) {
        if (n_in != 20 || out_size != M * DM || ws_size < WS_END) { fprintf(stderr, "kernel_launch: unexpected shapes (n_in %d, out %d, ws %zu < %zu); nothing launched\n", n_in, out_size, ws_size, (size_t)WS_END); grid = -1; return; }
        int dev = 0, cus = 0, per_cu = 0;
        if (hipGetDevice(&dev) != hipSuccess || hipDeviceGetAttribute(&cus, hipDeviceAttributeMultiprocessorCount, dev) != hipSuccess) { grid = -1; return; }
        if (hipFuncSetAttribute((const void*)fwd, hipFuncAttributeMaxDynamicSharedMemorySize, LDS_TOTAL) != hipSuccess) { fprintf(stderr, "kernel_launch: hipFuncSetAttribute failed\n"); grid = -1; return; }
        if (hipOccupancyMaxActiveBlocksPerMultiprocessor(&per_cu, (const void*)fwd, NTHREADS, LDS_TOTAL) != hipSuccess || per_cu < 1) { fprintf(stderr, "kernel_launch: occupancy query says %d\n", per_cu); }
        (void)hipGetLastError();
        grid = cus;
    }
    if (grid < 0) return;
    if (hipMemsetAsync((char*)d_ws + WS_CTL, 0, CTL_ZERO_BYTES, stream) != hipSuccess) return;
    Args a{};
    a.x = (const float*)d_in[0]; a.mem = (const float*)d_in[1]; a.positions = (const int*)d_in[2]; a.mix_norm = (const float*)d_in[3]; a.w_in_a = (const float*)d_in[4];
    a.gla_gate_w = (const float*)d_in[5]; a.gla_gate_b = (const float*)d_in[6]; a.gla_out_norm = (const float*)d_in[7]; a.w_in_b = (const float*)d_in[8]; a.swa_sinks = (const float*)d_in[9];
    a.mem_norm = (const float*)d_in[10]; a.w_mem_kv = (const float*)d_in[11]; a.w_out = (const float*)d_in[12]; a.ffn_norm = (const float*)d_in[13]; a.ffn_w_gate_up = (const float*)d_in[14];
    a.ffn_w_down = (const float*)d_in[15]; a.router_w = (const float*)d_in[16]; a.exp_w_gate_up = (const float*)d_in[17]; a.exp_w_down = (const float*)d_in[18]; a.final_norm = (const float*)d_in[19];
    a.out = (float*)d_out; a.ws = (unsigned char*)d_ws; a.li = 0; a.pad = 0;
#if N_LAUNCH_MODE == 1
    a.lo = 0; a.hi = NSTEPS;
    hipLaunchKernelGGL(fwd, dim3(grid), dim3(NTHREADS), LDS_TOTAL, stream, a);
#else
    for (int s = 0; s < NSTEPS; ++s) { if (s == 17 || (s == 6 && FAST(5)) || (s == 9 && FAST(8)) || (s == 11 && FAST(10)) || (s == 14 && FAST(13))) continue;
        const int nrep = 1 + (int)((PROBE_REPEAT_MASK >> s) & 1u);
        for (int rep = 0; rep < nrep; ++rep) { a.lo = s; a.hi = s + 1; a.li = (nrep == 2 && rep == 0) ? 1 : 0; hipLaunchKernelGGL(fwd, dim3(grid), dim3(NTHREADS), LDS_TOTAL, stream, a); } }
#endif
}
```
